# Optimizing an MI355X kernel written in HIP

```python
import jax
import jax.numpy as jnp
from jax import lax
import numpy as np

D_MODEL = 1024
BATCH = 4
SEQ = 4096
DEPTH = 4

SSM_WIDTH = D_MODEL // 2
SSM_GROUP = 16
SSM_GROUPS = SSM_WIDTH // SSM_GROUP
SSM_STATE = 64
DT_MIN = 1e-3
DT_MAX = 1e-1
CONV_CH = D_MODEL // 2
CONV_K = 3
HEAD_DIM = 64
N_HEADS = (D_MODEL // 2) // HEAD_DIM
N_KV_HEADS = 2
GQA = N_HEADS // N_KV_HEADS
ATTN_WIDTH = N_HEADS * HEAD_DIM
KV_WIDTH = N_KV_HEADS * HEAD_DIM
CMP_BLOCK = 32
SEL_BLOCK = 64
N_SELECT = 16
WINDOW = 512
CMP_HIDDEN = 256
Q_CHUNK = 64
FORCE_SCORE = 1e4
NSA_BRANCHES = 3
MIX_BRANCHES = 3
D_FF = -(-8 * D_MODEL // (3 * 256)) * 256
RMS_EPS = 1e-6
IN_WIDTH = SSM_WIDTH + 3 * CONV_CH + ATTN_WIDTH + 6 * KV_WIDTH + N_HEADS * NSA_BRANCHES + MIX_BRANCHES * D_MODEL

kernel_name = 'hybrid_s5_conv_nsa_gated_trunk'


def rms_norm(x, g):
    xf = x.astype(jnp.float32)
    y = xf * lax.rsqrt(jnp.mean(xf * xf, axis=-1, keepdims=True) + RMS_EPS)
    return (y * g.astype(jnp.float32)).astype(x.dtype)


def masked_softmax(s, mask):
    s = jnp.where(mask, s, -jnp.inf)
    m = jnp.max(s, axis=-1, keepdims=True)
    m = jnp.where(jnp.isfinite(m), m, 0.0)
    e = jnp.exp(s - m)
    return e / jnp.maximum(jnp.sum(e, axis=-1, keepdims=True), 1e-30)


def split_projection(z):
    sizes = ([SSM_WIDTH, CONV_CH, CONV_CH, CONV_CH, ATTN_WIDTH] + [KV_WIDTH] * 6
             + [N_HEADS * NSA_BRANCHES, MIX_BRANCHES * D_MODEL])
    return jnp.split(z, np.cumsum(sizes)[:-1].tolist(), axis=-1)


def s5_mixer(u, lam_re, lam_im, b_re, b_im, c_re, c_im, d_skip, log_dt, w_glu):
    bsz, seq, _ = u.shape
    f32 = jnp.float32
    uf = u.astype(f32).reshape(bsz, seq, SSM_GROUPS, SSM_GROUP)
    lam = lax.complex(lam_re.astype(f32), lam_im.astype(f32))
    dt = jnp.exp(log_dt.astype(f32))[:, None]
    lam_bar = jnp.exp(lam * dt)
    b = lax.complex(b_re.astype(f32), b_im.astype(f32))
    b_bar = ((lam_bar - 1.0) / lam)[..., None] * b
    c = lax.complex(c_re.astype(f32), c_im.astype(f32))
    bu = jnp.einsum('bsgh,gph->bsgp', uf.astype(jnp.complex64), b_bar)
    a = jnp.broadcast_to(lam_bar, bu.shape)

    def combine(left, right):
        a_l, b_l = left
        a_r, b_r = right
        return a_r * a_l, a_r * b_l + b_r

    _, states = lax.associative_scan(combine, (a, bu), axis=1)
    y = jnp.einsum('bsgp,ghp->bsgh', states, c).real + d_skip.astype(f32).reshape(SSM_GROUPS, SSM_GROUP) * uf
    y = jax.nn.gelu(y.reshape(bsz, seq, SSM_WIDTH)).astype(u.dtype)
    y_lin, y_gate = jnp.split(y @ w_glu, 2, axis=-1)
    return y_lin * jax.nn.sigmoid(y_gate)


def short_conv_mixer(xin, gate_b, gate_c, conv_w, w_out):
    z = gate_c * xin
    z = lax.conv_general_dilated(z, conv_w[:, None, :], window_strides=(1,), padding=[(CONV_K - 1, 0)],
                                 dimension_numbers=('NWC', 'WIO', 'NWC'), feature_group_count=CONV_CH)
    return (gate_b * z) @ w_out


def nsa_mixer(q, k_cmp, v_cmp, k_sel, v_sel, k_win, v_win, gate_logits,
              q_norm_g, k_norm_g, cmp_pe, cmp_w1, cmp_w2, w_o):
    bsz, seq, _ = q.shape
    f32 = jnp.float32
    scale = HEAD_DIM ** -0.5
    pos = jnp.arange(seq)

    def heads(t, n):
        return t.reshape(bsz, seq, n, HEAD_DIM)

    q = rms_norm(heads(q, N_HEADS), q_norm_g).reshape(bsz, seq, N_KV_HEADS, GQA, HEAD_DIM)

    n_cmp = seq // CMP_BLOCK

    def compress(t, which):
        blocks = heads(t, N_KV_HEADS).reshape(bsz, n_cmp, CMP_BLOCK, N_KV_HEADS, HEAD_DIM) + cmp_pe[which][:, None, :]
        blocks = blocks.transpose(0, 1, 3, 2, 4).reshape(bsz, n_cmp, N_KV_HEADS, CMP_BLOCK * HEAD_DIM)
        return jax.nn.gelu(blocks @ cmp_w1[which]) @ cmp_w2[which]

    kc = rms_norm(compress(k_cmp, 0), k_norm_g[0])
    vc = compress(v_cmp, 1)
    s = jnp.einsum('bqhgd,bchd->bhgqc', q, kc).astype(f32) * scale
    cmp_end = (jnp.arange(n_cmp) + 1) * CMP_BLOCK - 1
    p_cmp = masked_softmax(s, cmp_end[None, :] <= pos[:, None])
    o_cmp = jnp.einsum('bhgqc,bchd->bqhgd', p_cmp.astype(vc.dtype), vc)

    n_blocks = seq // SEL_BLOCK
    n_top = min(N_SELECT, n_blocks)
    imp = jnp.sum(p_cmp, axis=2).reshape(bsz, N_KV_HEADS, seq, n_blocks, SEL_BLOCK // CMP_BLOCK).sum(-1)
    blk = jnp.arange(n_blocks)[None, :]
    cur = (pos // SEL_BLOCK)[:, None]
    forced = (blk == 0) | (blk == cur) | (blk == cur - 1)
    visible = blk * SEL_BLOCK <= pos[:, None]
    imp = jnp.where(forced, FORCE_SCORE, jnp.where(visible, imp, -jnp.inf))
    _, sel_idx = lax.top_k(imp, n_top)

    ks_blocks = rms_norm(heads(k_sel, N_KV_HEADS), k_norm_g[1]).reshape(
        bsz, n_blocks, SEL_BLOCK, N_KV_HEADS, HEAD_DIM).transpose(0, 3, 1, 2, 4)
    vs_blocks = heads(v_sel, N_KV_HEADS).reshape(
        bsz, n_blocks, SEL_BLOCK, N_KV_HEADS, HEAD_DIM).transpose(0, 3, 1, 2, 4)
    pad = ((0, 0), (WINDOW, 0), (0, 0), (0, 0))
    kw_pad = jnp.pad(rms_norm(heads(k_win, N_KV_HEADS), k_norm_g[2]), pad)
    vw_pad = jnp.pad(heads(v_win, N_KV_HEADS), pad)
    b_ix = jnp.arange(bsz)[:, None, None, None]
    h_ix = jnp.arange(N_KV_HEADS)[None, :, None, None]
    n_sel_keys = n_top * SEL_BLOCK

    def query_chunk(c):
        start = c * Q_CHUNK
        t = start + jnp.arange(Q_CHUNK)
        qc = lax.dynamic_slice_in_dim(q, start, Q_CHUNK, axis=1)
        idx = lax.dynamic_slice_in_dim(sel_idx, start, Q_CHUNK, axis=2)
        kg = ks_blocks[b_ix, h_ix, idx].reshape(bsz, N_KV_HEADS, Q_CHUNK, n_sel_keys, HEAD_DIM)
        vg = vs_blocks[b_ix, h_ix, idx].reshape(bsz, N_KV_HEADS, Q_CHUNK, n_sel_keys, HEAD_DIM)
        key_pos = (idx[..., None] * SEL_BLOCK + jnp.arange(SEL_BLOCK)).reshape(bsz, N_KV_HEADS, Q_CHUNK, n_sel_keys)
        s_sel = jnp.einsum('bqhgd,bhqkd->bhgqk', qc, kg).astype(f32) * scale
        p_sel = masked_softmax(s_sel, (key_pos <= t[:, None])[:, :, None])
        o_sel = jnp.einsum('bhgqk,bhqkd->bqhgd', p_sel.astype(vg.dtype), vg)
        kwc = lax.dynamic_slice_in_dim(kw_pad, start, Q_CHUNK + WINDOW, axis=1)
        vwc = lax.dynamic_slice_in_dim(vw_pad, start, Q_CHUNK + WINDOW, axis=1)
        wpos = (start - WINDOW + jnp.arange(Q_CHUNK + WINDOW))[None, :]
        wmask = (wpos <= t[:, None]) & (wpos > t[:, None] - WINDOW) & (wpos >= 0)
        s_win = jnp.einsum('bqhgd,bkhd->bhgqk', qc, kwc).astype(f32) * scale
        p_win = masked_softmax(s_win, wmask)
        o_win = jnp.einsum('bhgqk,bkhd->bqhgd', p_win.astype(vwc.dtype), vwc)
        return o_sel, o_win

    o_sel, o_win = lax.map(query_chunk, jnp.arange(seq // Q_CHUNK))

    def unchunk(o):
        return jnp.moveaxis(o, 0, 1).reshape(bsz, seq, N_KV_HEADS, GQA, HEAD_DIM)

    g = jax.nn.sigmoid(gate_logits.astype(f32)).reshape(bsz, seq, N_KV_HEADS, GQA, NSA_BRANCHES).astype(q.dtype)
    o = g[..., 0:1] * o_cmp + g[..., 1:2] * unchunk(o_sel) + g[..., 2:3] * unchunk(o_win)
    return o.reshape(bsz, seq, ATTN_WIDTH) @ w_o


def setup_inputs(seed: int = 0) -> dict:
    key = jax.random.key(seed)
    ks = jax.random.split(key, 24)
    f32 = jnp.float32
    nl, G, P, H = DEPTH, SSM_GROUPS, SSM_STATE, SSM_GROUP

    def nrm(k, shape, scale):
        return scale * jax.random.normal(k, shape, f32)

    return {
        'x': nrm(ks[0], (BATCH, SEQ, D_MODEL), 1.0),
        'mix_norm_g': 1.0 + nrm(ks[1], (nl, D_MODEL), 0.02),
        'w_in': nrm(ks[2], (nl, D_MODEL, IN_WIDTH), D_MODEL ** -0.5),
        'ssm_lam_re': -0.5 + nrm(ks[3], (nl, G, P), 0.01),
        'ssm_lam_im': jnp.pi * jnp.arange(P, dtype=f32) + nrm(ks[4], (nl, G, P), 0.01),
        'ssm_b_re': nrm(ks[5], (nl, G, P, H), (2 * H) ** -0.5),
        'ssm_b_im': nrm(ks[6], (nl, G, P, H), (2 * H) ** -0.5),
        'ssm_c_re': nrm(ks[7], (nl, G, H, P), 0.5 ** 0.5),
        'ssm_c_im': nrm(ks[8], (nl, G, H, P), 0.5 ** 0.5),
        'ssm_d': nrm(ks[9], (nl, SSM_WIDTH), 1.0),
        'ssm_log_dt': jax.random.uniform(ks[10], (nl, G), f32, float(np.log(DT_MIN)), float(np.log(DT_MAX))),
        'ssm_w_glu': nrm(ks[11], (nl, SSM_WIDTH, 2 * D_MODEL), SSM_WIDTH ** -0.5),
        'conv_w': nrm(ks[12], (nl, CONV_K, CONV_CH), CONV_K ** -0.5),
        'conv_w_out': nrm(ks[13], (nl, CONV_CH, D_MODEL), CONV_CH ** -0.5),
        'q_norm_g': 1.0 + nrm(ks[14], (nl, HEAD_DIM), 0.02),
        'k_norm_g': 1.0 + nrm(ks[15], (nl, NSA_BRANCHES, HEAD_DIM), 0.02),
        'cmp_pe': nrm(ks[16], (nl, 2, CMP_BLOCK, HEAD_DIM), 0.1),
        'cmp_w1': nrm(ks[17], (nl, 2, CMP_BLOCK * HEAD_DIM, CMP_HIDDEN), (CMP_BLOCK * HEAD_DIM) ** -0.5),
        'cmp_w2': nrm(ks[18], (nl, 2, CMP_HIDDEN, HEAD_DIM), CMP_HIDDEN ** -0.5),
        'nsa_w_o': nrm(ks[19], (nl, ATTN_WIDTH, D_MODEL), ATTN_WIDTH ** -0.5),
        'w_out': nrm(ks[20], (nl, D_MODEL, D_MODEL), D_MODEL ** -0.5),
        'ffn_norm_g': 1.0 + nrm(ks[21], (nl, D_MODEL), 0.02),
        'ffn_w_gate_up': nrm(ks[22], (nl, D_MODEL, 2 * D_FF), D_MODEL ** -0.5),
        'ffn_w_down': nrm(ks[23], (nl, D_FF, D_MODEL), D_FF ** -0.5),
    }


def reference(x, mix_norm_g, w_in, ssm_lam_re, ssm_lam_im, ssm_b_re, ssm_b_im, ssm_c_re, ssm_c_im,
              ssm_d, ssm_log_dt, ssm_w_glu, conv_w, conv_w_out, q_norm_g, k_norm_g, cmp_pe, cmp_w1,
              cmp_w2, nsa_w_o, w_out, ffn_norm_g, ffn_w_gate_up, ffn_w_down):
    bsz, seq, _ = x.shape
    for i in range(DEPTH):
        h = rms_norm(x, mix_norm_g[i])
        (u, c_b, c_c, c_x, q, k_c, v_c, k_s, v_s, k_w, v_w, nsa_gates, mix_gates) = split_projection(h @ w_in[i])
        y_ssm = s5_mixer(u, ssm_lam_re[i], ssm_lam_im[i], ssm_b_re[i], ssm_b_im[i], ssm_c_re[i], ssm_c_im[i],
                         ssm_d[i], ssm_log_dt[i], ssm_w_glu[i])
        y_conv = short_conv_mixer(c_x, c_b, c_c, conv_w[i], conv_w_out[i])
        y_attn = nsa_mixer(q, k_c, v_c, k_s, v_s, k_w, v_w, nsa_gates, q_norm_g[i], k_norm_g[i],
                           cmp_pe[i], cmp_w1[i], cmp_w2[i], nsa_w_o[i])
        gates = jax.nn.sigmoid(mix_gates.astype(jnp.float32)).astype(x.dtype).reshape(bsz, seq, MIX_BRANCHES, D_MODEL)
        mixed = gates[:, :, 0] * y_ssm + gates[:, :, 1] * y_conv + gates[:, :, 2] * y_attn
        x = x + mixed @ w_out[i]
        h = rms_norm(x, ffn_norm_g[i])
        f_gate, f_up = jnp.split(h @ ffn_w_gate_up[i], 2, axis=-1)
        x = x + (jax.nn.silu(f_gate) * f_up) @ ffn_w_down[i]
    return x
```

```cpp
#include <hip/hip_runtime.h>
#include <hip/hip_cooperative_groups.h>
#include <stdint.h>
#include <cstdio>
#include <cstring>
namespace cg = cooperative_groups;

#ifndef MEGA
#define MEGA 1
#endif

typedef unsigned short bf16_t;
typedef short bf16x8 __attribute__((ext_vector_type(8)));
typedef float f32x4 __attribute__((ext_vector_type(4)));

#define T_TOK 16384
#define SEQL 4096
#define DM 1024
#define ZLD 6528
#define NIN 6424
#define DFF 2816
#define DEPTH 4
#define LDH 1088
#define LD5 576
#define LDA 2880
#define LDC 2112
#define LDV 4160
#define LDS_F 544
#define ZC_U 0
#define ZC_CB 512
#define ZC_CC 1024
#define ZC_CX 1536
#define ZC_Q 2048
#define ZC_KC 2560
#define ZC_VC 2688
#define ZC_KS 2816
#define ZC_VS 2944
#define ZC_KW 3072
#define ZC_VW 3200
#define ZC_MIX 3328
#define ZC_NG 6400
#define RMS_EPS 1e-6f

struct Params {
  const float* in[24];
  float* x;
  bf16_t *Wt_in, *Wt_glu, *Wt_conv, *Wt_o, *Wt_out, *Wt_gu, *Wt_down, *Wt_c1;
  bf16_t *z, *hbuf, *ys, *cv, *ob, *qn, *ksn, *kwn, *vsT, *vwT, *acmp, *hid, *kc, *vcT;
  unsigned* bar;
  float* cbias;
};

__device__ __forceinline__ int tidx_() { int t = threadIdx.x; asm volatile("" : "+v"(t)); return t; }
__device__ __forceinline__ int bidx_() { int t = blockIdx.x; asm volatile("" : "+s"(t)); return t; }
#define TIDX tidx_()
#define BIDX bidx_()
__device__ __forceinline__ float bf2f(bf16_t b) { return __uint_as_float(((uint32_t)b) << 16); }
__device__ __forceinline__ uint32_t pack2(float lo, float hi) {
  uint32_t r; asm("v_cvt_pk_bf16_f32 %0, %1, %2" : "=v"(r) : "v"(lo), "v"(hi)); return r;
}
__device__ __forceinline__ float lo2f(uint32_t w) { return __uint_as_float(w << 16); }
__device__ __forceinline__ float hi2f(uint32_t w) { return __uint_as_float(w & 0xffff0000u); }
__device__ __forceinline__ float sigmoidf_(float x) { return __builtin_amdgcn_rcpf(1.0f + __expf(-x)); }
__device__ __forceinline__ float gelu_tanh(float x) { return x * sigmoidf_(1.5957691216f * (x + 0.044715f * x * x * x)); }
__device__ __forceinline__ int lds_off(int row, int ch) { return row * 128 + ((ch ^ ((row >> 1) & 7)) << 4); }

__device__ void conv_job(const float* __restrict__ src, int K, int Nsrc, int col0, int ncols, bf16_t* __restrict__ dst, int drow0, float* lt, int b0, int bs, int mode = 0) {
  const int tid = TIDX;
  const int kt = K >> 6, nt = (ncols + 63) >> 6;
  for (int tile = b0; tile < kt * nt; tile += bs) {
    const int tk = tile % kt, tn = tile / kt;
    const int nl = tid & 63, kl = tid >> 6;
    const int n = tn * 64 + nl;
#pragma unroll
    for (int i = 0; i < 16; ++i) {
      const int k = kl + 4 * i;
      int sc = col0 + n;
      if (mode == 1) { const int t = n >> 7, r = n & 127, wc = r >> 6, nn = (r & 63) >> 4, ii = r & 15; sc = ((nn < 2) ? 0 : DFF) + t * 64 + wc * 32 + (nn & 1) * 16 + ii; }
      float v = (n < ncols) ? src[(size_t)(tk * 64 + k) * Nsrc + sc] : 0.f;
      lt[nl * 65 + k] = v;
    }
    __syncthreads();
    const int k8 = (tid & 7) * 8, n2 = tid >> 3;
#pragma unroll
    for (int i = 0; i < 2; ++i) {
      const int nn = n2 + 32 * i;
      if (tn * 64 + nn < ncols) {
        const float* r = lt + nn * 65 + k8;
        uint4 w;
        w.x = pack2(r[0], r[1]); w.y = pack2(r[2], r[3]); w.z = pack2(r[4], r[5]); w.w = pack2(r[6], r[7]);
        *(uint4*)(dst + (size_t)(drow0 + tn * 64 + nn) * (K + 64) + tk * 64 + k8) = w;
      }
    }
    __syncthreads();
  }
}

__device__ void phase_convert(const Params& P, int layer, char* smem) {
  float* lt = (float*)smem;
  const int b0 = BIDX, bs = gridDim.x;
  const float* w_in = P.in[2] + (size_t)layer * DM * NIN;
  conv_job(w_in, DM, NIN, 0, 3328, P.Wt_in, 0, lt, b0, bs);
  conv_job(w_in, DM, NIN, 3352, 3072, P.Wt_in, ZC_MIX, lt, b0, bs);
  conv_job(w_in, DM, NIN, 3328, 24, P.Wt_in, ZC_NG, lt, b0, bs);
  conv_job(P.in[17] + (size_t)(layer * 2 + 0) * 2048 * 256, 2048, 256, 0, 256, P.Wt_c1, 0, lt, b0, bs);
  conv_job(P.in[17] + (size_t)(layer * 2 + 1) * 2048 * 256, 2048, 256, 0, 256, P.Wt_c1, 256, lt, b0, bs);
}
__device__ void phase_convert_late(const Params& P, int layer, char* smem, int b0, int bs) {
  float* lt = (float*)smem;
  conv_job(P.in[11] + (size_t)layer * 512 * 2048, 512, 2048, 0, 2048, P.Wt_glu, 0, lt, b0, bs);
  conv_job(P.in[13] + (size_t)layer * 512 * 1024, 512, 1024, 0, 1024, P.Wt_conv, 0, lt, b0, bs);
  conv_job(P.in[19] + (size_t)layer * 512 * 1024, 512, 1024, 0, 1024, P.Wt_o, 0, lt, b0, bs);
  conv_job(P.in[20] + (size_t)layer * 1024 * 1024, 1024, 1024, 0, 1024, P.Wt_out, 0, lt, b0, bs);
  conv_job(P.in[22] + (size_t)layer * 1024 * 5632, 1024, 5632, 0, 5632, P.Wt_gu, 0, lt, b0, bs, 1);
  conv_job(P.in[23] + (size_t)layer * DFF * 1024, DFF, 1024, 0, 1024, P.Wt_down, 0, lt, b0, bs);
}

__device__ void phase_rmsnorm(const float* __restrict__ xin, float* __restrict__ xcopy, const float* __restrict__ g, bf16_t* __restrict__ out) {
  const int lane = TIDX & 63, wave = TIDX >> 6;
  for (int tok = BIDX * 4 + wave; tok < T_TOK; tok += gridDim.x * 4) {
    const float4* xr = (const float4*)(xin + (size_t)tok * DM);
    float4 v[4];
    float ss = 0.f;
#pragma unroll
    for (int i = 0; i < 4; ++i) { v[i] = xr[lane + 64 * i]; ss += v[i].x * v[i].x + v[i].y * v[i].y + v[i].z * v[i].z + v[i].w * v[i].w; }
#pragma unroll
    for (int o = 32; o >= 1; o >>= 1) ss += __shfl_xor(ss, o);
    const float r = rsqrtf(ss * (1.0f / DM) + RMS_EPS);
    if (xcopy) {
      float4* xc = (float4*)(xcopy + (size_t)tok * DM);
#pragma unroll
      for (int i = 0; i < 4; ++i) xc[lane + 64 * i] = v[i];
    }
#pragma unroll
    for (int i = 0; i < 4; ++i) {
      const float4 gg = ((const float4*)g)[lane + 64 * i];
      uint2 w; w.x = pack2(v[i].x * r * gg.x, v[i].y * r * gg.y); w.y = pack2(v[i].z * r * gg.z, v[i].w * r * gg.w);
      *(uint2*)(out + (size_t)tok * LDH + (lane + 64 * i) * 4) = w;
    }
  }
}

template <bool A_GATHER = false>
__device__ __forceinline__ void gemm_main(const bf16_t* __restrict__ A, size_t lda, const bf16_t* __restrict__ Bt, int ldb, int K, f32x4 (&acc)[4][4], char* smem, size_t kstepA = 64) {
  const int tid = TIDX, lane = tid & 63, wave = tid >> 6, wr = wave >> 1, wc = wave & 1, l15 = lane & 15, q4 = lane >> 4;
  const int lrow = tid >> 3, lch = tid & 7;
  const bf16_t* ap = A_GATHER ? A : A + (size_t)lrow * lda + lch * 8;
  const bf16_t* bp = Bt + (size_t)lrow * ldb + lch * 8;
  const size_t sa = A_GATHER ? lda : (size_t)32 * lda, sb = (size_t)32 * ldb;
  typedef unsigned u32x4 __attribute__((ext_vector_type(4)));
  u32x4 ra0, ra1, ra2, ra3, rb0, rb1, rb2, rb3;
  u32x4 rc0, rc1, rc2, rc3, rd0, rd1, rd2, rd3;
  int nk = K >> 6;
  asm volatile("" : "+s"(nk));
  const int st_off = lds_off(lrow, lch);
  const int sw = (l15 >> 1) & 7;
  const int fr0 = l15 * 128 + (((q4 ^ (sw & 3)) << 4) | ((sw >> 2) << 6));
  const int a_off = wr * 8192 + fr0, b_off = 16384 + wc * 8192 + fr0;
#ifndef EXP_GL
#define EXP_GL 0
#endif
#ifndef EXP_LDSW
#define EXP_LDSW 0
#endif
#if EXP_GL
#define GLQ const volatile u32x4*
#define GLREP 2
#else
#define GLQ const u32x4*
#define GLREP 1
#endif
#if EXP_LDSW == 1
#define LSQ volatile u32x4*
#define LSREP 2
#else
#define LSQ u32x4*
#define LSREP 1
#endif
#define GLOAD0(AP, BP) do { for (int rep_ = 0; rep_ < GLREP; ++rep_) { ra0 = *(GLQ)(AP); ra1 = *(GLQ)((AP) + sa); ra2 = *(GLQ)((AP) + 2 * sa); ra3 = *(GLQ)((AP) + 3 * sa); \
                            rb0 = *(GLQ)(BP); rb1 = *(GLQ)((BP) + sb); rb2 = *(GLQ)((BP) + 2 * sb); rb3 = *(GLQ)((BP) + 3 * sb); } } while (0)
#define GLOAD1(AP, BP) do { for (int rep_ = 0; rep_ < GLREP; ++rep_) { rc0 = *(GLQ)(AP); rc1 = *(GLQ)((AP) + sa); rc2 = *(GLQ)((AP) + 2 * sa); rc3 = *(GLQ)((AP) + 3 * sa); \
                            rd0 = *(GLQ)(BP); rd1 = *(GLQ)((BP) + sb); rd2 = *(GLQ)((BP) + 2 * sb); rd3 = *(GLQ)((BP) + 3 * sb); } } while (0)
#define XW(P_, V_) asm volatile("ds_write_b128 %0, %1" :: "v"((unsigned)(size_t)(P_)), "v"(V_) : "memory")
#if EXP_LDSW == 2
#define XDUP0(PS) do { XW((PS), ra0); XW((PS) + 4096, ra1); XW((PS) + 8192, ra2); XW((PS) + 12288, ra3); XW((PS) + 16384, rb0); XW((PS) + 20480, rb1); XW((PS) + 24576, rb2); XW((PS) + 28672, rb3); } while (0)
#define XDUP1(PS) do { XW((PS), rc0); XW((PS) + 4096, rc1); XW((PS) + 8192, rc2); XW((PS) + 12288, rc3); XW((PS) + 16384, rd0); XW((PS) + 20480, rd1); XW((PS) + 24576, rd2); XW((PS) + 28672, rd3); } while (0)
#else
#define XDUP0(PS) do { } while (0)
#define XDUP1(PS) do { } while (0)
#endif
#define LSTORE0(PS) do { XDUP0(PS); for (int rep_ = 0; rep_ < LSREP; ++rep_) { *(LSQ)(PS) = ra0; *(LSQ)((PS) + 4096) = ra1; *(LSQ)((PS) + 8192) = ra2; *(LSQ)((PS) + 12288) = ra3; \
                         *(LSQ)((PS) + 16384) = rb0; *(LSQ)((PS) + 20480) = rb1; *(LSQ)((PS) + 24576) = rb2; *(LSQ)((PS) + 28672) = rb3; } } while (0)
#define LSTORE1(PS) do { XDUP1(PS); for (int rep_ = 0; rep_ < LSREP; ++rep_) { *(LSQ)(PS) = rc0; *(LSQ)((PS) + 4096) = rc1; *(LSQ)((PS) + 8192) = rc2; *(LSQ)((PS) + 12288) = rc3; \
                         *(LSQ)((PS) + 16384) = rd0; *(LSQ)((PS) + 20480) = rd1; *(LSQ)((PS) + 24576) = rd2; *(LSQ)((PS) + 28672) = rd3; } } while (0)
#define COMPUTE(BO) do { _Pragma("unroll") for (int ks = 0; ks < 2; ++ks) { \
      bf16x8 af[4], bfr[4]; \
      const char* pa = smem + (BO) + (a_off ^ (ks * 64)); \
      const char* pb = smem + (BO) + (b_off ^ (ks * 64)); \
      _Pragma("unroll") for (int m = 0; m < 4; ++m) af[m] = *(const bf16x8*)(pa + m * 2048); \
      _Pragma("unroll") for (int n = 0; n < 4; ++n) bfr[n] = *(const bf16x8*)(pb + n * 2048); \
      _Pragma("unroll") for (int m = 0; m < 4; ++m) \
        _Pragma("unroll") for (int n = 0; n < 4; ++n) acc[m][n] = __builtin_amdgcn_mfma_f32_16x16x32_bf16(bfr[n], af[m], acc[m][n], 0, 0, 0); } } while (0)
  GLOAD0(ap, bp);
  GLOAD1(ap + kstepA, bp + 64);
  LSTORE0(smem + st_off);
  __syncthreads();
#pragma nounroll
  for (int kt = 0; kt < nk; kt += 2) {
    { const int t2 = (kt + 2 < nk) ? kt + 2 : nk - 1; const bf16_t* ap2 = ap + t2 * kstepA; const bf16_t* bp2 = bp + t2 * 64; GLOAD0(ap2, bp2); }
    __builtin_amdgcn_sched_barrier(0);
    COMPUTE(0);
    LSTORE1(smem + 32768 + st_off);
    __syncthreads();
    { const int t3 = (kt + 3 < nk) ? kt + 3 : nk - 1; const bf16_t* ap2 = ap + t3 * kstepA; const bf16_t* bp2 = bp + t3 * 64; GLOAD1(ap2, bp2); }
    __builtin_amdgcn_sched_barrier(0);
    COMPUTE(32768);
    LSTORE0(smem + st_off);
    __syncthreads();
  }
#undef GLOAD0
#undef GLOAD1
#undef LSTORE0
#undef LSTORE1
#undef COMPUTE
#undef GLQ
#undef LSQ
#undef GLREP
#undef LSREP
}

__device__ __forceinline__ void gemm_main_shallow(const bf16_t* __restrict__ A, int lda, const bf16_t* __restrict__ Bt, int ldb, int K, f32x4 (&acc)[4][4], char* smem) {
  const int tid = TIDX, lane = tid & 63, wave = tid >> 6, wr = wave >> 1, wc = wave & 1, l15 = lane & 15, q4 = lane >> 4;
  const int lrow = tid >> 3, lch = tid & 7;
  const bf16_t* ap = A + (size_t)lrow * lda + lch * 8;
  const bf16_t* bp = Bt + (size_t)lrow * ldb + lch * 8;
  const size_t sa = (size_t)32 * lda, sb = (size_t)32 * ldb;
  uint4 ra0, ra1, ra2, ra3, rb0, rb1, rb2, rb3;
  int nk = K >> 6;
  asm volatile("" : "+s"(nk));
  const int st_off = lds_off(lrow, lch);
  const int sw = (l15 >> 1) & 7;
  const int fr0 = l15 * 128 + (((q4 ^ (sw & 3)) << 4) | ((sw >> 2) << 6));
  const int a_off = wr * 8192 + fr0, b_off = 16384 + wc * 8192 + fr0;
#define GLOAD(AP, BP) do { ra0 = *(const uint4*)(AP); ra1 = *(const uint4*)((AP) + sa); ra2 = *(const uint4*)((AP) + 2 * sa); ra3 = *(const uint4*)((AP) + 3 * sa); \
                           rb0 = *(const uint4*)(BP); rb1 = *(const uint4*)((BP) + sb); rb2 = *(const uint4*)((BP) + 2 * sb); rb3 = *(const uint4*)((BP) + 3 * sb); } while (0)
#define LSTORE(PS) do { *(uint4*)(PS) = ra0; *(uint4*)((PS) + 4096) = ra1; *(uint4*)((PS) + 8192) = ra2; *(uint4*)((PS) + 12288) = ra3; \
                        *(uint4*)((PS) + 16384) = rb0; *(uint4*)((PS) + 20480) = rb1; *(uint4*)((PS) + 24576) = rb2; *(uint4*)((PS) + 28672) = rb3; } while (0)
  GLOAD(ap, bp);
  LSTORE(smem + st_off);
  __syncthreads();
#pragma nounroll
  for (int kt = 0; kt < nk; ++kt) {
    const int bo = (kt & 1) * 32768;
    const bool more = kt + 1 < nk;
    if (more) { const bf16_t* ap2 = ap + (kt + 1) * 64; const bf16_t* bp2 = bp + (kt + 1) * 64; GLOAD(ap2, bp2); }
#pragma unroll
    for (int ks = 0; ks < 2; ++ks) {
      bf16x8 af[4], bfr[4];
      const char* pa = smem + bo + (a_off ^ (ks * 64));
      const char* pb = smem + bo + (b_off ^ (ks * 64));
#pragma unroll
      for (int m = 0; m < 4; ++m) af[m] = *(const bf16x8*)(pa + m * 2048);
#pragma unroll
      for (int n = 0; n < 4; ++n) bfr[n] = *(const bf16x8*)(pb + n * 2048);
#pragma unroll
      for (int m = 0; m < 4; ++m)
#pragma unroll
        for (int n = 0; n < 4; ++n) acc[m][n] = __builtin_amdgcn_mfma_f32_16x16x32_bf16(bfr[n], af[m], acc[m][n], 0, 0, 0);
    }
    if (more) { char* ps = smem + (bo ^ 32768) + st_off; LSTORE(ps); }
    __syncthreads();
  }
#undef GLOAD
#undef LSTORE
}

__device__ __forceinline__ void zero_acc(f32x4 (&acc)[4][4]) {
#pragma unroll
  for (int m = 0; m < 4; ++m)
#pragma unroll
    for (int n = 0; n < 4; ++n) acc[m][n] = (f32x4){0.f, 0.f, 0.f, 0.f};
}
__device__ __forceinline__ bool tile_coords(int u, int nN, int& tm, int& tn) {
  const int xcd = u & 7, loc = u >> 3;
  const int sb = loc >> 6, mi = loc & 7, ni = (loc >> 3) & 7;
  tm = xcd * 16 + (sb & 1) * 8 + mi; tn = (sb >> 1) * 8 + ni;
  return tn < nN;
}
__device__ __forceinline__ int tile_slots(int nN) { return 128 * ((nN + 7) & ~7); }
#define EPI_SETUP const int lane_ = TIDX & 63, wave_ = TIDX >> 6; const int rbase = tm * 128 + (wave_ >> 1) * 64 + (lane_ & 15); const int cbase = tn * 128 + (wave_ & 1) * 64 + (lane_ >> 4) * 4;

__device__ void phase_gemm_in(const Params& P, char* smem) {
  for (int u = BIDX; u < tile_slots(51); u += gridDim.x) {
    int tm, tn; if (!tile_coords(u, 51, tm, tn)) continue;
    f32x4 acc[4][4]; zero_acc(acc);
    gemm_main(P.hbuf + (size_t)tm * 128 * LDH, LDH, P.Wt_in + (size_t)tn * 128 * LDH, LDH, DM, acc, smem);
    EPI_SETUP
    const bool is_gate = (tn >= ZC_MIX / 128) && (tn < ZC_NG / 128);
#pragma unroll
    for (int m = 0; m < 4; ++m)
#pragma unroll
      for (int n = 0; n < 4; ++n) {
        const int row = rbase + m * 16, col = cbase + n * 16;
        f32x4 v = acc[m][n];
        if (is_gate) { v[0] = sigmoidf_(v[0]); v[1] = sigmoidf_(v[1]); v[2] = sigmoidf_(v[2]); v[3] = sigmoidf_(v[3]); }
        uint2 w; w.x = pack2(v[0], v[1]); w.y = pack2(v[2], v[3]);
        *(uint2*)(P.z + (size_t)row * ZLD + col) = w;
      }
  }
}
__device__ void phase_gemm_resid(const Params& P, const bf16_t* A, int lda, const bf16_t* Bt, int K, char* smem, float alpha = 1.0f) {
  for (int u = BIDX; u < tile_slots(8); u += gridDim.x) {
    int tm, tn; if (!tile_coords(u, 8, tm, tn)) continue;
    f32x4 acc[4][4]; zero_acc(acc);
    gemm_main(A + (size_t)tm * 128 * lda, lda, Bt + (size_t)tn * 128 * (K + 64), K + 64, K, acc, smem);
    EPI_SETUP
#pragma unroll
    for (int m = 0; m < 4; ++m)
#pragma unroll
      for (int n = 0; n < 4; ++n) {
        const int row = rbase + m * 16, col = cbase + n * 16;
        float4* p = (float4*)(P.x + (size_t)row * DM + col);
        float4 v = *p;
        v.x += alpha * acc[m][n][0]; v.y += alpha * acc[m][n][1]; v.z += alpha * acc[m][n][2]; v.w += alpha * acc[m][n][3];
        *p = v;
      }
  }
}
__device__ void phase_gemm_gateup(const Params& P, char* smem) {
  bf16_t* act = P.z;
  for (int u = BIDX; u < tile_slots(44); u += gridDim.x) {
    int tm, tn; if (!tile_coords(u, 44, tm, tn)) continue;
    f32x4 acc[4][4]; zero_acc(acc);
    gemm_main(P.hbuf + (size_t)tm * 128 * LDH, LDH, P.Wt_gu + (size_t)tn * 128 * LDH, LDH, DM, acc, smem);
    const int lane_ = TIDX & 63, wave_ = TIDX >> 6;
    const int rbase = tm * 128 + (wave_ >> 1) * 64 + (lane_ & 15);
    const int cbase = tn * 64 + (wave_ & 1) * 32 + (lane_ >> 4) * 4;
#pragma unroll
    for (int m = 0; m < 4; ++m)
#pragma unroll
      for (int n = 0; n < 2; ++n) {
        const int row = rbase + m * 16, col = cbase + n * 16;
        float o[4];
#pragma unroll
        for (int r = 0; r < 4; ++r) { const float gq = acc[m][n][r]; o[r] = gq * sigmoidf_(gq) * acc[m][n + 2][r]; }
        uint2 w; w.x = pack2(o[0], o[1]); w.y = pack2(o[2], o[3]);
        *(uint2*)(act + (size_t)row * LDA + col) = w;
      }
  }
}
__device__ void phase_gemm_cmp1(const Params& P, char* smem, int u0, int ustride) {
  for (int u = u0; u < 32; u += ustride) {
    const int which = u >> 4, rem = u & 15, tm = rem & 7, tn = rem >> 3;
    f32x4 acc[4][4]; zero_acc(acc);
    const int tid = TIDX, lrow = tid >> 3, lch = tid & 7;
    const bf16_t* ap = P.z + ((size_t)(tm * 64 + (lrow >> 1)) * 32) * ZLD + (which ? ZC_VC : ZC_KC) + (lrow & 1) * 64 + lch * 8;
    gemm_main<true>(ap, (size_t)512 * ZLD, P.Wt_c1 + (size_t)which * 256 * LDC + (size_t)tn * 128 * LDC, LDC, 2048, acc, smem, (size_t)ZLD);
    EPI_SETUP
#pragma unroll
    for (int m = 0; m < 4; ++m)
#pragma unroll
      for (int n = 0; n < 4; ++n) {
        const int row = rbase + m * 16, col = cbase + n * 16;
        const float4 bb = *(const float4*)(P.cbias + which * 256 + col);
        uint2 w; w.x = pack2(gelu_tanh(acc[m][n][0] + bb.x), gelu_tanh(acc[m][n][1] + bb.y)); w.y = pack2(gelu_tanh(acc[m][n][2] + bb.z), gelu_tanh(acc[m][n][3] + bb.w));
        *(uint2*)(P.hid + (size_t)which * 1024 * 256 + (size_t)row * 256 + col) = w;
      }
  }
}
__device__ void phase_cmp_bias(const Params& P, int layer) {
  const int lane = TIDX & 63, wave = TIDX >> 6;
  for (int o = BIDX * 4 + wave; o < 512; o += gridDim.x * 4) {
    const int which = o >> 8, col = o & 255;
    const float* pe = P.in[16] + (size_t)(layer * 2 + which) * 2048;
    const float* w1 = P.in[17] + (size_t)(layer * 2 + which) * 2048 * 256 + col;
    float acc = 0.f;
    for (int k = lane; k < 2048; k += 64) acc += pe[k] * w1[(size_t)k * 256];
#pragma unroll
    for (int o2 = 32; o2 >= 1; o2 >>= 1) acc += __shfl_xor(acc, o2);
    if (lane == 0) P.cbias[o] = acc;
  }
}
__device__ void phase_merge(const Params& P, char* smem) {
  for (int u = BIDX; u < tile_slots(8); u += gridDim.x) {
    int tm, tn; if (!tile_coords(u, 8, tm, tn)) continue;
    EPI_SETUP
    const unsigned eoff = (unsigned)rbase * ZLD + (unsigned)cbase;
    const unsigned hoff = (unsigned)rbase * LDH + (unsigned)cbase;
    {
      f32x4 a0[4][4], a1[4][4]; zero_acc(a0); zero_acc(a1);
      gemm_main_shallow(P.ys + (size_t)tm * 128 * LD5, LD5, P.Wt_glu + (size_t)tn * 128 * LD5, LD5, 512, a0, smem);
      gemm_main_shallow(P.ys + (size_t)tm * 128 * LD5, LD5, P.Wt_glu + (size_t)(1024 + tn * 128) * LD5, LD5, 512, a1, smem);
      const bf16_t* zg = P.z + ZC_MIX;
#pragma unroll
      for (int m = 0; m < 4; ++m)
#pragma unroll
        for (int n = 0; n < 4; ++n) {
          const uint2 gw = *(const uint2*)(zg + (eoff + (unsigned)(m * 16 * ZLD + n * 16)));
          uint2 w;
          w.x = pack2(lo2f(gw.x) * a0[m][n][0] * sigmoidf_(a1[m][n][0]), hi2f(gw.x) * a0[m][n][1] * sigmoidf_(a1[m][n][1]));
          w.y = pack2(lo2f(gw.y) * a0[m][n][2] * sigmoidf_(a1[m][n][2]), hi2f(gw.y) * a0[m][n][3] * sigmoidf_(a1[m][n][3]));
          *(uint2*)(P.hbuf + (hoff + (unsigned)(m * 16 * LDH + n * 16))) = w;
        }
    }
    int nbr = 3;
    asm volatile("" : "+s"(nbr));
    for (int br = 1; br < nbr; ++br) {
      f32x4 a1[4][4]; zero_acc(a1);
      const bf16_t* A = (br == 1) ? P.cv : P.ob;
      const bf16_t* B = (br == 1) ? P.Wt_conv : P.Wt_o;
      gemm_main_shallow(A + (size_t)tm * 128 * LD5, LD5, B + (size_t)tn * 128 * LD5, LD5, 512, a1, smem);
      const bf16_t* zg = P.z + ZC_MIX + br * 1024;
#pragma unroll
      for (int m = 0; m < 4; ++m)
#pragma unroll
        for (int n = 0; n < 4; ++n) {
          const uint2 gw = *(const uint2*)(zg + (eoff + (unsigned)(m * 16 * ZLD + n * 16)));
          uint2* hp = (uint2*)(P.hbuf + (hoff + (unsigned)(m * 16 * LDH + n * 16)));
          const uint2 hv = *hp;
          uint2 w;
          w.x = pack2(lo2f(hv.x) + lo2f(gw.x) * a1[m][n][0], hi2f(hv.x) + hi2f(gw.x) * a1[m][n][1]);
          w.y = pack2(lo2f(hv.y) + lo2f(gw.y) * a1[m][n][2], hi2f(hv.y) + hi2f(gw.y) * a1[m][n][3]);
          *hp = w;
        }
    }
  }
}

__device__ void s5_unit(const Params& P, int layer, int unit, char* smem) {
  const int b = unit >> 5, g = unit & 31;
  const int tid = TIDX, lane = tid & 63, w = tid >> 6, l15 = lane & 15, q4 = lane >> 4;
  const int p = lane, q = w;
  float* bu = (float*)smem;
  bf16_t* stb = (bf16_t*)(smem + 33280);
  float2* send = (float2*)(smem + 33280 + 17408);
  bf16_t* usb = (bf16_t*)(smem + 33280 + 17408 + 2048);
  const float* lam_re = P.in[3] + (size_t)layer * 32 * 64 + g * 64, *lam_im = P.in[4] + (size_t)layer * 32 * 64 + g * 64;
  const float* b_re = P.in[5] + ((size_t)layer * 32 + g) * 64 * 16, *b_im = P.in[6] + ((size_t)layer * 32 + g) * 64 * 16;
  const float* c_re = P.in[7] + ((size_t)layer * 32 + g) * 16 * 64, *c_im = P.in[8] + ((size_t)layer * 32 + g) * 16 * 64;
  const float dk = P.in[9][(size_t)layer * 512 + g * 16 + l15];
  const float dt = expf(P.in[10][layer * 32 + g]);
  float lbr, lbi, l16r, l16i;
  {
    const float lr = lam_re[p], li = lam_im[p];
    float sn, cs_; sincosf(li * dt, &sn, &cs_);
    const float e = expf(lr * dt);
    lbr = e * cs_; lbi = e * sn;
    l16r = lbr; l16i = lbi;
#pragma unroll
    for (int i = 0; i < 4; ++i) { const float tr = l16r * l16r - l16i * l16i, ti = 2.f * l16r * l16i; l16r = tr; l16i = ti; }
  }
  bf16x8 bB[2];
#pragma unroll
  for (int nt = 0; nt < 2; ++nt) {
    const int pp = (2 * w + nt) * 16 + l15, ps = pp >> 1, cpl = pp & 1;
    const float lr = lam_re[ps], li = lam_im[ps];
    float sn, cs_; sincosf(li * dt, &sn, &cs_);
    const float e = expf(lr * dt);
    const float nr = e * cs_ - 1.0f, ni = e * sn, den = lr * lr + li * li;
    const float cfr = (nr * lr + ni * li) / den, cfi = (ni * lr - nr * li) / den;
    float v[8];
#pragma unroll
    for (int j = 0; j < 8; ++j) {
      const int h = (q4 & 1) * 8 + j;
      const float br = b_re[ps * 16 + h], bi = b_im[ps * 16 + h];
      const float val = cpl ? (cfr * bi + cfi * br) : (cfr * br - cfi * bi);
      v[j] = (q4 < 2) ? val : 0.f;
    }
    union { uint32_t u[4]; bf16x8 x; } cv; cv.u[0] = pack2(v[0], v[1]); cv.u[1] = pack2(v[2], v[3]); cv.u[2] = pack2(v[4], v[5]); cv.u[3] = pack2(v[6], v[7]);
    bB[nt] = cv.x;
  }
  bf16x8 cB[4];
#pragma unroll
  for (int ks = 0; ks < 4; ++ks) {
    float v[8];
#pragma unroll
    for (int j = 0; j < 8; ++j) {
      const int pp = ks * 32 + q4 * 8 + j, ps = pp >> 1;
      v[j] = (pp & 1) ? -c_im[l15 * 64 + ps] : c_re[l15 * 64 + ps];
    }
    union { uint32_t u[4]; bf16x8 x; } cv; cv.u[0] = pack2(v[0], v[1]); cv.u[1] = pack2(v[2], v[3]); cv.u[2] = pack2(v[4], v[5]); cv.u[3] = pack2(v[6], v[7]);
    cB[ks] = cv.x;
  }
  float car_r = 0.f, car_i = 0.f;
  bf16x8 un0, un1, un2, un3;
  {
    const bf16_t* zp = P.z + ((size_t)b * SEQL + l15) * ZLD + ZC_U + g * 16 + (q4 & 1) * 8;
    un0 = *(const bf16x8*)(zp); un1 = *(const bf16x8*)(zp + (size_t)16 * ZLD); un2 = *(const bf16x8*)(zp + (size_t)32 * ZLD); un3 = *(const bf16x8*)(zp + (size_t)48 * ZLD);
  }
  for (int chunk = 0; chunk < 64; ++chunk) {
    const size_t tok0 = (size_t)b * SEQL + chunk * 64;
    {
      bf16x8 ua[4];
      const bf16x8 zz = (bf16x8){0, 0, 0, 0, 0, 0, 0, 0};
      ua[0] = (q4 < 2) ? un0 : zz; ua[1] = (q4 < 2) ? un1 : zz; ua[2] = (q4 < 2) ? un2 : zz; ua[3] = (q4 < 2) ? un3 : zz;
      if (w == 0 && q4 < 2) {
#pragma unroll
        for (int mt = 0; mt < 4; ++mt) *(bf16x8*)(usb + (chunk & 1) * 1024 + (mt * 16 + l15) * 16 + q4 * 8) = ua[mt];
      }
      if (chunk + 1 < 64) {
        const bf16_t* zp = P.z + (tok0 + 64 + l15) * ZLD + ZC_U + g * 16 + (q4 & 1) * 8;
        un0 = *(const bf16x8*)(zp); un1 = *(const bf16x8*)(zp + (size_t)16 * ZLD); un2 = *(const bf16x8*)(zp + (size_t)32 * ZLD); un3 = *(const bf16x8*)(zp + (size_t)48 * ZLD);
      }
#pragma unroll
      for (int mt = 0; mt < 4; ++mt)
#pragma unroll
        for (int nt = 0; nt < 2; ++nt) {
          const f32x4 acc = __builtin_amdgcn_mfma_f32_16x16x32_bf16(ua[mt], bB[nt], (f32x4){0.f, 0.f, 0.f, 0.f}, 0, 0, 0);
          float* dst = bu + (mt * 16 + q4 * 4) * 130 + (2 * w + nt) * 16 + l15;
          dst[0] = acc[0]; dst[130] = acc[1]; dst[260] = acc[2]; dst[390] = acc[3];
        }
    }
    __syncthreads();
    float locr[16], loci[16];
    float sr = 0.f, si = 0.f;
#pragma unroll
    for (int i = 0; i < 16; ++i) {
      const float2 v = *(const float2*)(bu + (q * 16 + i) * 130 + 2 * p);
      const float nsr = lbr * sr - lbi * si + v.x, nsi = lbr * si + lbi * sr + v.y;
      sr = nsr; si = nsi; locr[i] = sr; loci[i] = si;
    }
    send[q * 64 + p] = make_float2(sr, si);
    __syncthreads();
    float cur_r = car_r, cur_i = car_i, mine_r = 0.f, mine_i = 0.f;
#pragma unroll
    for (int qq = 0; qq < 4; ++qq) {
      if (qq == q) { mine_r = cur_r; mine_i = cur_i; }
      const float2 ev = send[qq * 64 + p];
      const float tr = l16r * cur_r - l16i * cur_i + ev.x, ti = l16r * cur_i + l16i * cur_r + ev.y;
      cur_r = tr; cur_i = ti;
    }
    car_r = cur_r; car_i = cur_i;
    float cpr = lbr * mine_r - lbi * mine_i, cpi = lbr * mine_i + lbi * mine_r;
#pragma unroll
    for (int i = 0; i < 16; ++i) {
      *(uint32_t*)(stb + (q * 16 + i) * 136 + 2 * p) = pack2(locr[i] + cpr, loci[i] + cpi);
      const float tr = lbr * cpr - lbi * cpi, ti = lbr * cpi + lbi * cpr;
      cpr = tr; cpi = ti;
    }
    __syncthreads();
    {
      f32x4 acc = (f32x4){0.f, 0.f, 0.f, 0.f};
#pragma unroll
      for (int ks = 0; ks < 4; ++ks) {
        const bf16x8 as = *(const bf16x8*)(stb + (w * 16 + l15) * 136 + ks * 32 + q4 * 8);
        acc = __builtin_amdgcn_mfma_f32_16x16x32_bf16(as, cB[ks], acc, 0, 0, 0);
      }
#pragma unroll
      for (int r = 0; r < 4; ++r) {
        const size_t t = tok0 + w * 16 + q4 * 4 + r;
        const float uval = bf2f(usb[(chunk & 1) * 1024 + (w * 16 + q4 * 4 + r) * 16 + l15]);
        const float y = gelu_tanh(acc[r] + dk * uval);
        P.ys[t * LD5 + g * 16 + l15] = (bf16_t)(pack2(y, 0.f) & 0xffffu);
      }
    }
  }
}

__device__ __forceinline__ void load8(const bf16_t* p, float (&f)[8]) {
  const uint4 w = *(const uint4*)p;
  f[0] = lo2f(w.x); f[1] = hi2f(w.x); f[2] = lo2f(w.y); f[3] = hi2f(w.y); f[4] = lo2f(w.z); f[5] = hi2f(w.z); f[6] = lo2f(w.w); f[7] = hi2f(w.w);
}
__device__ __forceinline__ void store8(bf16_t* p, const float (&f)[8]) {
  uint4 w; w.x = pack2(f[0], f[1]); w.y = pack2(f[2], f[3]); w.z = pack2(f[4], f[5]); w.w = pack2(f[6], f[7]);
  *(uint4*)p = w;
}
__device__ void prep_unit(const Params& P, int layer, int ck, char* smem) {
  const int tid = TIDX;
  const int tok0 = ck * 64, b = tok0 >> 12, s0 = tok0 & 4095;
  const bf16_t* z = P.z;
  {
    const float* cw = P.in[12] + (size_t)layer * 3 * 512;
    const int c2 = tid * 2;
    const float w00 = cw[c2], w01 = cw[c2 + 1], w10 = cw[512 + c2], w11 = cw[512 + c2 + 1], w20 = cw[1024 + c2], w21 = cw[1024 + c2 + 1];
    float p2a = 0.f, p2b = 0.f, p1a = 0.f, p1b = 0.f;
    if (s0 >= 2) {
      const uint32_t cc2 = *(const uint32_t*)(z + (size_t)(tok0 - 2) * ZLD + ZC_CC + c2), cx2 = *(const uint32_t*)(z + (size_t)(tok0 - 2) * ZLD + ZC_CX + c2);
      const uint32_t cc1 = *(const uint32_t*)(z + (size_t)(tok0 - 1) * ZLD + ZC_CC + c2), cx1 = *(const uint32_t*)(z + (size_t)(tok0 - 1) * ZLD + ZC_CX + c2);
      p2a = lo2f(cc2) * lo2f(cx2); p2b = hi2f(cc2) * hi2f(cx2); p1a = lo2f(cc1) * lo2f(cx1); p1b = hi2f(cc1) * hi2f(cx1);
    }
#pragma unroll 4
    for (int t = 0; t < 64; ++t) {
      const size_t ro = (size_t)(tok0 + t) * ZLD;
      const uint32_t cb = *(const uint32_t*)(z + ro + ZC_CB + c2), cc = *(const uint32_t*)(z + ro + ZC_CC + c2), cx = *(const uint32_t*)(z + ro + ZC_CX + c2);
      const float p0a = lo2f(cc) * lo2f(cx), p0b = hi2f(cc) * hi2f(cx);
      const float oa = lo2f(cb) * (w00 * p2a + w10 * p1a + w20 * p0a), ob_ = hi2f(cb) * (w01 * p2b + w11 * p1b + w21 * p0b);
      *(uint32_t*)(P.cv + (size_t)(tok0 + t) * LD5 + c2) = pack2(oa, ob_);
      p2a = p1a; p2b = p1b; p1a = p0a; p1b = p0b;
    }
  }
  {
    const float* qg = P.in[14] + (size_t)layer * 64;
    const int d8 = (tid & 7) * 8;
    float gq[8];
#pragma unroll
    for (int j = 0; j < 8; ++j) gq[j] = qg[d8 + j] * (0.125f * 1.44269504089f);
#pragma unroll 2
    for (int it = 0; it < 16; ++it) {
      const int row = it * 32 + (tid >> 3), t = row >> 3, h = row & 7;
      float f[8]; load8(z + (size_t)(tok0 + t) * ZLD + ZC_Q + h * 64 + d8, f);
      float ss = 0.f;
#pragma unroll
      for (int j = 0; j < 8; ++j) ss += f[j] * f[j];
      ss += __shfl_xor(ss, 1); ss += __shfl_xor(ss, 2); ss += __shfl_xor(ss, 4);
      const float r = rsqrtf(ss * (1.0f / 64.f) + RMS_EPS);
#pragma unroll
      for (int j = 0; j < 8; ++j) f[j] = f[j] * r * gq[j];
      store8(P.qn + (size_t)(tok0 + t) * 512 + h * 64 + d8, f);
    }
  }
  {
    const float* kg = P.in[15] + (size_t)layer * 3 * 64;
    const int d8 = (tid & 7) * 8;
#pragma unroll 2
    for (int it = 0; it < 8; ++it) {
      const int row = it * 32 + (tid >> 3), which = row >> 7, t = (row >> 1) & 63, kvh = row & 1;
      float f[8]; load8(z + (size_t)(tok0 + t) * ZLD + (which ? ZC_KW : ZC_KS) + kvh * 64 + d8, f);
      float ss = 0.f;
#pragma unroll
      for (int j = 0; j < 8; ++j) ss += f[j] * f[j];
      ss += __shfl_xor(ss, 1); ss += __shfl_xor(ss, 2); ss += __shfl_xor(ss, 4);
      const float r = rsqrtf(ss * (1.0f / 64.f) + RMS_EPS);
#pragma unroll
      for (int j = 0; j < 8; ++j) f[j] = f[j] * r * kg[(1 + which) * 64 + d8 + j];
      bf16_t* dst = (which ? P.kwn : P.ksn) + ((size_t)(b * 2 + kvh) * SEQL + s0 + t) * 64 + d8;
      store8(dst, f);
    }
  }
  {
    bf16_t* lt = (bf16_t*)smem;
    for (int which = 0; which < 2; ++which) {
      __syncthreads();
      {
        const int c8 = (tid & 15) * 8;
#pragma unroll
        for (int it = 0; it < 4; ++it) {
          const int t = it * 16 + (tid >> 4);
          const uint4 w = *(const uint4*)(z + (size_t)(tok0 + t) * ZLD + (which ? ZC_VW : ZC_VS) + c8);
          uint32_t* d = (uint32_t*)(lt + t * 130 + c8);
          d[0] = w.x; d[1] = w.y; d[2] = w.z; d[3] = w.w;
        }
      }
      __syncthreads();
      const int lane = tid & 63, wave = tid >> 6;
      bf16_t* dstb = which ? P.vwT : P.vsT;
#pragma unroll 4
      for (int it = 0; it < 32; ++it) {
        const int row = it * 4 + wave;
        dstb[((size_t)(b * 2) * 64 + row) * LDV + s0 + lane] = lt[lane * 130 + row];
      }
    }
  }
}
__device__ void phase_prep(const Params& P, int layer, char* smem) {
  const int bid = BIDX;
  if (bid < 32) phase_gemm_cmp1(P, smem, bid, 32);
  else if (bid < 288) { prep_unit(P, layer, bid - 32, smem); }
  else phase_convert_late(P, layer, smem, bid - 288, gridDim.x - 288);
}

__device__ void phase_cmp2(const Params& P, int layer) {
  const int lane = TIDX & 63, wave = TIDX >> 6;
  for (int wu = BIDX * 4 + wave; wu < 2048; wu += gridDim.x * 4) {
    const int which = wu >> 10, row = wu & 1023;
    const float* w2 = P.in[18] + (size_t)(layer * 2 + which) * 256 * 64;
    const bf16_t* hr = P.hid + (size_t)which * 1024 * 256 + (size_t)row * 256;
    float acc = 0.f;
#pragma unroll 8
    for (int k = 0; k < 256; ++k) acc += bf2f(hr[k]) * w2[k * 64 + lane];
    const int kvh = row & 1, bc = row >> 1, b = bc >> 7, c = bc & 127;
    if (which == 0) {
      float ss = acc * acc;
#pragma unroll
      for (int o = 32; o >= 1; o >>= 1) ss += __shfl_xor(ss, o);
      const float r = rsqrtf(ss * (1.0f / 64.f) + RMS_EPS);
      const float v = acc * r * P.in[15][(size_t)layer * 3 * 64 + lane];
      P.kc[((size_t)(b * 2 + kvh) * 128 + c) * 64 + lane] = (bf16_t)(pack2(v, 0.f) & 0xffff);
    } else {
      P.vcT[((size_t)(b * 2 + kvh) * 64 + lane) * 128 + c] = (bf16_t)(pack2(acc, 0.f) & 0xffff);
    }
  }
}

#define NEGBIG (-1e30f)
#define NQ 2
__device__ __forceinline__ void attn_load_tiles(const bf16_t* __restrict__ Kp, const bf16_t* __restrict__ Vp, int vstride, char* KT, char* VT) {
  const int tid = TIDX;
  const int row = tid >> 3, ch = tid & 7;
  const int so = lds_off(row, ch);
  const uint4 k0 = *(const uint4*)(Kp + (size_t)row * 64 + ch * 8), k1 = *(const uint4*)(Kp + (size_t)(row + 32) * 64 + ch * 8);
  const uint4 v0 = *(const uint4*)(Vp + (size_t)row * vstride + ch * 8), v1 = *(const uint4*)(Vp + (size_t)(row + 32) * vstride + ch * 8);
  *(uint4*)(KT + so) = k0; *(uint4*)(KT + so + 4096) = k1;
  *(uint4*)(VT + so) = v0; *(uint4*)(VT + so + 4096) = v1;
}
#define KV_ISSUE(Kp, Vp, vstride) do { const int tid_ = TIDX; const int row_ = tid_ >> 3, ch_ = tid_ & 7; \
    rk0 = *(const uint4*)((Kp) + (size_t)row_ * 64 + ch_ * 8); rk1 = *(const uint4*)((Kp) + (size_t)(row_ + 32) * 64 + ch_ * 8); \
    rv0 = *(const uint4*)((Vp) + (size_t)row_ * (vstride) + ch_ * 8); rv1 = *(const uint4*)((Vp) + (size_t)(row_ + 32) * (vstride) + ch_ * 8); } while (0)
#define KV_STORE() do { const int tid_ = TIDX; const int so_ = lds_off(tid_ >> 3, tid_ & 7); \
    *(uint4*)(KT + so_) = rk0; *(uint4*)(KT + so_ + 4096) = rk1; *(uint4*)(VT + so_) = rv0; *(uint4*)(VT + so_ + 4096) = rv1; } while (0)
__device__ __forceinline__ void attn_scores(const char* KT, int kfr0, const bf16x8 (&qf)[NQ][2], f32x4 (&S)[4][NQ]) {
#pragma unroll
  for (int mk = 0; mk < 4; ++mk)
#pragma unroll
    for (int nq = 0; nq < NQ; ++nq) S[mk][nq] = (f32x4){0.f, 0.f, 0.f, 0.f};
#pragma unroll
  for (int ks = 0; ks < 2; ++ks) {
    const char* pk = KT + (kfr0 ^ (ks * 64));
#pragma unroll
    for (int mk = 0; mk < 4; ++mk) {
      const bf16x8 kf = *(const bf16x8*)(pk + mk * 2048);
#pragma unroll
      for (int nq = 0; nq < NQ; ++nq) S[mk][nq] = __builtin_amdgcn_mfma_f32_16x16x32_bf16(kf, qf[nq][ks], S[mk][nq], 0, 0, 0);
    }
  }
}
__device__ __forceinline__ void attn_pv(const char* VT, int vfr0, const f32x4 (&S)[4][NQ], f32x4 (&O)[4][NQ]) {
#pragma unroll
  for (int s2 = 0; s2 < 2; ++s2) {
    bf16x8 pf[NQ];
#pragma unroll
    for (int nq = 0; nq < NQ; ++nq) {
      union { uint32_t u[4]; bf16x8 v; } cvt;
      cvt.u[0] = pack2(S[2 * s2][nq][0], S[2 * s2][nq][1]); cvt.u[1] = pack2(S[2 * s2][nq][2], S[2 * s2][nq][3]);
      cvt.u[2] = pack2(S[2 * s2 + 1][nq][0], S[2 * s2 + 1][nq][1]); cvt.u[3] = pack2(S[2 * s2 + 1][nq][2], S[2 * s2 + 1][nq][3]);
      pf[nq] = cvt.v;
    }
    const char* pv0 = VT + (vfr0 ^ (s2 * 64));
    const char* pv1 = VT + (vfr0 ^ (s2 * 64) ^ 32);
#pragma unroll
    for (int md = 0; md < 4; ++md) {
      union { uint2 h[2]; bf16x8 v; } vv;
      vv.h[0] = *(const uint2*)(pv0 + md * 2048);
      vv.h[1] = *(const uint2*)(pv1 + md * 2048);
#pragma unroll
      for (int nq = 0; nq < NQ; ++nq) O[md][nq] = __builtin_amdgcn_mfma_f32_16x16x32_bf16(vv.v, pf[nq], O[md][nq], 0, 0, 0);
    }
  }
}
__device__ __forceinline__ void attn_mask(f32x4 (&S)[4][NQ], int mode, int selbits, int hb, int posbase, int kbase, int l15, int q4) {
#pragma unroll
  for (int nq = 0; nq < NQ; ++nq) {
    const int rr = nq * 16 + l15;
    const bool rs = (selbits >> nq) & 1;
    const int lim = (posbase + rr + 1) >> 5;
#pragma unroll
    for (int mk = 0; mk < 4; ++mk)
#pragma unroll
      for (int r = 0; r < 4; ++r) {
        const int kk = mk * 16 + q4 * 4 + r;
        bool valid = rs;
        if (mode == 1) valid = valid && (kk <= hb + rr);
        else if (mode == 2) valid = valid && (kk > hb + rr);
        else if (mode == 3) valid = valid && (kbase + kk < lim);
        S[mk][nq][r] = valid ? S[mk][nq][r] : NEGBIG;
      }
  }
}
__device__ __forceinline__ void attn_softmax_step(f32x4 (&S)[4][NQ], float (&m)[NQ], float (&l)[NQ], f32x4 (&O)[4][NQ], bool rescale) {
#pragma unroll
  for (int nq = 0; nq < NQ; ++nq) {
    float mx = NEGBIG;
#pragma unroll
    for (int mk = 0; mk < 4; ++mk)
#pragma unroll
      for (int r = 0; r < 4; ++r) mx = fmaxf(mx, S[mk][nq][r]);
    mx = fmaxf(mx, __shfl_xor(mx, 16)); mx = fmaxf(mx, __shfl_xor(mx, 32));
    const float mnew = fmaxf(m[nq], mx);
    const float alpha = __builtin_amdgcn_exp2f(m[nq] - mnew);
    m[nq] = mnew;
    const float muse = fmaxf(mnew, -1e28f);
    float ps = 0.f;
#pragma unroll
    for (int mk = 0; mk < 4; ++mk)
#pragma unroll
      for (int r = 0; r < 4; ++r) {
        const float pv = __builtin_amdgcn_exp2f(S[mk][nq][r] - muse);
        ps += pv; S[mk][nq][r] = pv;
      }
    l[nq] = l[nq] * alpha + ps;
    if (rescale) {
#pragma unroll
      for (int md = 0; md < 4; ++md) O[md][nq] *= alpha;
    }
  }
}
__device__ __forceinline__ void attn_reset(float (&m)[NQ], float (&l)[NQ], f32x4 (&O)[4][NQ]) {
#pragma unroll
  for (int nq = 0; nq < NQ; ++nq) { m[nq] = NEGBIG; l[nq] = 0.f; }
#pragma unroll
  for (int md = 0; md < 4; ++md)
#pragma unroll
    for (int nq = 0; nq < NQ; ++nq) O[md][nq] = (f32x4){0.f, 0.f, 0.f, 0.f};
}

__device__ void attn_unit(const Params& P, int unit, char* smem) {
  const int c32 = 127 - (unit >> 3);
  const int bk = unit & 7, b = bk >> 1, kvh = bk & 1;
  const int c = c32 >> 1, hb = (c32 & 1) * 32, posbase = c32 * 32;
  const int tid = TIDX, lane = tid & 63, g = tid >> 6, l15 = lane & 15, q4 = lane >> 4;
  const int h = kvh * 4 + g;
  const size_t tok0 = (size_t)b * SEQL + posbase;
  char* KT = smem;
  char* VT = smem + 8192;
  float* IMP = (float*)(smem + 16384);
  uint32_t* MASK = (uint32_t*)(smem + 16384 + 32 * 65 * 4);
  float* scratch = (float*)P.hbuf;
  const int sw = (l15 >> 1) & 7;
  const int kfr0 = l15 * 128 + (((q4 ^ (sw & 3)) << 4) | ((sw >> 2) << 6));
  const int vfr0 = l15 * 128 + ((((q4 >> 1) ^ (sw & 1)) | (sw & 6)) << 4) + (q4 & 1) * 8;

  bf16x8 qf[NQ][2];
#pragma unroll
  for (int nq = 0; nq < NQ; ++nq)
#pragma unroll
    for (int ks = 0; ks < 2; ++ks) qf[nq][ks] = *(const bf16x8*)(P.qn + (tok0 + nq * 16 + l15) * 512 + h * 64 + ks * 32 + q4 * 8);

  f32x4 S[4][NQ], O[4][NQ];
  float m[NQ], l[NQ];
  const bf16_t* kcb = P.kc + (size_t)(b * 2 + kvh) * 128 * 64;
  const bf16_t* vcb = P.vcT + (size_t)(b * 2 + kvh) * 64 * 128;
  const int njb = (c32 + 1 + 63) >> 6;
  attn_reset(m, l, O);

  uint4 rk0, rk1, rv0, rv1;
  KV_ISSUE(kcb, vcb, 128);
  for (int jb = 0; jb < njb; ++jb) {
    __syncthreads();
    KV_STORE();
    __syncthreads();
    { const int jn = (jb + 1 < njb) ? jb + 1 : 0; KV_ISSUE(kcb + (size_t)jn * 64 * 64, vcb + jn * 64, 128); }
    __builtin_amdgcn_sched_barrier(0);
    attn_scores(KT, kfr0, qf, S);
    attn_mask(S, 3, 3, hb, posbase, jb * 64, l15, q4);
    attn_softmax_step(S, m, l, O, false);
  }
  float invl[NQ];
#pragma unroll
  for (int nq = 0; nq < NQ; ++nq) { float lt = l[nq]; lt += __shfl_xor(lt, 16); lt += __shfl_xor(lt, 32); invl[nq] = 1.0f / fmaxf(lt, 1e-30f); }
  for (int jb = 0; jb < njb; ++jb) {
    __syncthreads();
    KV_STORE();
    __syncthreads();
    { const int jn = (jb + 1 < njb) ? jb + 1 : jb; KV_ISSUE(kcb + (size_t)jn * 64 * 64, vcb + jn * 64, 128); }
    __builtin_amdgcn_sched_barrier(0);
    attn_scores(KT, kfr0, qf, S);
    attn_mask(S, 3, 3, hb, posbase, jb * 64, l15, q4);
#pragma unroll
    for (int nq = 0; nq < NQ; ++nq)
#pragma unroll
      for (int mk = 0; mk < 4; ++mk)
#pragma unroll
        for (int r = 0; r < 4; ++r) S[mk][nq][r] = __builtin_amdgcn_exp2f(S[mk][nq][r] - fmaxf(m[nq], -1e28f)) * invl[nq];
    for (int gg = 0; gg < 4; ++gg) {
      if (g == gg) {
#pragma unroll
        for (int nq = 0; nq < NQ; ++nq)
#pragma unroll
          for (int mk = 0; mk < 4; ++mk) {
            float* ip = IMP + (nq * 16 + l15) * 65 + jb * 32 + mk * 8 + q4 * 2;
            const float v0 = S[mk][nq][0] + S[mk][nq][1], v1 = S[mk][nq][2] + S[mk][nq][3];
            if (gg == 0) { ip[0] = v0; ip[1] = v1; } else { ip[0] += v0; ip[1] += v1; }
          }
      }
      __syncthreads();
    }
    attn_pv(VT, vfr0, S, O);
  }
#pragma unroll
  for (int nq = 0; nq < NQ; ++nq) {
    const float g0 = sigmoidf_(bf2f(P.z[(tok0 + nq * 16 + l15) * ZLD + ZC_NG + h * 3 + 0]));
#pragma unroll
    for (int md = 0; md < 4; ++md) {
      float4 v; v.x = O[md][nq][0] * g0; v.y = O[md][nq][1] * g0; v.z = O[md][nq][2] * g0; v.w = O[md][nq][3] * g0;
      *(float4*)(scratch + (tok0 + nq * 16 + l15) * LDS_F + h * 64 + md * 16 + q4 * 4) = v;
    }
  }
  __syncthreads();
  for (int i = 0; i < 8; ++i) {
    const int rr = g * 8 + i;
    const float v = IMP[rr * 65 + lane];
    const bool visible = lane <= c;
    const bool forced = (lane == 0) || (lane == c) || (lane == c - 1);
    const float val = forced ? 1e4f : (visible ? v : -INFINITY);
    int rank = 0;
#pragma unroll
    for (int j = 0; j < 64; ++j) {
      const float vj = __int_as_float(__builtin_amdgcn_readlane(__float_as_int(val), j));
      rank += ((vj > val) || (vj == val && j < lane)) ? 1 : 0;
    }
    const bool sel = (rank < 16) && visible;
    const unsigned long long mk = __ballot(sel);
    if (lane == 0) { MASK[rr * 2] = (uint32_t)mk; MASK[rr * 2 + 1] = (uint32_t)(mk >> 32); }
  }
  __syncthreads();
  uint32_t ulo = MASK[(lane & 31) * 2], uhi = MASK[(lane & 31) * 2 + 1];
#pragma unroll
  for (int o = 16; o >= 1; o >>= 1) { ulo |= __shfl_xor(ulo, o); uhi |= __shfl_xor(uhi, o); }
  ulo = __builtin_amdgcn_readfirstlane(ulo); uhi = __builtin_amdgcn_readfirstlane(uhi);
  unsigned long long rem = ((unsigned long long)uhi << 32) | ulo;
  unsigned long long mrow[NQ];
#pragma unroll
  for (int nq = 0; nq < NQ; ++nq) mrow[nq] = ((unsigned long long)MASK[(nq * 16 + l15) * 2 + 1] << 32) | MASK[(nq * 16 + l15) * 2];

  attn_reset(m, l, O);
  {
    const bf16_t* kb = P.ksn + (size_t)(b * 2 + kvh) * SEQL * 64;
    const bf16_t* vb = P.vsT + (size_t)(b * 2 + kvh) * 64 * LDV;
    int j = __builtin_ctzll(rem);
    rem &= rem - 1;
    KV_ISSUE(kb + (size_t)j * 64 * 64, vb + j * 64, LDV);
    for (;;) {
      __syncthreads();
      KV_STORE();
      __syncthreads();
      const bool last = (rem == 0);
      const int jn = last ? j : __builtin_ctzll(rem);
      rem &= rem - 1;
      KV_ISSUE(kb + (size_t)jn * 64 * 64, vb + jn * 64, LDV);
      __builtin_amdgcn_sched_barrier(0);
      attn_scores(KT, kfr0, qf, S);
      int selbits = 0;
#pragma unroll
      for (int nq = 0; nq < NQ; ++nq) selbits |= (int)((mrow[nq] >> j) & 1ull) << nq;
      if (j == c) attn_mask(S, 1, selbits, hb, posbase, 0, l15, q4); else attn_mask(S, 0, selbits, hb, posbase, 0, l15, q4);
      attn_softmax_step(S, m, l, O, true);
      attn_pv(VT, vfr0, S, O);
      if (last) break;
      j = jn;
    }
  }
#pragma unroll
  for (int nq = 0; nq < NQ; ++nq) {
    float lt = l[nq]; lt += __shfl_xor(lt, 16); lt += __shfl_xor(lt, 32);
    const float sc = sigmoidf_(bf2f(P.z[(tok0 + nq * 16 + l15) * ZLD + ZC_NG + h * 3 + 1])) / fmaxf(lt, 1e-30f);
#pragma unroll
    for (int md = 0; md < 4; ++md) {
      float4* p = (float4*)(scratch + (tok0 + nq * 16 + l15) * LDS_F + h * 64 + md * 16 + q4 * 4);
      float4 v = *p;
      v.x += O[md][nq][0] * sc; v.y += O[md][nq][1] * sc; v.z += O[md][nq][2] * sc; v.w += O[md][nq][3] * sc;
      *p = v;
    }
  }
  attn_reset(m, l, O);
  {
    const bf16_t* kb = P.kwn + (size_t)(b * 2 + kvh) * SEQL * 64;
    const bf16_t* vb = P.vwT + (size_t)(b * 2 + kvh) * 64 * LDV;
    const int j0 = (c - 8 > 0) ? (c - 8) : 0;
    KV_ISSUE(kb + (size_t)j0 * 64 * 64, vb + j0 * 64, LDV);
    for (int j = j0; j <= c; ++j) {
      __syncthreads();
      KV_STORE();
      __syncthreads();
      { const int jn = (j < c) ? j + 1 : j; KV_ISSUE(kb + (size_t)jn * 64 * 64, vb + jn * 64, LDV); }
      __builtin_amdgcn_sched_barrier(0);
      attn_scores(KT, kfr0, qf, S);
      if (j == c) attn_mask(S, 1, 3, hb, posbase, 0, l15, q4);
      else if (j == c - 8) attn_mask(S, 2, 3, hb, posbase, 0, l15, q4);
      attn_softmax_step(S, m, l, O, true);
      attn_pv(VT, vfr0, S, O);
    }
  }
#pragma unroll
  for (int nq = 0; nq < NQ; ++nq) {
    float lt = l[nq]; lt += __shfl_xor(lt, 16); lt += __shfl_xor(lt, 32);
    const float sc = sigmoidf_(bf2f(P.z[(tok0 + nq * 16 + l15) * ZLD + ZC_NG + h * 3 + 2])) / fmaxf(lt, 1e-30f);
#pragma unroll
    for (int md = 0; md < 4; ++md) {
      const float4 v = *(const float4*)(scratch + (tok0 + nq * 16 + l15) * LDS_F + h * 64 + md * 16 + q4 * 4);
      uint2 w; w.x = pack2(v.x + O[md][nq][0] * sc, v.y + O[md][nq][1] * sc); w.y = pack2(v.z + O[md][nq][2] * sc, v.w + O[md][nq][3] * sc);
      *(uint2*)(P.ob + (tok0 + nq * 16 + l15) * LD5 + h * 64 + md * 16 + q4 * 4) = w;
    }
  }
}
__device__ void phase_attn_s5(const Params& P, int layer, char* smem, int pass) {
  if (BIDX < 128) { s5_unit(P, layer, BIDX, smem); }
  unsigned* ctr = P.bar + 3600 + (layer * 2 + pass) * 56;
  volatile int* slot = (volatile int*)(smem + 65024);
  for (;;) {
    __syncthreads();
    if (threadIdx.x == 0) *slot = (int)atomicAdd(ctr, 1u);
    __syncthreads();
    const int u = __builtin_amdgcn_readfirstlane(*slot);
    if (u >= 1024) break;
    attn_unit(P, u, smem);
  }
}

#define NPHASE 11
__device__ __forceinline__ void run_phase(const Params& P, int layer, int ph, char* smem, float alpha = 1.0f) {
  switch (ph) {
    case 0: phase_convert(P, layer, smem); phase_cmp_bias(P, layer);
            phase_rmsnorm(layer == 0 ? P.in[0] : P.x, layer == 0 ? P.x : nullptr, P.in[1] + (size_t)layer * DM, P.hbuf); break;
    case 1: phase_gemm_in(P, smem); break;
    case 2: phase_prep(P, layer, smem); break;
    case 3: break;
    case 4: phase_cmp2(P, layer); break;
    case 5: phase_attn_s5(P, layer, smem, alpha == 0.0f ? 1 : 0); break;
    case 6: phase_merge(P, smem); break;
    case 7: phase_gemm_resid(P, P.hbuf, LDH, P.Wt_out, DM, smem, alpha); break;
    case 8: phase_rmsnorm(P.x, nullptr, P.in[21] + (size_t)layer * DM, P.hbuf); break;
    case 9: phase_gemm_gateup(P, smem); break;
    case 10: phase_gemm_resid(P, P.z, LDA, P.Wt_down, DFF, smem, alpha); break;
  }
}

#ifndef REPEAT_MASK
#define REPEAT_MASK 0
#endif
#if !MEGA
__global__ void __launch_bounds__(256, 2) k_phase(Params P, int layer, int ph) {
  __shared__ __attribute__((aligned(16))) char smem[65536];
  run_phase(P, layer, ph, smem);
}
#else
#define XB_TMO      128
#define XB_XCNT(j)  (256  + 64 * (j))
#define XB_XSUB(j)  (1280 + 64 * (j))
#define XB_XGEN(j)  (2304 + 64 * (j))
#define XB_TOP      3328
#define XB_TOPGEN   3392
#define XCD_BAR_WORDS 3456
#define XB_SPIN_CAP (1u << 22)
__device__ __forceinline__ unsigned xb_ld(unsigned* p)              { return __hip_atomic_load(p, __ATOMIC_RELAXED, __HIP_MEMORY_SCOPE_AGENT); }
__device__ __forceinline__ unsigned xb_add(unsigned* p, unsigned v) { return __hip_atomic_fetch_add(p, v, __ATOMIC_RELAXED, __HIP_MEMORY_SCOPE_AGENT); }
__device__ __forceinline__ unsigned xb_xcc_id() { return (unsigned)__builtin_amdgcn_s_getreg((3 << 11) | 20) & 0xFu; }
#define XB_SPIN(cond, bar) do { unsigned _sp = 0; while (cond) { __builtin_amdgcn_s_sleep(1); \
    if ((++_sp & 255u) == 0u) { if (xb_ld(&(bar)[XB_TMO])) break; if (_sp > XB_SPIN_CAP) { atomicAdd(&(bar)[XB_TMO], 1u); break; } } } } while (0)
struct XcdBarrier { unsigned* bar; unsigned x, nloc, nx; };
__device__ __forceinline__ void xcd_barrier_complete(unsigned* bar, unsigned x, unsigned& nloc, unsigned& nx) {
  const unsigned G = gridDim.x;
  unsigned sum, cnt, mine, sp = 0u;
  for (;;) {
    sum = 0u; cnt = 0u; mine = 0u;
#pragma unroll
    for (unsigned j = 0; j < 16; ++j) { const unsigned c = xb_ld(&bar[XB_XCNT(j)]); sum += c; cnt += (c > 0u) ? 1u : 0u; mine = (j == x) ? c : mine; }
    if (sum == G) break;
    __builtin_amdgcn_s_sleep(1);
    if ((++sp & 255u) == 0u) { if (xb_ld(&bar[XB_TMO])) break; if (sp > XB_SPIN_CAP) { atomicAdd(&bar[XB_TMO], 1u); break; } }
  }
  nloc = mine > 0u ? mine : 1u; nx = cnt > 0u ? cnt : 1u;
}
__device__ __forceinline__ void xcd_barrier(const XcdBarrier& b) {
  asm volatile("s_waitcnt vmcnt(0)" ::: "memory");
  __syncthreads();
  if (threadIdx.x == 0) {
    unsigned* bar = b.bar;
    __builtin_amdgcn_s_waitcnt(0);
    const unsigned nloc = b.nloc, nx = b.nx;
    const unsigned old = xb_add(&bar[XB_XSUB(b.x)], 1u);
    const unsigned gen = old / nloc;
    if (old + 1u == (gen + 1u) * nloc) {
      __builtin_amdgcn_fence(__ATOMIC_RELEASE, "agent");
      asm volatile("s_waitcnt vmcnt(0)" ::: "memory");
      const unsigned og = xb_add(&bar[XB_TOP], 1u);
      const unsigned tg = og / nx;
      if (og + 1u == (tg + 1u) * nx) xb_add(&bar[XB_TOPGEN], 1u);
      else XB_SPIN(xb_ld(&bar[XB_TOPGEN]) == tg, bar);
      __builtin_amdgcn_fence(__ATOMIC_ACQUIRE, "agent");
      xb_add(&bar[XB_XGEN(b.x)], 1u);
      asm volatile("s_waitcnt vmcnt(0)" ::: "memory");
    } else {
      XB_SPIN(xb_ld(&bar[XB_XGEN(b.x)]) == gen, bar);
      __builtin_amdgcn_fence(__ATOMIC_ACQUIRE, "agent");
      asm volatile("s_waitcnt vmcnt(0)" ::: "memory");
    }
  }
  __syncthreads();
}

__global__ void __launch_bounds__(256, 2) k_mega(Params P) {
  __shared__ __attribute__((aligned(16))) char smem[65536];
  if (P.x == nullptr) { cg::this_grid().sync(); }
  XcdBarrier xb; xb.bar = P.bar; xb.x = xb_xcc_id(); xb.nloc = 1u; xb.nx = 1u;
  if (threadIdx.x == 0) { (void)xb_add(&P.bar[XB_XCNT(xb.x)], 1u); xcd_barrier_complete(P.bar, xb.x, xb.nloc, xb.nx); }
  for (int layer = 0; layer < DEPTH; ++layer) {
    for (int ph = 0; ph < NPHASE; ++ph) {
      if (ph == 3) continue;
      run_phase(P, layer, ph, smem);
      if ((REPEAT_MASK >> ph) & 1) { xcd_barrier(xb); run_phase(P, layer, ph, smem, 0.0f); }
      if (!(layer == DEPTH - 1 && ph == NPHASE - 1)) xcd_barrier(xb);
    }
  }
}
#endif

extern "C" void kernel_launch(void* const* d_in, const int* in_sizes, int n_in, void* d_out, int out_size, void* d_ws, size_t ws_size, hipStream_t stream) {
  Params P;
  memset(&P, 0, sizeof(P));
  for (int i = 0; i < 24; ++i) P.in[i] = (const float*)d_in[i];
  P.x = (float*)d_out;
  char* w = (char*)d_ws;
  size_t off = 0;
  auto take = [&](size_t bytes) { char* p = w + off; off += (bytes + 255) & ~(size_t)255; return (bf16_t*)p; };
  P.Wt_in = take((size_t)ZLD * LDH * 2);
  P.Wt_glu = take((size_t)2048 * LD5 * 2);
  P.Wt_conv = take((size_t)1024 * LD5 * 2);
  P.Wt_o = take((size_t)1024 * LD5 * 2);
  P.Wt_out = take((size_t)1024 * LDH * 2);
  P.Wt_gu = take((size_t)5632 * LDH * 2);
  P.Wt_down = take((size_t)1024 * LDA * 2);
  P.Wt_c1 = take((size_t)512 * LDC * 2);
  P.z = take((size_t)T_TOK * ZLD * 2);
  P.hbuf = take((size_t)T_TOK * LDH * 2);
  P.ys = take((size_t)T_TOK * LD5 * 2);
  P.cv = take((size_t)T_TOK * LD5 * 2);
  P.ob = take((size_t)T_TOK * LD5 * 2);
  P.qn = take((size_t)T_TOK * 512 * 2);
  P.ksn = take((size_t)T_TOK * 128 * 2);
  P.kwn = take((size_t)T_TOK * 128 * 2);
  P.vsT = take((size_t)8 * 64 * LDV * 2);
  P.vwT = take((size_t)8 * 64 * LDV * 2);
  P.acmp = take((size_t)2 * 1024 * LDC * 2);
  P.hid = take((size_t)2 * 1024 * 256 * 2);
  P.kc = take((size_t)8 * 128 * 64 * 2);
  P.vcT = take((size_t)8 * 64 * 128 * 2);
  P.bar = (unsigned*)take((size_t)4096 * 4);
  P.cbias = (float*)take((size_t)512 * 4);
  if (off > ws_size) { fprintf(stderr, "kernel_launch: workspace too small: need %zu have %zu\n", off, ws_size); return; }
#if MEGA
  static int grid_blocks = 0;
  if (!grid_blocks) {
    int dev = 0, cus = 0, per_cu = 0;
    hipGetDevice(&dev);
    hipDeviceGetAttribute(&cus, hipDeviceAttributeMultiprocessorCount, dev);
    hipOccupancyMaxActiveBlocksPerMultiprocessor(&per_cu, k_mega, 256, 0);
    (void)per_cu;
    grid_blocks = cus * 2;
  }
  hipMemsetAsync(P.bar, 0, 4096 * 4, stream);
  void* args[] = {&P};
  hipError_t e = hipLaunchCooperativeKernel((void*)k_mega, dim3(grid_blocks), dim3(256), args, 0, stream);
  if (e != hipSuccess) fprintf(stderr, "cooperative launch failed: %s (grid %d)\n", hipGetErrorString(e), grid_blocks);
#else
  for (int layer = 0; layer < DEPTH; ++layer)
    for (int ph = 0; ph < NPHASE; ++ph) {
      hipLaunchKernelGGL(k_phase, dim3(512), dim3(256), 0, stream, P, layer, ph);
      if ((REPEAT_MASK >> ph) & 1) hipLaunchKernelGGL(k_phase, dim3(512), dim3(256), 0, stream, P, layer, ph);
    }
#endif
}
```

```cpp
#include <hip/hip_runtime.h>
#include <hip/hip_cooperative_groups.h>
#include <stdint.h>
#include <cstdio>
#include <cstring>
namespace cg = cooperative_groups;

#ifndef MEGA
#define MEGA 1
#endif

typedef unsigned short bf16_t;
typedef short bf16x8 __attribute__((ext_vector_type(8)));
typedef float f32x4 __attribute__((ext_vector_type(4)));

#define T_TOK 16384
#define SEQL 4096
#define DM 1024
#define ZLD 6528
#define NIN 6424
#define DFF 2816
#define DEPTH 4
#define LDH 1088
#define LD5 576
#define LDA 2880
#define LDC 2112
#define LDV 4160
#define LDS_F 544
#define ZC_U 0
#define ZC_CB 512
#define ZC_CC 1024
#define ZC_CX 1536
#define ZC_Q 2048
#define ZC_KC 2560
#define ZC_VC 2688
#define ZC_KS 2816
#define ZC_VS 2944
#define ZC_KW 3072
#define ZC_VW 3200
#define ZC_MIX 3328
#define ZC_NG 6400
#define RMS_EPS 1e-6f

struct Params {
  const float* in[24];
  float* x;
  bf16_t *Wt_in, *Wt_glu, *Wt_conv, *Wt_o, *Wt_out, *Wt_gu, *Wt_down, *Wt_c1;
  bf16_t *z, *hbuf, *ys, *cv, *ob, *qn, *ksn, *kwn, *vsT, *vwT, *acmp, *hid, *kc, *vcT;
  unsigned* bar;
  float* cbias;
};

__device__ __forceinline__ int tidx_() { int t = threadIdx.x; asm volatile("" : "+v"(t)); return t; }
__device__ __forceinline__ int bidx_() { int t = blockIdx.x; asm volatile("" : "+s"(t)); return t; }
#define TIDX tidx_()
#define BIDX bidx_()
__device__ __forceinline__ float bf2f(bf16_t b) { return __uint_as_float(((uint32_t)b) << 16); }
__device__ __forceinline__ uint32_t pack2(float lo, float hi) {
  uint32_t r; asm("v_cvt_pk_bf16_f32 %0, %1, %2" : "=v"(r) : "v"(lo), "v"(hi)); return r;
}
__device__ __forceinline__ float lo2f(uint32_t w) { return __uint_as_float(w << 16); }
__device__ __forceinline__ float hi2f(uint32_t w) { return __uint_as_float(w & 0xffff0000u); }
__device__ __forceinline__ float sigmoidf_(float x) { return __builtin_amdgcn_rcpf(1.0f + __expf(-x)); }
__device__ __forceinline__ float gelu_tanh(float x) { return x * sigmoidf_(1.5957691216f * (x + 0.044715f * x * x * x)); }
__device__ __forceinline__ int lds_off(int row, int ch) { return row * 128 + ((ch ^ ((row >> 1) & 7)) << 4); }

__device__ void conv_job(const float* __restrict__ src, int K, int Nsrc, int col0, int ncols, bf16_t* __restrict__ dst, int drow0, float* lt, int b0, int bs, int mode = 0) {
  const int tid = TIDX;
  const int kt = K >> 6, nt = (ncols + 63) >> 6;
  for (int tile = b0; tile < kt * nt; tile += bs) {
    const int tk = tile % kt, tn = tile / kt;
    const int nl = tid & 63, kl = tid >> 6;
    const int n = tn * 64 + nl;
#pragma unroll
    for (int i = 0; i < 16; ++i) {
      const int k = kl + 4 * i;
      int sc = col0 + n;
      if (mode == 1) { const int t = n >> 7, r = n & 127, wc = r >> 6, nn = (r & 63) >> 4, ii = r & 15; sc = ((nn < 2) ? 0 : DFF) + t * 64 + wc * 32 + (nn & 1) * 16 + ii; }
      float v = (n < ncols) ? src[(size_t)(tk * 64 + k) * Nsrc + sc] : 0.f;
      lt[nl * 65 + k] = v;
    }
    __syncthreads();
    const int k8 = (tid & 7) * 8, n2 = tid >> 3;
#pragma unroll
    for (int i = 0; i < 2; ++i) {
      const int nn = n2 + 32 * i;
      if (tn * 64 + nn < ncols) {
        const float* r = lt + nn * 65 + k8;
        uint4 w;
        w.x = pack2(r[0], r[1]); w.y = pack2(r[2], r[3]); w.z = pack2(r[4], r[5]); w.w = pack2(r[6], r[7]);
        *(uint4*)(dst + (size_t)(drow0 + tn * 64 + nn) * (K + 64) + tk * 64 + k8) = w;
      }
    }
    __syncthreads();
  }
}

__device__ void phase_convert(const Params& P, int layer, char* smem) {
  float* lt = (float*)smem;
  const int b0 = BIDX, bs = gridDim.x;
  const float* w_in = P.in[2] + (size_t)layer * DM * NIN;
  conv_job(w_in, DM, NIN, 0, 3328, P.Wt_in, 0, lt, b0, bs);
  conv_job(w_in, DM, NIN, 3352, 3072, P.Wt_in, ZC_MIX, lt, b0, bs);
  conv_job(w_in, DM, NIN, 3328, 24, P.Wt_in, ZC_NG, lt, b0, bs);
  conv_job(P.in[17] + (size_t)(layer * 2 + 0) * 2048 * 256, 2048, 256, 0, 256, P.Wt_c1, 0, lt, b0, bs);
  conv_job(P.in[17] + (size_t)(layer * 2 + 1) * 2048 * 256, 2048, 256, 0, 256, P.Wt_c1, 256, lt, b0, bs);
}
__device__ void phase_convert_late(const Params& P, int layer, char* smem, int b0, int bs) {
  float* lt = (float*)smem;
  conv_job(P.in[11] + (size_t)layer * 512 * 2048, 512, 2048, 0, 2048, P.Wt_glu, 0, lt, b0, bs);
  conv_job(P.in[13] + (size_t)layer * 512 * 1024, 512, 1024, 0, 1024, P.Wt_conv, 0, lt, b0, bs);
  conv_job(P.in[19] + (size_t)layer * 512 * 1024, 512, 1024, 0, 1024, P.Wt_o, 0, lt, b0, bs);
  conv_job(P.in[20] + (size_t)layer * 1024 * 1024, 1024, 1024, 0, 1024, P.Wt_out, 0, lt, b0, bs);
  conv_job(P.in[22] + (size_t)layer * 1024 * 5632, 1024, 5632, 0, 5632, P.Wt_gu, 0, lt, b0, bs, 1);
  conv_job(P.in[23] + (size_t)layer * DFF * 1024, DFF, 1024, 0, 1024, P.Wt_down, 0, lt, b0, bs);
}

__device__ void phase_rmsnorm(const float* __restrict__ xin, float* __restrict__ xcopy, const float* __restrict__ g, bf16_t* __restrict__ out) {
  const int lane = TIDX & 63, wave = TIDX >> 6;
  for (int tok = BIDX * 4 + wave; tok < T_TOK; tok += gridDim.x * 4) {
    const float4* xr = (const float4*)(xin + (size_t)tok * DM);
    float4 v[4];
    float ss = 0.f;
#pragma unroll
    for (int i = 0; i < 4; ++i) { v[i] = xr[lane + 64 * i]; ss += v[i].x * v[i].x + v[i].y * v[i].y + v[i].z * v[i].z + v[i].w * v[i].w; }
#pragma unroll
    for (int o = 32; o >= 1; o >>= 1) ss += __shfl_xor(ss, o);
    const float r = rsqrtf(ss * (1.0f / DM) + RMS_EPS);
    if (xcopy) {
      float4* xc = (float4*)(xcopy + (size_t)tok * DM);
#pragma unroll
      for (int i = 0; i < 4; ++i) xc[lane + 64 * i] = v[i];
    }
#pragma unroll
    for (int i = 0; i < 4; ++i) {
      const float4 gg = ((const float4*)g)[lane + 64 * i];
      uint2 w; w.x = pack2(v[i].x * r * gg.x, v[i].y * r * gg.y); w.y = pack2(v[i].z * r * gg.z, v[i].w * r * gg.w);
      *(uint2*)(out + (size_t)tok * LDH + (lane + 64 * i) * 4) = w;
    }
  }
}

template <bool A_GATHER = false>
__device__ __forceinline__ void gemm_main(const bf16_t* __restrict__ A, size_t lda, const bf16_t* __restrict__ Bt, int ldb, int K, f32x4 (&acc)[4][4], char* smem, size_t kstepA = 64) {
  const int tid = TIDX, lane = tid & 63, wave = tid >> 6, wr = wave >> 1, wc = wave & 1, l15 = lane & 15, q4 = lane >> 4;
  const int lrow = tid >> 3, lch = tid & 7;
  const bf16_t* ap = A_GATHER ? A : A + (size_t)lrow * lda + lch * 8;
  const bf16_t* bp = Bt + (size_t)lrow * ldb + lch * 8;
  const size_t sa = A_GATHER ? lda : (size_t)32 * lda, sb = (size_t)32 * ldb;
  typedef unsigned u32x4 __attribute__((ext_vector_type(4)));
  u32x4 ra0, ra1, ra2, ra3, rb0, rb1, rb2, rb3;
  u32x4 rc0, rc1, rc2, rc3, rd0, rd1, rd2, rd3;
  int nk = K >> 6;
  asm volatile("" : "+s"(nk));
  const int st_off = lds_off(lrow, lch);
  const int sw = (l15 >> 1) & 7;
  const int fr0 = l15 * 128 + (((q4 ^ (sw & 3)) << 4) | ((sw >> 2) << 6));
  const int a_off = wr * 8192 + fr0, b_off = 16384 + wc * 8192 + fr0;
#ifndef EXP_GL
#define EXP_GL 0
#endif
#ifndef EXP_LDSW
#define EXP_LDSW 0
#endif
#if EXP_GL
#define GLQ const volatile u32x4*
#define GLREP 2
#else
#define GLQ const u32x4*
#define GLREP 1
#endif
#if EXP_LDSW == 1
#define LSQ volatile u32x4*
#define LSREP 2
#else
#define LSQ u32x4*
#define LSREP 1
#endif
#define GLOAD0(AP, BP) do { for (int rep_ = 0; rep_ < GLREP; ++rep_) { ra0 = *(GLQ)(AP); ra1 = *(GLQ)((AP) + sa); ra2 = *(GLQ)((AP) + 2 * sa); ra3 = *(GLQ)((AP) + 3 * sa); \
                            rb0 = *(GLQ)(BP); rb1 = *(GLQ)((BP) + sb); rb2 = *(GLQ)((BP) + 2 * sb); rb3 = *(GLQ)((BP) + 3 * sb); } } while (0)
#define GLOAD1(AP, BP) do { for (int rep_ = 0; rep_ < GLREP; ++rep_) { rc0 = *(GLQ)(AP); rc1 = *(GLQ)((AP) + sa); rc2 = *(GLQ)((AP) + 2 * sa); rc3 = *(GLQ)((AP) + 3 * sa); \
                            rd0 = *(GLQ)(BP); rd1 = *(GLQ)((BP) + sb); rd2 = *(GLQ)((BP) + 2 * sb); rd3 = *(GLQ)((BP) + 3 * sb); } } while (0)
#define XW(P_, V_) asm volatile("ds_write_b128 %0, %1" :: "v"((unsigned)(size_t)(P_)), "v"(V_) : "memory")
#if EXP_LDSW == 2
#define XDUP0(PS) do { XW((PS), ra0); XW((PS) + 4096, ra1); XW((PS) + 8192, ra2); XW((PS) + 12288, ra3); XW((PS) + 16384, rb0); XW((PS) + 20480, rb1); XW((PS) + 24576, rb2); XW((PS) + 28672, rb3); } while (0)
#define XDUP1(PS) do { XW((PS), rc0); XW((PS) + 4096, rc1); XW((PS) + 8192, rc2); XW((PS) + 12288, rc3); XW((PS) + 16384, rd0); XW((PS) + 20480, rd1); XW((PS) + 24576, rd2); XW((PS) + 28672, rd3); } while (0)
#else
#define XDUP0(PS) do { } while (0)
#define XDUP1(PS) do { } while (0)
#endif
#define LSTORE0(PS) do { XDUP0(PS); for (int rep_ = 0; rep_ < LSREP; ++rep_) { *(LSQ)(PS) = ra0; *(LSQ)((PS) + 4096) = ra1; *(LSQ)((PS) + 8192) = ra2; *(LSQ)((PS) + 12288) = ra3; \
                         *(LSQ)((PS) + 16384) = rb0; *(LSQ)((PS) + 20480) = rb1; *(LSQ)((PS) + 24576) = rb2; *(LSQ)((PS) + 28672) = rb3; } } while (0)
#define LSTORE1(PS) do { XDUP1(PS); for (int rep_ = 0; rep_ < LSREP; ++rep_) { *(LSQ)(PS) = rc0; *(LSQ)((PS) + 4096) = rc1; *(LSQ)((PS) + 8192) = rc2; *(LSQ)((PS) + 12288) = rc3; \
                         *(LSQ)((PS) + 16384) = rd0; *(LSQ)((PS) + 20480) = rd1; *(LSQ)((PS) + 24576) = rd2; *(LSQ)((PS) + 28672) = rd3; } } while (0)
#define COMPUTE(BO) do { _Pragma("unroll") for (int ks = 0; ks < 2; ++ks) { \
      bf16x8 af[4], bfr[4]; \
      const char* pa = smem + (BO) + (a_off ^ (ks * 64)); \
      const char* pb = smem + (BO) + (b_off ^ (ks * 64)); \
      _Pragma("unroll") for (int m = 0; m < 4; ++m) af[m] = *(const bf16x8*)(pa + m * 2048); \
      _Pragma("unroll") for (int n = 0; n < 4; ++n) bfr[n] = *(const bf16x8*)(pb + n * 2048); \
      _Pragma("unroll") for (int m = 0; m < 4; ++m) \
        _Pragma("unroll") for (int n = 0; n < 4; ++n) acc[m][n] = __builtin_amdgcn_mfma_f32_16x16x32_bf16(bfr[n], af[m], acc[m][n], 0, 0, 0); } } while (0)
  GLOAD0(ap, bp);
  GLOAD1(ap + kstepA, bp + 64);
  LSTORE0(smem + st_off);
  __syncthreads();
#pragma nounroll
  for (int kt = 0; kt < nk; kt += 2) {
    { const int t2 = (kt + 2 < nk) ? kt + 2 : nk - 1; const bf16_t* ap2 = ap + t2 * kstepA; const bf16_t* bp2 = bp + t2 * 64; GLOAD0(ap2, bp2); }
    __builtin_amdgcn_sched_barrier(0);
    COMPUTE(0);
    LSTORE1(smem + 32768 + st_off);
    __syncthreads();
    { const int t3 = (kt + 3 < nk) ? kt + 3 : nk - 1; const bf16_t* ap2 = ap + t3 * kstepA; const bf16_t* bp2 = bp + t3 * 64; GLOAD1(ap2, bp2); }
    __builtin_amdgcn_sched_barrier(0);
    COMPUTE(32768);
    LSTORE0(smem + st_off);
    __syncthreads();
  }
#undef GLOAD0
#undef GLOAD1
#undef LSTORE0
#undef LSTORE1
#undef COMPUTE
#undef GLQ
#undef LSQ
#undef GLREP
#undef LSREP
}

__device__ __forceinline__ void gemm_main_shallow(const bf16_t* __restrict__ A, int lda, const bf16_t* __restrict__ Bt, int ldb, int K, f32x4 (&acc)[4][4], char* smem) {
  const int tid = TIDX, lane = tid & 63, wave = tid >> 6, wr = wave >> 1, wc = wave & 1, l15 = lane & 15, q4 = lane >> 4;
  const int lrow = tid >> 3, lch = tid & 7;
  const bf16_t* ap = A + (size_t)lrow * lda + lch * 8;
  const bf16_t* bp = Bt + (size_t)lrow * ldb + lch * 8;
  const size_t sa = (size_t)32 * lda, sb = (size_t)32 * ldb;
  uint4 ra0, ra1, ra2, ra3, rb0, rb1, rb2, rb3;
  int nk = K >> 6;
  asm volatile("" : "+s"(nk));
  const int st_off = lds_off(lrow, lch);
  const int sw = (l15 >> 1) & 7;
  const int fr0 = l15 * 128 + (((q4 ^ (sw & 3)) << 4) | ((sw >> 2) << 6));
  const int a_off = wr * 8192 + fr0, b_off = 16384 + wc * 8192 + fr0;
#define GLOAD(AP, BP) do { ra0 = *(const uint4*)(AP); ra1 = *(const uint4*)((AP) + sa); ra2 = *(const uint4*)((AP) + 2 * sa); ra3 = *(const uint4*)((AP) + 3 * sa); \
                           rb0 = *(const uint4*)(BP); rb1 = *(const uint4*)((BP) + sb); rb2 = *(const uint4*)((BP) + 2 * sb); rb3 = *(const uint4*)((BP) + 3 * sb); } while (0)
#define LSTORE(PS) do { *(uint4*)(PS) = ra0; *(uint4*)((PS) + 4096) = ra1; *(uint4*)((PS) + 8192) = ra2; *(uint4*)((PS) + 12288) = ra3; \
                        *(uint4*)((PS) + 16384) = rb0; *(uint4*)((PS) + 20480) = rb1; *(uint4*)((PS) + 24576) = rb2; *(uint4*)((PS) + 28672) = rb3; } while (0)
  GLOAD(ap, bp);
  LSTORE(smem + st_off);
  __syncthreads();
#pragma nounroll
  for (int kt = 0; kt < nk; ++kt) {
    const int bo = (kt & 1) * 32768;
    const bool more = kt + 1 < nk;
    if (more) { const bf16_t* ap2 = ap + (kt + 1) * 64; const bf16_t* bp2 = bp + (kt + 1) * 64; GLOAD(ap2, bp2); }
#pragma unroll
    for (int ks = 0; ks < 2; ++ks) {
      bf16x8 af[4], bfr[4];
      const char* pa = smem + bo + (a_off ^ (ks * 64));
      const char* pb = smem + bo + (b_off ^ (ks * 64));
#pragma unroll
      for (int m = 0; m < 4; ++m) af[m] = *(const bf16x8*)(pa + m * 2048);
#pragma unroll
      for (int n = 0; n < 4; ++n) bfr[n] = *(const bf16x8*)(pb + n * 2048);
#pragma unroll
      for (int m = 0; m < 4; ++m)
#pragma unroll
        for (int n = 0; n < 4; ++n) acc[m][n] = __builtin_amdgcn_mfma_f32_16x16x32_bf16(bfr[n], af[m], acc[m][n], 0, 0, 0);
    }
    if (more) { char* ps = smem + (bo ^ 32768) + st_off; LSTORE(ps); }
    __syncthreads();
  }
#undef GLOAD
#undef LSTORE
}

__device__ __forceinline__ void zero_acc(f32x4 (&acc)[4][4]) {
#pragma unroll
  for (int m = 0; m < 4; ++m)
#pragma unroll
    for (int n = 0; n < 4; ++n) acc[m][n] = (f32x4){0.f, 0.f, 0.f, 0.f};
}
__device__ __forceinline__ bool tile_coords(int u, int nN, int& tm, int& tn) {
  const int xcd = u & 7, loc = u >> 3;
  const int sb = loc >> 6, mi = loc & 7, ni = (loc >> 3) & 7;
  tm = xcd * 16 + (sb & 1) * 8 + mi; tn = (sb >> 1) * 8 + ni;
  return tn < nN;
}
__device__ __forceinline__ int tile_slots(int nN) { return 128 * ((nN + 7) & ~7); }
#define EPI_SETUP const int lane_ = TIDX & 63, wave_ = TIDX >> 6; const int rbase = tm * 128 + (wave_ >> 1) * 64 + (lane_ & 15); const int cbase = tn * 128 + (wave_ & 1) * 64 + (lane_ >> 4) * 4;

__device__ void phase_gemm_in(const Params& P, char* smem) {
  for (int u = BIDX; u < tile_slots(51); u += gridDim.x) {
    int tm, tn; if (!tile_coords(u, 51, tm, tn)) continue;
    f32x4 acc[4][4]; zero_acc(acc);
    gemm_main(P.hbuf + (size_t)tm * 128 * LDH, LDH, P.Wt_in + (size_t)tn * 128 * LDH, LDH, DM, acc, smem);
    EPI_SETUP
    const bool is_gate = (tn >= ZC_MIX / 128) && (tn < ZC_NG / 128);
#pragma unroll
    for (int m = 0; m < 4; ++m)
#pragma unroll
      for (int n = 0; n < 4; ++n) {
        const int row = rbase + m * 16, col = cbase + n * 16;
        f32x4 v = acc[m][n];
        if (is_gate) { v[0] = sigmoidf_(v[0]); v[1] = sigmoidf_(v[1]); v[2] = sigmoidf_(v[2]); v[3] = sigmoidf_(v[3]); }
        uint2 w; w.x = pack2(v[0], v[1]); w.y = pack2(v[2], v[3]);
        *(uint2*)(P.z + (size_t)row * ZLD + col) = w;
      }
  }
}
__device__ void phase_gemm_resid(const Params& P, const bf16_t* A, int lda, const bf16_t* Bt, int K, char* smem, float alpha = 1.0f) {
  for (int u = BIDX; u < tile_slots(8); u += gridDim.x) {
    int tm, tn; if (!tile_coords(u, 8, tm, tn)) continue;
    f32x4 acc[4][4]; zero_acc(acc);
    gemm_main(A + (size_t)tm * 128 * lda, lda, Bt + (size_t)tn * 128 * (K + 64), K + 64, K, acc, smem);
    EPI_SETUP
#pragma unroll
    for (int m = 0; m < 4; ++m)
#pragma unroll
      for (int n = 0; n < 4; ++n) {
        const int row = rbase + m * 16, col = cbase + n * 16;
        float4* p = (float4*)(P.x + (size_t)row * DM + col);
        float4 v = *p;
        v.x += alpha * acc[m][n][0]; v.y += alpha * acc[m][n][1]; v.z += alpha * acc[m][n][2]; v.w += alpha * acc[m][n][3];
        *p = v;
      }
  }
}
__device__ void phase_gemm_gateup(const Params& P, char* smem) {
  bf16_t* act = P.z;
  for (int u = BIDX; u < tile_slots(44); u += gridDim.x) {
    int tm, tn; if (!tile_coords(u, 44, tm, tn)) continue;
    f32x4 acc[4][4]; zero_acc(acc);
    gemm_main(P.hbuf + (size_t)tm * 128 * LDH, LDH, P.Wt_gu + (size_t)tn * 128 * LDH, LDH, DM, acc, smem);
    const int lane_ = TIDX & 63, wave_ = TIDX >> 6;
    const int rbase = tm * 128 + (wave_ >> 1) * 64 + (lane_ & 15);
    const int cbase = tn * 64 + (wave_ & 1) * 32 + (lane_ >> 4) * 4;
#pragma unroll
    for (int m = 0; m < 4; ++m)
#pragma unroll
      for (int n = 0; n < 2; ++n) {
        const int row = rbase + m * 16, col = cbase + n * 16;
        float o[4];
#pragma unroll
        for (int r = 0; r < 4; ++r) { const float gq = acc[m][n][r]; o[r] = gq * sigmoidf_(gq) * acc[m][n + 2][r]; }
        uint2 w; w.x = pack2(o[0], o[1]); w.y = pack2(o[2], o[3]);
        *(uint2*)(act + (size_t)row * LDA + col) = w;
      }
  }
}
__device__ void phase_gemm_cmp1(const Params& P, char* smem, int u0, int ustride) {
  for (int u = u0; u < 32; u += ustride) {
    const int which = u >> 4, rem = u & 15, tm = rem & 7, tn = rem >> 3;
    f32x4 acc[4][4]; zero_acc(acc);
    const int tid = TIDX, lrow = tid >> 3, lch = tid & 7;
    const bf16_t* ap = P.z + ((size_t)(tm * 64 + (lrow >> 1)) * 32) * ZLD + (which ? ZC_VC : ZC_KC) + (lrow & 1) * 64 + lch * 8;
    gemm_main<true>(ap, (size_t)512 * ZLD, P.Wt_c1 + (size_t)which * 256 * LDC + (size_t)tn * 128 * LDC, LDC, 2048, acc, smem, (size_t)ZLD);
    EPI_SETUP
#pragma unroll
    for (int m = 0; m < 4; ++m)
#pragma unroll
      for (int n = 0; n < 4; ++n) {
        const int row = rbase + m * 16, col = cbase + n * 16;
        const float4 bb = *(const float4*)(P.cbias + which * 256 + col);
        uint2 w; w.x = pack2(gelu_tanh(acc[m][n][0] + bb.x), gelu_tanh(acc[m][n][1] + bb.y)); w.y = pack2(gelu_tanh(acc[m][n][2] + bb.z), gelu_tanh(acc[m][n][3] + bb.w));
        *(uint2*)(P.hid + (size_t)which * 1024 * 256 + (size_t)row * 256 + col) = w;
      }
  }
}
__device__ void phase_cmp_bias(const Params& P, int layer) {
  const int lane = TIDX & 63, wave = TIDX >> 6;
  for (int o = BIDX * 4 + wave; o < 512; o += gridDim.x * 4) {
    const int which = o >> 8, col = o & 255;
    const float* pe = P.in[16] + (size_t)(layer * 2 + which) * 2048;
    const float* w1 = P.in[17] + (size_t)(layer * 2 + which) * 2048 * 256 + col;
    float acc = 0.f;
    for (int k = lane; k < 2048; k += 64) acc += pe[k] * w1[(size_t)k * 256];
#pragma unroll
    for (int o2 = 32; o2 >= 1; o2 >>= 1) acc += __shfl_xor(acc, o2);
    if (lane == 0) P.cbias[o] = acc;
  }
}
__device__ void phase_merge(const Params& P, char* smem) {
  for (int u = BIDX; u < tile_slots(8); u += gridDim.x) {
    int tm, tn; if (!tile_coords(u, 8, tm, tn)) continue;
    EPI_SETUP
    const unsigned eoff = (unsigned)rbase * ZLD + (unsigned)cbase;
    const unsigned hoff = (unsigned)rbase * LDH + (unsigned)cbase;
    {
      f32x4 a0[4][4], a1[4][4]; zero_acc(a0); zero_acc(a1);
      gemm_main_shallow(P.ys + (size_t)tm * 128 * LD5, LD5, P.Wt_glu + (size_t)tn * 128 * LD5, LD5, 512, a0, smem);
      gemm_main_shallow(P.ys + (size_t)tm * 128 * LD5, LD5, P.Wt_glu + (size_t)(1024 + tn * 128) * LD5, LD5, 512, a1, smem);
      const bf16_t* zg = P.z + ZC_MIX;
#pragma unroll
      for (int m = 0; m < 4; ++m)
#pragma unroll
        for (int n = 0; n < 4; ++n) {
          const uint2 gw = *(const uint2*)(zg + (eoff + (unsigned)(m * 16 * ZLD + n * 16)));
          uint2 w;
          w.x = pack2(lo2f(gw.x) * a0[m][n][0] * sigmoidf_(a1[m][n][0]), hi2f(gw.x) * a0[m][n][1] * sigmoidf_(a1[m][n][1]));
          w.y = pack2(lo2f(gw.y) * a0[m][n][2] * sigmoidf_(a1[m][n][2]), hi2f(gw.y) * a0[m][n][3] * sigmoidf_(a1[m][n][3]));
          *(uint2*)(P.hbuf + (hoff + (unsigned)(m * 16 * LDH + n * 16))) = w;
        }
    }
    int nbr = 3;
    asm volatile("" : "+s"(nbr));
    for (int br = 1; br < nbr; ++br) {
      f32x4 a1[4][4]; zero_acc(a1);
      const bf16_t* A = (br == 1) ? P.cv : P.ob;
      const bf16_t* B = (br == 1) ? P.Wt_conv : P.Wt_o;
      gemm_main_shallow(A + (size_t)tm * 128 * LD5, LD5, B + (size_t)tn * 128 * LD5, LD5, 512, a1, smem);
      const bf16_t* zg = P.z + ZC_MIX + br * 1024;
#pragma unroll
      for (int m = 0; m < 4; ++m)
#pragma unroll
        for (int n = 0; n < 4; ++n) {
          const uint2 gw = *(const uint2*)(zg + (eoff + (unsigned)(m * 16 * ZLD + n * 16)));
          uint2* hp = (uint2*)(P.hbuf + (hoff + (unsigned)(m * 16 * LDH + n * 16)));
          const uint2 hv = *hp;
          uint2 w;
          w.x = pack2(lo2f(hv.x) + lo2f(gw.x) * a1[m][n][0], hi2f(hv.x) + hi2f(gw.x) * a1[m][n][1]);
          w.y = pack2(lo2f(hv.y) + lo2f(gw.y) * a1[m][n][2], hi2f(hv.y) + hi2f(gw.y) * a1[m][n][3]);
          *hp = w;
        }
    }
  }
}

__device__ void s5_unit(const Params& P, int layer, int unit, char* smem) {
  const int b = unit >> 5, g = unit & 31;
  const int tid = TIDX, lane = tid & 63, w = tid >> 6, l15 = lane & 15, q4 = lane >> 4;
  const int p = lane, q = w;
  float* bu = (float*)smem;
  bf16_t* stb = (bf16_t*)(smem + 33280);
  float2* send = (float2*)(smem + 33280 + 17408);
  bf16_t* usb = (bf16_t*)(smem + 33280 + 17408 + 2048);
  const float* lam_re = P.in[3] + (size_t)layer * 32 * 64 + g * 64, *lam_im = P.in[4] + (size_t)layer * 32 * 64 + g * 64;
  const float* b_re = P.in[5] + ((size_t)layer * 32 + g) * 64 * 16, *b_im = P.in[6] + ((size_t)layer * 32 + g) * 64 * 16;
  const float* c_re = P.in[7] + ((size_t)layer * 32 + g) * 16 * 64, *c_im = P.in[8] + ((size_t)layer * 32 + g) * 16 * 64;
  const float dk = P.in[9][(size_t)layer * 512 + g * 16 + l15];
  const float dt = expf(P.in[10][layer * 32 + g]);
  float lbr, lbi, l16r, l16i;
  {
    const float lr = lam_re[p], li = lam_im[p];
    float sn, cs_; sincosf(li * dt, &sn, &cs_);
    const float e = expf(lr * dt);
    lbr = e * cs_; lbi = e * sn;
    l16r = lbr; l16i = lbi;
#pragma unroll
    for (int i = 0; i < 4; ++i) { const float tr = l16r * l16r - l16i * l16i, ti = 2.f * l16r * l16i; l16r = tr; l16i = ti; }
  }
  bf16x8 bB[2];
#pragma unroll
  for (int nt = 0; nt < 2; ++nt) {
    const int pp = (2 * w + nt) * 16 + l15, ps = pp >> 1, cpl = pp & 1;
    const float lr = lam_re[ps], li = lam_im[ps];
    float sn, cs_; sincosf(li * dt, &sn, &cs_);
    const float e = expf(lr * dt);
    const float nr = e * cs_ - 1.0f, ni = e * sn, den = lr * lr + li * li;
    const float cfr = (nr * lr + ni * li) / den, cfi = (ni * lr - nr * li) / den;
    float v[8];
#pragma unroll
    for (int j = 0; j < 8; ++j) {
      const int h = (q4 & 1) * 8 + j;
      const float br = b_re[ps * 16 + h], bi = b_im[ps * 16 + h];
      const float val = cpl ? (cfr * bi + cfi * br) : (cfr * br - cfi * bi);
      v[j] = (q4 < 2) ? val : 0.f;
    }
    union { uint32_t u[4]; bf16x8 x; } cv; cv.u[0] = pack2(v[0], v[1]); cv.u[1] = pack2(v[2], v[3]); cv.u[2] = pack2(v[4], v[5]); cv.u[3] = pack2(v[6], v[7]);
    bB[nt] = cv.x;
  }
  bf16x8 cB[4];
#pragma unroll
  for (int ks = 0; ks < 4; ++ks) {
    float v[8];
#pragma unroll
    for (int j = 0; j < 8; ++j) {
      const int pp = ks * 32 + q4 * 8 + j, ps = pp >> 1;
      v[j] = (pp & 1) ? -c_im[l15 * 64 + ps] : c_re[l15 * 64 + ps];
    }
    union { uint32_t u[4]; bf16x8 x; } cv; cv.u[0] = pack2(v[0], v[1]); cv.u[1] = pack2(v[2], v[3]); cv.u[2] = pack2(v[4], v[5]); cv.u[3] = pack2(v[6], v[7]);
    cB[ks] = cv.x;
  }
  float car_r = 0.f, car_i = 0.f;
  bf16x8 un0, un1, un2, un3;
  {
    const bf16_t* zp = P.z + ((size_t)b * SEQL + l15) * ZLD + ZC_U + g * 16 + (q4 & 1) * 8;
    un0 = *(const bf16x8*)(zp); un1 = *(const bf16x8*)(zp + (size_t)16 * ZLD); un2 = *(const bf16x8*)(zp + (size_t)32 * ZLD); un3 = *(const bf16x8*)(zp + (size_t)48 * ZLD);
  }
  for (int chunk = 0; chunk < 64; ++chunk) {
    const size_t tok0 = (size_t)b * SEQL + chunk * 64;
    {
      bf16x8 ua[4];
      const bf16x8 zz = (bf16x8){0, 0, 0, 0, 0, 0, 0, 0};
      ua[0] = (q4 < 2) ? un0 : zz; ua[1] = (q4 < 2) ? un1 : zz; ua[2] = (q4 < 2) ? un2 : zz; ua[3] = (q4 < 2) ? un3 : zz;
      if (w == 0 && q4 < 2) {
#pragma unroll
        for (int mt = 0; mt < 4; ++mt) *(bf16x8*)(usb + (chunk & 1) * 1024 + (mt * 16 + l15) * 16 + q4 * 8) = ua[mt];
      }
      if (chunk + 1 < 64) {
        const bf16_t* zp = P.z + (tok0 + 64 + l15) * ZLD + ZC_U + g * 16 + (q4 & 1) * 8;
        un0 = *(const bf16x8*)(zp); un1 = *(const bf16x8*)(zp + (size_t)16 * ZLD); un2 = *(const bf16x8*)(zp + (size_t)32 * ZLD); un3 = *(const bf16x8*)(zp + (size_t)48 * ZLD);
      }
#pragma unroll
      for (int mt = 0; mt < 4; ++mt)
#pragma unroll
        for (int nt = 0; nt < 2; ++nt) {
          const f32x4 acc = __builtin_amdgcn_mfma_f32_16x16x32_bf16(ua[mt], bB[nt], (f32x4){0.f, 0.f, 0.f, 0.f}, 0, 0, 0);
          float* dst = bu + (mt * 16 + q4 * 4) * 130 + (2 * w + nt) * 16 + l15;
          dst[0] = acc[0]; dst[130] = acc[1]; dst[260] = acc[2]; dst[390] = acc[3];
        }
    }
    __syncthreads();
    float locr[16], loci[16];
    float sr = 0.f, si = 0.f;
#pragma unroll
    for (int i = 0; i < 16; ++i) {
      const float2 v = *(const float2*)(bu + (q * 16 + i) * 130 + 2 * p);
      const float nsr = lbr * sr - lbi * si + v.x, nsi = lbr * si + lbi * sr + v.y;
      sr = nsr; si = nsi; locr[i] = sr; loci[i] = si;
    }
    send[q * 64 + p] = make_float2(sr, si);
    __syncthreads();
    float cur_r = car_r, cur_i = car_i, mine_r = 0.f, mine_i = 0.f;
#pragma unroll
    for (int qq = 0; qq < 4; ++qq) {
      if (qq == q) { mine_r = cur_r; mine_i = cur_i; }
      const float2 ev = send[qq * 64 + p];
      const float tr = l16r * cur_r - l16i * cur_i + ev.x, ti = l16r * cur_i + l16i * cur_r + ev.y;
      cur_r = tr; cur_i = ti;
    }
    car_r = cur_r; car_i = cur_i;
    float cpr = lbr * mine_r - lbi * mine_i, cpi = lbr * mine_i + lbi * mine_r;
#pragma unroll
    for (int i = 0; i < 16; ++i) {
      *(uint32_t*)(stb + (q * 16 + i) * 136 + 2 * p) = pack2(locr[i] + cpr, loci[i] + cpi);
      const float tr = lbr * cpr - lbi * cpi, ti = lbr * cpi + lbi * cpr;
      cpr = tr; cpi = ti;
    }
    __syncthreads();
    {
      f32x4 acc = (f32x4){0.f, 0.f, 0.f, 0.f};
#pragma unroll
      for (int ks = 0; ks < 4; ++ks) {
        const bf16x8 as = *(const bf16x8*)(stb + (w * 16 + l15) * 136 + ks * 32 + q4 * 8);
        acc = __builtin_amdgcn_mfma_f32_16x16x32_bf16(as, cB[ks], acc, 0, 0, 0);
      }
#pragma unroll
      for (int r = 0; r < 4; ++r) {
        const size_t t = tok0 + w * 16 + q4 * 4 + r;
        const float uval = bf2f(usb[(chunk & 1) * 1024 + (w * 16 + q4 * 4 + r) * 16 + l15]);
        const float y = gelu_tanh(acc[r] + dk * uval);
        P.ys[t * LD5 + g * 16 + l15] = (bf16_t)(pack2(y, 0.f) & 0xffffu);
      }
    }
  }
}

__device__ __forceinline__ void load8(const bf16_t* p, float (&f)[8]) {
  const uint4 w = *(const uint4*)p;
  f[0] = lo2f(w.x); f[1] = hi2f(w.x); f[2] = lo2f(w.y); f[3] = hi2f(w.y); f[4] = lo2f(w.z); f[5] = hi2f(w.z); f[6] = lo2f(w.w); f[7] = hi2f(w.w);
}
__device__ __forceinline__ void store8(bf16_t* p, const float (&f)[8]) {
  uint4 w; w.x = pack2(f[0], f[1]); w.y = pack2(f[2], f[3]); w.z = pack2(f[4], f[5]); w.w = pack2(f[6], f[7]);
  *(uint4*)p = w;
}
__device__ void prep_unit(const Params& P, int layer, int ck, char* smem) {
  const int tid = TIDX;
  const int tok0 = ck * 64, b = tok0 >> 12, s0 = tok0 & 4095;
  const bf16_t* z = P.z;
  {
    const float* cw = P.in[12] + (size_t)layer * 3 * 512;
    const int c2 = tid * 2;
    const float w00 = cw[c2], w01 = cw[c2 + 1], w10 = cw[512 + c2], w11 = cw[512 + c2 + 1], w20 = cw[1024 + c2], w21 = cw[1024 + c2 + 1];
    float p2a = 0.f, p2b = 0.f, p1a = 0.f, p1b = 0.f;
    if (s0 >= 2) {
      const uint32_t cc2 = *(const uint32_t*)(z + (size_t)(tok0 - 2) * ZLD + ZC_CC + c2), cx2 = *(const uint32_t*)(z + (size_t)(tok0 - 2) * ZLD + ZC_CX + c2);
      const uint32_t cc1 = *(const uint32_t*)(z + (size_t)(tok0 - 1) * ZLD + ZC_CC + c2), cx1 = *(const uint32_t*)(z + (size_t)(tok0 - 1) * ZLD + ZC_CX + c2);
      p2a = lo2f(cc2) * lo2f(cx2); p2b = hi2f(cc2) * hi2f(cx2); p1a = lo2f(cc1) * lo2f(cx1); p1b = hi2f(cc1) * hi2f(cx1);
    }
#pragma unroll 4
    for (int t = 0; t < 64; ++t) {
      const size_t ro = (size_t)(tok0 + t) * ZLD;
      const uint32_t cb = *(const uint32_t*)(z + ro + ZC_CB + c2), cc = *(const uint32_t*)(z + ro + ZC_CC + c2), cx = *(const uint32_t*)(z + ro + ZC_CX + c2);
      const float p0a = lo2f(cc) * lo2f(cx), p0b = hi2f(cc) * hi2f(cx);
      const float oa = lo2f(cb) * (w00 * p2a + w10 * p1a + w20 * p0a), ob_ = hi2f(cb) * (w01 * p2b + w11 * p1b + w21 * p0b);
      *(uint32_t*)(P.cv + (size_t)(tok0 + t) * LD5 + c2) = pack2(oa, ob_);
      p2a = p1a; p2b = p1b; p1a = p0a; p1b = p0b;
    }
  }
  {
    const float* qg = P.in[14] + (size_t)layer * 64;
    const int d8 = (tid & 7) * 8;
    float gq[8];
#pragma unroll
    for (int j = 0; j < 8; ++j) gq[j] = qg[d8 + j] * (0.125f * 1.44269504089f);
#pragma unroll 2
    for (int it = 0; it < 16; ++it) {
      const int row = it * 32 + (tid >> 3), t = row >> 3, h = row & 7;
      float f[8]; load8(z + (size_t)(tok0 + t) * ZLD + ZC_Q + h * 64 + d8, f);
      float ss = 0.f;
#pragma unroll
      for (int j = 0; j < 8; ++j) ss += f[j] * f[j];
      ss += __shfl_xor(ss, 1); ss += __shfl_xor(ss, 2); ss += __shfl_xor(ss, 4);
      const float r = rsqrtf(ss * (1.0f / 64.f) + RMS_EPS);
#pragma unroll
      for (int j = 0; j < 8; ++j) f[j] = f[j] * r * gq[j];
      store8(P.qn + (size_t)(tok0 + t) * 512 + h * 64 + d8, f);
    }
  }
  {
    const float* kg = P.in[15] + (size_t)layer * 3 * 64;
    const int d8 = (tid & 7) * 8;
#pragma unroll 2
    for (int it = 0; it < 8; ++it) {
      const int row = it * 32 + (tid >> 3), which = row >> 7, t = (row >> 1) & 63, kvh = row & 1;
      float f[8]; load8(z + (size_t)(tok0 + t) * ZLD + (which ? ZC_KW : ZC_KS) + kvh * 64 + d8, f);
      float ss = 0.f;
#pragma unroll
      for (int j = 0; j < 8; ++j) ss += f[j] * f[j];
      ss += __shfl_xor(ss, 1); ss += __shfl_xor(ss, 2); ss += __shfl_xor(ss, 4);
      const float r = rsqrtf(ss * (1.0f / 64.f) + RMS_EPS);
#pragma unroll
      for (int j = 0; j < 8; ++j) f[j] = f[j] * r * kg[(1 + which) * 64 + d8 + j];
      bf16_t* dst = (which ? P.kwn : P.ksn) + ((size_t)(b * 2 + kvh) * SEQL + s0 + t) * 64 + d8;
      store8(dst, f);
    }
  }
  {
    bf16_t* lt = (bf16_t*)smem;
    for (int which = 0; which < 2; ++which) {
      __syncthreads();
      {
        const int c8 = (tid & 15) * 8;
#pragma unroll
        for (int it = 0; it < 4; ++it) {
          const int t = it * 16 + (tid >> 4);
          const uint4 w = *(const uint4*)(z + (size_t)(tok0 + t) * ZLD + (which ? ZC_VW : ZC_VS) + c8);
          uint32_t* d = (uint32_t*)(lt + t * 130 + c8);
          d[0] = w.x; d[1] = w.y; d[2] = w.z; d[3] = w.w;
        }
      }
      __syncthreads();
      const int lane = tid & 63, wave = tid >> 6;
      bf16_t* dstb = which ? P.vwT : P.vsT;
#pragma unroll 4
      for (int it = 0; it < 32; ++it) {
        const int row = it * 4 + wave;
        dstb[((size_t)(b * 2) * 64 + row) * LDV + s0 + lane] = lt[lane * 130 + row];
      }
    }
  }
}
__device__ void phase_prep(const Params& P, int layer, char* smem) {
  const int bid = BIDX;
  if (bid < 32) phase_gemm_cmp1(P, smem, bid, 32);
  else if (bid < 288) { prep_unit(P, layer, bid - 32, smem); }
  else phase_convert_late(P, layer, smem, bid - 288, gridDim.x - 288);
}

__device__ void phase_cmp2(const Params& P, int layer) {
  const int lane = TIDX & 63, wave = TIDX >> 6;
  for (int wu = BIDX * 4 + wave; wu < 2048; wu += gridDim.x * 4) {
    const int which = wu >> 10, row = wu & 1023;
    const float* w2 = P.in[18] + (size_t)(layer * 2 + which) * 256 * 64;
    const bf16_t* hr = P.hid + (size_t)which * 1024 * 256 + (size_t)row * 256;
    float acc = 0.f;
#pragma unroll 8
    for (int k = 0; k < 256; ++k) acc += bf2f(hr[k]) * w2[k * 64 + lane];
    const int kvh = row & 1, bc = row >> 1, b = bc >> 7, c = bc & 127;
    if (which == 0) {
      float ss = acc * acc;
#pragma unroll
      for (int o = 32; o >= 1; o >>= 1) ss += __shfl_xor(ss, o);
      const float r = rsqrtf(ss * (1.0f / 64.f) + RMS_EPS);
      const float v = acc * r * P.in[15][(size_t)layer * 3 * 64 + lane];
      P.kc[((size_t)(b * 2 + kvh) * 128 + c) * 64 + lane] = (bf16_t)(pack2(v, 0.f) & 0xffff);
    } else {
      P.vcT[((size_t)(b * 2 + kvh) * 64 + lane) * 128 + c] = (bf16_t)(pack2(acc, 0.f) & 0xffff);
    }
  }
}

#define NEGBIG (-1e30f)
#define NQ 2
__device__ __forceinline__ void attn_load_tiles(const bf16_t* __restrict__ Kp, const bf16_t* __restrict__ Vp, int vstride, char* KT, char* VT) {
  const int tid = TIDX;
  const int row = tid >> 3, ch = tid & 7;
  const int so = lds_off(row, ch);
  const uint4 k0 = *(const uint4*)(Kp + (size_t)row * 64 + ch * 8), k1 = *(const uint4*)(Kp + (size_t)(row + 32) * 64 + ch * 8);
  const uint4 v0 = *(const uint4*)(Vp + (size_t)row * vstride + ch * 8), v1 = *(const uint4*)(Vp + (size_t)(row + 32) * vstride + ch * 8);
  *(uint4*)(KT + so) = k0; *(uint4*)(KT + so + 4096) = k1;
  *(uint4*)(VT + so) = v0; *(uint4*)(VT + so + 4096) = v1;
}
#define KV_ISSUE(Kp, Vp, vstride) do { const int tid_ = TIDX; const int row_ = tid_ >> 3, ch_ = tid_ & 7; \
    rk0 = *(const uint4*)((Kp) + (size_t)row_ * 64 + ch_ * 8); rk1 = *(const uint4*)((Kp) + (size_t)(row_ + 32) * 64 + ch_ * 8); \
    rv0 = *(const uint4*)((Vp) + (size_t)row_ * (vstride) + ch_ * 8); rv1 = *(const uint4*)((Vp) + (size_t)(row_ + 32) * (vstride) + ch_ * 8); } while (0)
#define KV_STORE() do { const int tid_ = TIDX; const int so_ = lds_off(tid_ >> 3, tid_ & 7); \
    *(uint4*)(KT + so_) = rk0; *(uint4*)(KT + so_ + 4096) = rk1; *(uint4*)(VT + so_) = rv0; *(uint4*)(VT + so_ + 4096) = rv1; } while (0)
__device__ __forceinline__ void attn_scores(const char* KT, int kfr0, const bf16x8 (&qf)[NQ][2], f32x4 (&S)[4][NQ]) {
#pragma unroll
  for (int mk = 0; mk < 4; ++mk)
#pragma unroll
    for (int nq = 0; nq < NQ; ++nq) S[mk][nq] = (f32x4){0.f, 0.f, 0.f, 0.f};
#pragma unroll
  for (int ks = 0; ks < 2; ++ks) {
    const char* pk = KT + (kfr0 ^ (ks * 64));
#pragma unroll
    for (int mk = 0; mk < 4; ++mk) {
      const bf16x8 kf = *(const bf16x8*)(pk + mk * 2048);
#pragma unroll
      for (int nq = 0; nq < NQ; ++nq) S[mk][nq] = __builtin_amdgcn_mfma_f32_16x16x32_bf16(kf, qf[nq][ks], S[mk][nq], 0, 0, 0);
    }
  }
}
__device__ __forceinline__ void attn_pv(const char* VT, int vfr0, const f32x4 (&S)[4][NQ], f32x4 (&O)[4][NQ]) {
#pragma unroll
  for (int s2 = 0; s2 < 2; ++s2) {
    bf16x8 pf[NQ];
#pragma unroll
    for (int nq = 0; nq < NQ; ++nq) {
      union { uint32_t u[4]; bf16x8 v; } cvt;
      cvt.u[0] = pack2(S[2 * s2][nq][0], S[2 * s2][nq][1]); cvt.u[1] = pack2(S[2 * s2][nq][2], S[2 * s2][nq][3]);
      cvt.u[2] = pack2(S[2 * s2 + 1][nq][0], S[2 * s2 + 1][nq][1]); cvt.u[3] = pack2(S[2 * s2 + 1][nq][2], S[2 * s2 + 1][nq][3]);
      pf[nq] = cvt.v;
    }
    const char* pv0 = VT + (vfr0 ^ (s2 * 64));
    const char* pv1 = VT + (vfr0 ^ (s2 * 64) ^ 32);
#pragma unroll
    for (int md = 0; md < 4; ++md) {
      union { uint2 h[2]; bf16x8 v; } vv;
      vv.h[0] = *(const uint2*)(pv0 + md * 2048);
      vv.h[1] = *(const uint2*)(pv1 + md * 2048);
#pragma unroll
      for (int nq = 0; nq < NQ; ++nq) O[md][nq] = __builtin_amdgcn_mfma_f32_16x16x32_bf16(vv.v, pf[nq], O[md][nq], 0, 0, 0);
    }
  }
}
__device__ __forceinline__ void attn_mask(f32x4 (&S)[4][NQ], int mode, int selbits, int hb, int posbase, int kbase, int l15, int q4) {
#pragma unroll
  for (int nq = 0; nq < NQ; ++nq) {
    const int rr = nq * 16 + l15;
    const bool rs = (selbits >> nq) & 1;
    const int lim = (posbase + rr + 1) >> 5;
#pragma unroll
    for (int mk = 0; mk < 4; ++mk)
#pragma unroll
      for (int r = 0; r < 4; ++r) {
        const int kk = mk * 16 + q4 * 4 + r;
        bool valid = rs;
        if (mode == 1) valid = valid && (kk <= hb + rr);
        else if (mode == 2) valid = valid && (kk > hb + rr);
        else if (mode == 3) valid = valid && (kbase + kk < lim);
        S[mk][nq][r] = valid ? S[mk][nq][r] : NEGBIG;
      }
  }
}
__device__ __forceinline__ void attn_softmax_step(f32x4 (&S)[4][NQ], float (&m)[NQ], float (&l)[NQ], f32x4 (&O)[4][NQ], bool rescale) {
#pragma unroll
  for (int nq = 0; nq < NQ; ++nq) {
    float mx = NEGBIG;
#pragma unroll
    for (int mk = 0; mk < 4; ++mk)
#pragma unroll
      for (int r = 0; r < 4; ++r) mx = fmaxf(mx, S[mk][nq][r]);
    mx = fmaxf(mx, __shfl_xor(mx, 16)); mx = fmaxf(mx, __shfl_xor(mx, 32));
    const float mnew = fmaxf(m[nq], mx);
    const float alpha = __builtin_amdgcn_exp2f(m[nq] - mnew);
    m[nq] = mnew;
    const float muse = fmaxf(mnew, -1e28f);
    float ps = 0.f;
#pragma unroll
    for (int mk = 0; mk < 4; ++mk)
#pragma unroll
      for (int r = 0; r < 4; ++r) {
        const float pv = __builtin_amdgcn_exp2f(S[mk][nq][r] - muse);
        ps += pv; S[mk][nq][r] = pv;
      }
    l[nq] = l[nq] * alpha + ps;
    if (rescale && __ballot(alpha != 1.0f) != 0ull) {
#pragma unroll
      for (int md = 0; md < 4; ++md) O[md][nq] *= alpha;
    }
  }
}
__device__ __forceinline__ void attn_reset(float (&m)[NQ], float (&l)[NQ], f32x4 (&O)[4][NQ]) {
#pragma unroll
  for (int nq = 0; nq < NQ; ++nq) { m[nq] = NEGBIG; l[nq] = 0.f; }
#pragma unroll
  for (int md = 0; md < 4; ++md)
#pragma unroll
    for (int nq = 0; nq < NQ; ++nq) O[md][nq] = (f32x4){0.f, 0.f, 0.f, 0.f};
}

__device__ void attn_unit(const Params& P, int unit, char* smem) {
  const int c32 = 127 - (unit >> 3);
  const int bk = unit & 7, b = bk >> 1, kvh = bk & 1;
  const int c = c32 >> 1, hb = (c32 & 1) * 32, posbase = c32 * 32;
  const int tid = TIDX, lane = tid & 63, g = tid >> 6, l15 = lane & 15, q4 = lane >> 4;
  const int h = kvh * 4 + g;
  const size_t tok0 = (size_t)b * SEQL + posbase;
  char* KT = smem;
  char* VT = smem + 8192;
  float* IMP = (float*)(smem + 16384);
  uint32_t* MASK = (uint32_t*)(smem + 16384 + 32 * 65 * 4);
  float* scratch = (float*)P.hbuf;
  const int sw = (l15 >> 1) & 7;
  const int kfr0 = l15 * 128 + (((q4 ^ (sw & 3)) << 4) | ((sw >> 2) << 6));
  const int vfr0 = l15 * 128 + ((((q4 >> 1) ^ (sw & 1)) | (sw & 6)) << 4) + (q4 & 1) * 8;

  bf16x8 qf[NQ][2];
#pragma unroll
  for (int nq = 0; nq < NQ; ++nq)
#pragma unroll
    for (int ks = 0; ks < 2; ++ks) qf[nq][ks] = *(const bf16x8*)(P.qn + (tok0 + nq * 16 + l15) * 512 + h * 64 + ks * 32 + q4 * 8);

  f32x4 S[4][NQ], O[4][NQ];
  float m[NQ], l[NQ];
  const bf16_t* kcb = P.kc + (size_t)(b * 2 + kvh) * 128 * 64;
  const bf16_t* vcb = P.vcT + (size_t)(b * 2 + kvh) * 64 * 128;
  const int njb = (c32 + 1 + 63) >> 6;
  attn_reset(m, l, O);

  uint4 rk0, rk1, rv0, rv1;
  KV_ISSUE(kcb, vcb, 128);
  for (int jb = 0; jb < njb; ++jb) {
    __syncthreads();
    KV_STORE();
    __syncthreads();
    { const int jn = (jb + 1 < njb) ? jb + 1 : 0; KV_ISSUE(kcb + (size_t)jn * 64 * 64, vcb + jn * 64, 128); }
    __builtin_amdgcn_sched_barrier(0);
    attn_scores(KT, kfr0, qf, S);
    attn_mask(S, 3, 3, hb, posbase, jb * 64, l15, q4);
    attn_softmax_step(S, m, l, O, false);
  }
  float invl[NQ];
#pragma unroll
  for (int nq = 0; nq < NQ; ++nq) { float lt = l[nq]; lt += __shfl_xor(lt, 16); lt += __shfl_xor(lt, 32); invl[nq] = 1.0f / fmaxf(lt, 1e-30f); }
  for (int jb = 0; jb < njb; ++jb) {
    __syncthreads();
    KV_STORE();
    __syncthreads();
    { const int jn = (jb + 1 < njb) ? jb + 1 : jb; KV_ISSUE(kcb + (size_t)jn * 64 * 64, vcb + jn * 64, 128); }
    __builtin_amdgcn_sched_barrier(0);
    attn_scores(KT, kfr0, qf, S);
    attn_mask(S, 3, 3, hb, posbase, jb * 64, l15, q4);
#pragma unroll
    for (int nq = 0; nq < NQ; ++nq)
#pragma unroll
      for (int mk = 0; mk < 4; ++mk)
#pragma unroll
        for (int r = 0; r < 4; ++r) S[mk][nq][r] = __builtin_amdgcn_exp2f(S[mk][nq][r] - fmaxf(m[nq], -1e28f)) * invl[nq];
    for (int gg = 0; gg < 4; ++gg) {
      if (g == gg) {
#pragma unroll
        for (int nq = 0; nq < NQ; ++nq)
#pragma unroll
          for (int mk = 0; mk < 4; ++mk) {
            float* ip = IMP + (nq * 16 + l15) * 65 + jb * 32 + mk * 8 + q4 * 2;
            const float v0 = S[mk][nq][0] + S[mk][nq][1], v1 = S[mk][nq][2] + S[mk][nq][3];
            if (gg == 0) { ip[0] = v0; ip[1] = v1; } else { ip[0] += v0; ip[1] += v1; }
          }
      }
      __syncthreads();
    }
    attn_pv(VT, vfr0, S, O);
  }
#pragma unroll
  for (int nq = 0; nq < NQ; ++nq) {
    const float g0 = sigmoidf_(bf2f(P.z[(tok0 + nq * 16 + l15) * ZLD + ZC_NG + h * 3 + 0]));
#pragma unroll
    for (int md = 0; md < 4; ++md) {
      float4 v; v.x = O[md][nq][0] * g0; v.y = O[md][nq][1] * g0; v.z = O[md][nq][2] * g0; v.w = O[md][nq][3] * g0;
      *(float4*)(scratch + (tok0 + nq * 16 + l15) * LDS_F + h * 64 + md * 16 + q4 * 4) = v;
    }
  }
  __syncthreads();
  for (int i = 0; i < 8; ++i) {
    const int rr = g * 8 + i;
    const float v = IMP[rr * 65 + lane];
    const bool visible = lane <= c;
    const bool forced = (lane == 0) || (lane == c) || (lane == c - 1);
    const float val = forced ? 1e4f : (visible ? v : -INFINITY);
    int rank = 0;
#pragma unroll
    for (int j = 0; j < 64; ++j) {
      const float vj = __int_as_float(__builtin_amdgcn_readlane(__float_as_int(val), j));
      rank += ((vj > val) || (vj == val && j < lane)) ? 1 : 0;
    }
    const bool sel = (rank < 16) && visible;
    const unsigned long long mk = __ballot(sel);
    if (lane == 0) { MASK[rr * 2] = (uint32_t)mk; MASK[rr * 2 + 1] = (uint32_t)(mk >> 32); }
  }
  __syncthreads();
  uint32_t ulo = MASK[(lane & 31) * 2], uhi = MASK[(lane & 31) * 2 + 1];
#pragma unroll
  for (int o = 16; o >= 1; o >>= 1) { ulo |= __shfl_xor(ulo, o); uhi |= __shfl_xor(uhi, o); }
  ulo = __builtin_amdgcn_readfirstlane(ulo); uhi = __builtin_amdgcn_readfirstlane(uhi);
  unsigned long long rem = ((unsigned long long)uhi << 32) | ulo;
  unsigned long long mrow[NQ];
#pragma unroll
  for (int nq = 0; nq < NQ; ++nq) mrow[nq] = ((unsigned long long)MASK[(nq * 16 + l15) * 2 + 1] << 32) | MASK[(nq * 16 + l15) * 2];

  attn_reset(m, l, O);
  {
    const bf16_t* kb = P.ksn + (size_t)(b * 2 + kvh) * SEQL * 64;
    const bf16_t* vb = P.vsT + (size_t)(b * 2 + kvh) * 64 * LDV;
    int j = __builtin_ctzll(rem);
    rem &= rem - 1;
    KV_ISSUE(kb + (size_t)j * 64 * 64, vb + j * 64, LDV);
    __syncthreads();
    KV_STORE();
    bool last = (rem == 0);
    int jn = last ? j : __builtin_ctzll(rem);
    rem &= rem - 1;
    KV_ISSUE(kb + (size_t)jn * 64 * 64, vb + jn * 64, LDV);
    __syncthreads();
    int pb = 0;
    for (;;) {
      const char* KTc = smem + pb * 32768; const char* VTc = KTc + 8192;
      __builtin_amdgcn_sched_barrier(0);
      attn_scores(KTc, kfr0, qf, S);
      int selbits = 0;
#pragma unroll
      for (int nq = 0; nq < NQ; ++nq) selbits |= (int)((mrow[nq] >> j) & 1ull) << nq;
      if (j == c) attn_mask(S, 1, selbits, hb, posbase, 0, l15, q4); else attn_mask(S, 0, selbits, hb, posbase, 0, l15, q4);
      attn_softmax_step(S, m, l, O, true);
      attn_pv(VTc, vfr0, S, O);
      if (last) break;
      { char* KT = smem + (pb ^ 1) * 32768; char* VT = KT + 8192; KV_STORE(); }
      j = jn; last = (rem == 0); jn = last ? j : __builtin_ctzll(rem); rem &= rem - 1;
      KV_ISSUE(kb + (size_t)jn * 64 * 64, vb + jn * 64, LDV);
      __syncthreads();
      pb ^= 1;
    }
  }
#pragma unroll
  for (int nq = 0; nq < NQ; ++nq) {
    float lt = l[nq]; lt += __shfl_xor(lt, 16); lt += __shfl_xor(lt, 32);
    const float sc = sigmoidf_(bf2f(P.z[(tok0 + nq * 16 + l15) * ZLD + ZC_NG + h * 3 + 1])) / fmaxf(lt, 1e-30f);
#pragma unroll
    for (int md = 0; md < 4; ++md) {
      float4* p = (float4*)(scratch + (tok0 + nq * 16 + l15) * LDS_F + h * 64 + md * 16 + q4 * 4);
      float4 v = *p;
      v.x += O[md][nq][0] * sc; v.y += O[md][nq][1] * sc; v.z += O[md][nq][2] * sc; v.w += O[md][nq][3] * sc;
      *p = v;
    }
  }
  attn_reset(m, l, O);
  {
    const bf16_t* kb = P.kwn + (size_t)(b * 2 + kvh) * SEQL * 64;
    const bf16_t* vb = P.vwT + (size_t)(b * 2 + kvh) * 64 * LDV;
    const int j0 = (c - 8 > 0) ? (c - 8) : 0;
    int j = j0;
    KV_ISSUE(kb + (size_t)j * 64 * 64, vb + j * 64, LDV);
    __syncthreads();
    KV_STORE();
    int jn = (j < c) ? j + 1 : j;
    KV_ISSUE(kb + (size_t)jn * 64 * 64, vb + jn * 64, LDV);
    __syncthreads();
    int pb = 0;
    for (;;) {
      const char* KTc = smem + pb * 32768; const char* VTc = KTc + 8192;
      __builtin_amdgcn_sched_barrier(0);
      attn_scores(KTc, kfr0, qf, S);
      if (j == c) attn_mask(S, 1, 3, hb, posbase, 0, l15, q4);
      else if (j == c - 8) attn_mask(S, 2, 3, hb, posbase, 0, l15, q4);
      attn_softmax_step(S, m, l, O, true);
      attn_pv(VTc, vfr0, S, O);
      if (j == c) break;
      { char* KT = smem + (pb ^ 1) * 32768; char* VT = KT + 8192; KV_STORE(); }
      j = jn; jn = (j < c) ? j + 1 : j;
      KV_ISSUE(kb + (size_t)jn * 64 * 64, vb + jn * 64, LDV);
      __syncthreads();
      pb ^= 1;
    }
  }
#pragma unroll
  for (int nq = 0; nq < NQ; ++nq) {
    float lt = l[nq]; lt += __shfl_xor(lt, 16); lt += __shfl_xor(lt, 32);
    const float sc = sigmoidf_(bf2f(P.z[(tok0 + nq * 16 + l15) * ZLD + ZC_NG + h * 3 + 2])) / fmaxf(lt, 1e-30f);
#pragma unroll
    for (int md = 0; md < 4; ++md) {
      const float4 v = *(const float4*)(scratch + (tok0 + nq * 16 + l15) * LDS_F + h * 64 + md * 16 + q4 * 4);
      uint2 w; w.x = pack2(v.x + O[md][nq][0] * sc, v.y + O[md][nq][1] * sc); w.y = pack2(v.z + O[md][nq][2] * sc, v.w + O[md][nq][3] * sc);
      *(uint2*)(P.ob + (tok0 + nq * 16 + l15) * LD5 + h * 64 + md * 16 + q4 * 4) = w;
    }
  }
}
__device__ void phase_attn_s5(const Params& P, int layer, char* smem, int pass) {
  if (BIDX < 128) { s5_unit(P, layer, BIDX, smem); }
  unsigned* ctr = P.bar + 3600 + (layer * 2 + pass) * 56;
  volatile int* slot = (volatile int*)(smem + 65024);
  for (;;) {
    __syncthreads();
    if (threadIdx.x == 0) *slot = (int)atomicAdd(ctr, 1u);
    __syncthreads();
    const int u = __builtin_amdgcn_readfirstlane(*slot);
    if (u >= 1024) break;
    attn_unit(P, u, smem);
  }
}

#define NPHASE 11
__device__ __forceinline__ void run_phase(const Params& P, int layer, int ph, char* smem, float alpha = 1.0f) {
  switch (ph) {
    case 0: phase_convert(P, layer, smem); phase_cmp_bias(P, layer);
            phase_rmsnorm(layer == 0 ? P.in[0] : P.x, layer == 0 ? P.x : nullptr, P.in[1] + (size_t)layer * DM, P.hbuf); break;
    case 1: phase_gemm_in(P, smem); break;
    case 2: phase_prep(P, layer, smem); break;
    case 3: break;
    case 4: phase_cmp2(P, layer); break;
    case 5: phase_attn_s5(P, layer, smem, alpha == 0.0f ? 1 : 0); break;
    case 6: phase_merge(P, smem); break;
    case 7: phase_gemm_resid(P, P.hbuf, LDH, P.Wt_out, DM, smem, alpha); break;
    case 8: phase_rmsnorm(P.x, nullptr, P.in[21] + (size_t)layer * DM, P.hbuf); break;
    case 9: phase_gemm_gateup(P, smem); break;
    case 10: phase_gemm_resid(P, P.z, LDA, P.Wt_down, DFF, smem, alpha); break;
  }
}

#ifndef REPEAT_MASK
#define REPEAT_MASK 0
#endif
#if !MEGA
__global__ void __launch_bounds__(256, 2) k_phase(Params P, int layer, int ph) {
  __shared__ __attribute__((aligned(16))) char smem[65536];
  run_phase(P, layer, ph, smem);
}
#else
#define XB_TMO      128
#define XB_XCNT(j)  (256  + 64 * (j))
#define XB_XSUB(j)  (1280 + 64 * (j))
#define XB_XGEN(j)  (2304 + 64 * (j))
#define XB_TOP      3328
#define XB_TOPGEN   3392
#define XCD_BAR_WORDS 3456
#define XB_SPIN_CAP (1u << 22)
__device__ __forceinline__ unsigned xb_ld(unsigned* p)              { return __hip_atomic_load(p, __ATOMIC_RELAXED, __HIP_MEMORY_SCOPE_AGENT); }
__device__ __forceinline__ unsigned xb_add(unsigned* p, unsigned v) { return __hip_atomic_fetch_add(p, v, __ATOMIC_RELAXED, __HIP_MEMORY_SCOPE_AGENT); }
__device__ __forceinline__ unsigned xb_xcc_id() { return (unsigned)__builtin_amdgcn_s_getreg((3 << 11) | 20) & 0xFu; }
#define XB_SPIN(cond, bar) do { unsigned _sp = 0; while (cond) { __builtin_amdgcn_s_sleep(1); \
    if ((++_sp & 255u) == 0u) { if (xb_ld(&(bar)[XB_TMO])) break; if (_sp > XB_SPIN_CAP) { atomicAdd(&(bar)[XB_TMO], 1u); break; } } } } while (0)
struct XcdBarrier { unsigned* bar; unsigned x, nloc, nx; };
__device__ __forceinline__ void xcd_barrier_complete(unsigned* bar, unsigned x, unsigned& nloc, unsigned& nx) {
  const unsigned G = gridDim.x;
  unsigned sum, cnt, mine, sp = 0u;
  for (;;) {
    sum = 0u; cnt = 0u; mine = 0u;
#pragma unroll
    for (unsigned j = 0; j < 16; ++j) { const unsigned c = xb_ld(&bar[XB_XCNT(j)]); sum += c; cnt += (c > 0u) ? 1u : 0u; mine = (j == x) ? c : mine; }
    if (sum == G) break;
    __builtin_amdgcn_s_sleep(1);
    if ((++sp & 255u) == 0u) { if (xb_ld(&bar[XB_TMO])) break; if (sp > XB_SPIN_CAP) { atomicAdd(&bar[XB_TMO], 1u); break; } }
  }
  nloc = mine > 0u ? mine : 1u; nx = cnt > 0u ? cnt : 1u;
}
__device__ __forceinline__ void xcd_barrier(const XcdBarrier& b) {
  asm volatile("s_waitcnt vmcnt(0)" ::: "memory");
  __syncthreads();
  if (threadIdx.x == 0) {
    unsigned* bar = b.bar;
    __builtin_amdgcn_s_waitcnt(0);
    const unsigned nloc = b.nloc, nx = b.nx;
    const unsigned old = xb_add(&bar[XB_XSUB(b.x)], 1u);
    const unsigned gen = old / nloc;
    if (old + 1u == (gen + 1u) * nloc) {
      __builtin_amdgcn_fence(__ATOMIC_RELEASE, "agent");
      asm volatile("s_waitcnt vmcnt(0)" ::: "memory");
      const unsigned og = xb_add(&bar[XB_TOP], 1u);
      const unsigned tg = og / nx;
      if (og + 1u == (tg + 1u) * nx) xb_add(&bar[XB_TOPGEN], 1u);
      else XB_SPIN(xb_ld(&bar[XB_TOPGEN]) == tg, bar);
      __builtin_amdgcn_fence(__ATOMIC_ACQUIRE, "agent");
      xb_add(&bar[XB_XGEN(b.x)], 1u);
      asm volatile("s_waitcnt vmcnt(0)" ::: "memory");
    } else {
      XB_SPIN(xb_ld(&bar[XB_XGEN(b.x)]) == gen, bar);
      __builtin_amdgcn_fence(__ATOMIC_ACQUIRE, "agent");
      asm volatile("s_waitcnt vmcnt(0)" ::: "memory");
    }
  }
  __syncthreads();
}

__global__ void __launch_bounds__(256, 2) k_mega(Params P) {
  __shared__ __attribute__((aligned(16))) char smem[65536];
  if (P.x == nullptr) { cg::this_grid().sync(); }
  XcdBarrier xb; xb.bar = P.bar; xb.x = xb_xcc_id(); xb.nloc = 1u; xb.nx = 1u;
  if (threadIdx.x == 0) { (void)xb_add(&P.bar[XB_XCNT(xb.x)], 1u); xcd_barrier_complete(P.bar, xb.x, xb.nloc, xb.nx); }
  for (int layer = 0; layer < DEPTH; ++layer) {
    for (int ph = 0; ph < NPHASE; ++ph) {
      if (ph == 3) continue;
      run_phase(P, layer, ph, smem);
      if ((REPEAT_MASK >> ph) & 1) { xcd_barrier(xb); run_phase(P, layer, ph, smem, 0.0f); }
      if (!(layer == DEPTH - 1 && ph == NPHASE - 1)) xcd_barrier(xb);
    }
  }
}
#endif

extern "C" void kernel_launch(void* const* d_in, const int* in_sizes, int n_in, void* d_out, int out_size, void* d_ws, size_t ws_size, hipStream_t stream) {
  Params P;
  memset(&P, 0, sizeof(P));
  for (int i = 0; i < 24; ++i) P.in[i] = (const float*)d_in[i];
  P.x = (float*)d_out;
  char* w = (char*)d_ws;
  size_t off = 0;
  auto take = [&](size_t bytes) { char* p = w + off; off += (bytes + 255) & ~(size_t)255; return (bf16_t*)p; };
  P.Wt_in = take((size_t)ZLD * LDH * 2);
  P.Wt_glu = take((size_t)2048 * LD5 * 2);
  P.Wt_conv = take((size_t)1024 * LD5 * 2);
  P.Wt_o = take((size_t)1024 * LD5 * 2);
  P.Wt_out = take((size_t)1024 * LDH * 2);
  P.Wt_gu = take((size_t)5632 * LDH * 2);
  P.Wt_down = take((size_t)1024 * LDA * 2);
  P.Wt_c1 = take((size_t)512 * LDC * 2);
  P.z = take((size_t)T_TOK * ZLD * 2);
  P.hbuf = take((size_t)T_TOK * LDH * 2);
  P.ys = take((size_t)T_TOK * LD5 * 2);
  P.cv = take((size_t)T_TOK * LD5 * 2);
  P.ob = take((size_t)T_TOK * LD5 * 2);
  P.qn = take((size_t)T_TOK * 512 * 2);
  P.ksn = take((size_t)T_TOK * 128 * 2);
  P.kwn = take((size_t)T_TOK * 128 * 2);
  P.vsT = take((size_t)8 * 64 * LDV * 2);
  P.vwT = take((size_t)8 * 64 * LDV * 2);
  P.acmp = take((size_t)2 * 1024 * LDC * 2);
  P.hid = take((size_t)2 * 1024 * 256 * 2);
  P.kc = take((size_t)8 * 128 * 64 * 2);
  P.vcT = take((size_t)8 * 64 * 128 * 2);
  P.bar = (unsigned*)take((size_t)4096 * 4);
  P.cbias = (float*)take((size_t)512 * 4);
  if (off > ws_size) { fprintf(stderr, "kernel_launch: workspace too small: need %zu have %zu\n", off, ws_size); return; }
#if MEGA
  static int grid_blocks = 0;
  if (!grid_blocks) {
    int dev = 0, cus = 0, per_cu = 0;
    hipGetDevice(&dev);
    hipDeviceGetAttribute(&cus, hipDeviceAttributeMultiprocessorCount, dev);
    hipOccupancyMaxActiveBlocksPerMultiprocessor(&per_cu, k_mega, 256, 0);
    (void)per_cu;
    grid_blocks = cus * 2;
  }
  hipMemsetAsync(P.bar, 0, 4096 * 4, stream);
  void* args[] = {&P};
  hipError_t e = hipLaunchCooperativeKernel((void*)k_mega, dim3(grid_blocks), dim3(256), args, 0, stream);
  if (e != hipSuccess) fprintf(stderr, "cooperative launch failed: %s (grid %d)\n", hipGetErrorString(e), grid_blocks);
#else
  for (int layer = 0; layer < DEPTH; ++layer)
    for (int ph = 0; ph < NPHASE; ++ph) {
      hipLaunchKernelGGL(k_phase, dim3(512), dim3(256), 0, stream, P, layer, ph);
      if ((REPEAT_MASK >> ph) & 1) hipLaunchKernelGGL(k_phase, dim3(512), dim3(256), 0, stream, P, layer, ph);
    }
#endif
}
```

```cpp
#include <hip/hip_runtime.h>
#include <hip/hip_cooperative_groups.h>
#include <stdint.h>
#include <cstdio>
#include <cstring>
namespace cg = cooperative_groups;

#ifndef MEGA
#define MEGA 1
#endif

typedef unsigned short bf16_t;
typedef short bf16x8 __attribute__((ext_vector_type(8)));
typedef float f32x4 __attribute__((ext_vector_type(4)));

#define T_TOK 16384
#define SEQL 4096
#define DM 1024
#define ZLD 6528
#define NIN 6424
#define DFF 2816
#define DEPTH 4
#define LDH 1088
#define LD5 576
#define LDA 2880
#define LDC 2112
#define LDV 4160
#define LDS_F 544
#define ZC_U 0
#define ZC_CB 512
#define ZC_CC 1024
#define ZC_CX 1536
#define ZC_Q 2048
#define ZC_KC 2560
#define ZC_VC 2688
#define ZC_KS 2816
#define ZC_VS 2944
#define ZC_KW 3072
#define ZC_VW 3200
#define ZC_MIX 3328
#define ZC_NG 6400
#define RMS_EPS 1e-6f

struct Params {
  const float* in[24];
  float* x;
  bf16_t *Wt_in, *Wt_glu, *Wt_conv, *Wt_o, *Wt_out, *Wt_gu, *Wt_down, *Wt_c1;
  bf16_t *z, *hbuf, *ys, *cv, *ob, *qn, *ksn, *kwn, *vsT, *vwT, *acmp, *hid, *kc, *vcT;
  unsigned* bar;
  float* cbias;
};

__device__ __forceinline__ int tidx_() { int t = threadIdx.x; asm volatile("" : "+v"(t)); return t; }
__device__ __forceinline__ int bidx_() { int t = blockIdx.x; asm volatile("" : "+s"(t)); return t; }
#define TIDX tidx_()
#define BIDX bidx_()
__device__ __forceinline__ float bf2f(bf16_t b) { return __uint_as_float(((uint32_t)b) << 16); }
__device__ __forceinline__ uint32_t pack2(float lo, float hi) {
  uint32_t r; asm("v_cvt_pk_bf16_f32 %0, %1, %2" : "=v"(r) : "v"(lo), "v"(hi)); return r;
}
__device__ __forceinline__ float lo2f(uint32_t w) { return __uint_as_float(w << 16); }
__device__ __forceinline__ float hi2f(uint32_t w) { return __uint_as_float(w & 0xffff0000u); }
__device__ __forceinline__ float sigmoidf_(float x) { return __builtin_amdgcn_rcpf(1.0f + __expf(-x)); }
__device__ __forceinline__ float gelu_tanh(float x) { return x * sigmoidf_(1.5957691216f * (x + 0.044715f * x * x * x)); }
__device__ __forceinline__ int lds_off(int row, int ch) { return row * 128 + ((ch ^ ((row >> 1) & 7)) << 4); }

__device__ void conv_job(const float* __restrict__ src, int K, int Nsrc, int col0, int ncols, bf16_t* __restrict__ dst, int drow0, float* lt, int b0, int bs, int mode = 0) {
  const int tid = TIDX;
  const int kt = K >> 6, nt = (ncols + 63) >> 6;
  for (int tile = b0; tile < kt * nt; tile += bs) {
    const int tk = tile % kt, tn = tile / kt;
    const int nl = tid & 63, kl = tid >> 6;
    const int n = tn * 64 + nl;
#pragma unroll
    for (int i = 0; i < 16; ++i) {
      const int k = kl + 4 * i;
      int sc = col0 + n;
      if (mode == 1) { const int t = n >> 7, r = n & 127, wc = r >> 6, nn = (r & 63) >> 4, ii = r & 15; sc = ((nn < 2) ? 0 : DFF) + t * 64 + wc * 32 + (nn & 1) * 16 + ii; }
      float v = (n < ncols) ? src[(size_t)(tk * 64 + k) * Nsrc + sc] : 0.f;
      lt[nl * 65 + k] = v;
    }
    __syncthreads();
    const int k8 = (tid & 7) * 8, n2 = tid >> 3;
#pragma unroll
    for (int i = 0; i < 2; ++i) {
      const int nn = n2 + 32 * i;
      if (tn * 64 + nn < ncols) {
        const float* r = lt + nn * 65 + k8;
        uint4 w;
        w.x = pack2(r[0], r[1]); w.y = pack2(r[2], r[3]); w.z = pack2(r[4], r[5]); w.w = pack2(r[6], r[7]);
        *(uint4*)(dst + (size_t)(drow0 + tn * 64 + nn) * (K + 64) + tk * 64 + k8) = w;
      }
    }
    __syncthreads();
  }
}

__device__ void phase_convert(const Params& P, int layer, char* smem) {
  float* lt = (float*)smem;
  const int b0 = BIDX, bs = gridDim.x;
  const float* w_in = P.in[2] + (size_t)layer * DM * NIN;
  conv_job(w_in, DM, NIN, 0, 3328, P.Wt_in, 0, lt, b0, bs);
  conv_job(w_in, DM, NIN, 3352, 3072, P.Wt_in, ZC_MIX, lt, b0, bs);
  conv_job(w_in, DM, NIN, 3328, 24, P.Wt_in, ZC_NG, lt, b0, bs);
  conv_job(P.in[17] + (size_t)(layer * 2 + 0) * 2048 * 256, 2048, 256, 0, 256, P.Wt_c1, 0, lt, b0, bs);
  conv_job(P.in[17] + (size_t)(layer * 2 + 1) * 2048 * 256, 2048, 256, 0, 256, P.Wt_c1, 256, lt, b0, bs);
}
__device__ void phase_convert_late(const Params& P, int layer, char* smem, int b0, int bs) {
  float* lt = (float*)smem;
  conv_job(P.in[11] + (size_t)layer * 512 * 2048, 512, 2048, 0, 2048, P.Wt_glu, 0, lt, b0, bs);
  conv_job(P.in[13] + (size_t)layer * 512 * 1024, 512, 1024, 0, 1024, P.Wt_conv, 0, lt, b0, bs);
  conv_job(P.in[19] + (size_t)layer * 512 * 1024, 512, 1024, 0, 1024, P.Wt_o, 0, lt, b0, bs);
  conv_job(P.in[20] + (size_t)layer * 1024 * 1024, 1024, 1024, 0, 1024, P.Wt_out, 0, lt, b0, bs);
  conv_job(P.in[22] + (size_t)layer * 1024 * 5632, 1024, 5632, 0, 5632, P.Wt_gu, 0, lt, b0, bs, 1);
  conv_job(P.in[23] + (size_t)layer * DFF * 1024, DFF, 1024, 0, 1024, P.Wt_down, 0, lt, b0, bs);
}

__device__ void phase_rmsnorm(const float* __restrict__ xin, float* __restrict__ xcopy, const float* __restrict__ g, bf16_t* __restrict__ out) {
  const int lane = TIDX & 63, wave = TIDX >> 6;
  for (int tok = BIDX * 4 + wave; tok < T_TOK; tok += gridDim.x * 4) {
    const float4* xr = (const float4*)(xin + (size_t)tok * DM);
    float4 v[4];
    float ss = 0.f;
#pragma unroll
    for (int i = 0; i < 4; ++i) { v[i] = xr[lane + 64 * i]; ss += v[i].x * v[i].x + v[i].y * v[i].y + v[i].z * v[i].z + v[i].w * v[i].w; }
#pragma unroll
    for (int o = 32; o >= 1; o >>= 1) ss += __shfl_xor(ss, o);
    const float r = rsqrtf(ss * (1.0f / DM) + RMS_EPS);
    if (xcopy) {
      float4* xc = (float4*)(xcopy + (size_t)tok * DM);
#pragma unroll
      for (int i = 0; i < 4; ++i) xc[lane + 64 * i] = v[i];
    }
#pragma unroll
    for (int i = 0; i < 4; ++i) {
      const float4 gg = ((const float4*)g)[lane + 64 * i];
      uint2 w; w.x = pack2(v[i].x * r * gg.x, v[i].y * r * gg.y); w.y = pack2(v[i].z * r * gg.z, v[i].w * r * gg.w);
      *(uint2*)(out + (size_t)tok * LDH + (lane + 64 * i) * 4) = w;
    }
  }
}

template <bool A_GATHER = false>
__device__ __forceinline__ void gemm_main(const bf16_t* __restrict__ A, size_t lda, const bf16_t* __restrict__ Bt, int ldb, int K, f32x4 (&acc)[4][4], char* smem, size_t kstepA = 64) {
  const int tid = TIDX, lane = tid & 63, wave = tid >> 6, wr = wave >> 1, wc = wave & 1, l15 = lane & 15, q4 = lane >> 4;
  const int lrow = tid >> 3, lch = tid & 7;
  const bf16_t* ap = A_GATHER ? A : A + (size_t)lrow * lda + lch * 8;
  const bf16_t* bp = Bt + (size_t)lrow * ldb + lch * 8;
  const size_t sa = A_GATHER ? lda : (size_t)32 * lda, sb = (size_t)32 * ldb;
  typedef unsigned u32x4 __attribute__((ext_vector_type(4)));
  u32x4 ra0, ra1, ra2, ra3, rb0, rb1, rb2, rb3;
  u32x4 rc0, rc1, rc2, rc3, rd0, rd1, rd2, rd3;
  int nk = K >> 6;
  asm volatile("" : "+s"(nk));
  const int st_off = lds_off(lrow, lch);
  const int sw = (l15 >> 1) & 7;
  const int fr0 = l15 * 128 + (((q4 ^ (sw & 3)) << 4) | ((sw >> 2) << 6));
  const int a_off = wr * 8192 + fr0, b_off = 16384 + wc * 8192 + fr0;
#ifndef EXP_GL
#define EXP_GL 0
#endif
#ifndef EXP_LDSW
#define EXP_LDSW 0
#endif
#if EXP_GL
#define GLQ const volatile u32x4*
#define GLREP 2
#else
#define GLQ const u32x4*
#define GLREP 1
#endif
#if EXP_LDSW == 1
#define LSQ volatile u32x4*
#define LSREP 2
#else
#define LSQ u32x4*
#define LSREP 1
#endif
#define GLOAD0(AP, BP) do { for (int rep_ = 0; rep_ < GLREP; ++rep_) { ra0 = *(GLQ)(AP); ra1 = *(GLQ)((AP) + sa); ra2 = *(GLQ)((AP) + 2 * sa); ra3 = *(GLQ)((AP) + 3 * sa); \
                            rb0 = *(GLQ)(BP); rb1 = *(GLQ)((BP) + sb); rb2 = *(GLQ)((BP) + 2 * sb); rb3 = *(GLQ)((BP) + 3 * sb); } } while (0)
#define GLOAD1(AP, BP) do { for (int rep_ = 0; rep_ < GLREP; ++rep_) { rc0 = *(GLQ)(AP); rc1 = *(GLQ)((AP) + sa); rc2 = *(GLQ)((AP) + 2 * sa); rc3 = *(GLQ)((AP) + 3 * sa); \
                            rd0 = *(GLQ)(BP); rd1 = *(GLQ)((BP) + sb); rd2 = *(GLQ)((BP) + 2 * sb); rd3 = *(GLQ)((BP) + 3 * sb); } } while (0)
#define XW(P_, V_) asm volatile("ds_write_b128 %0, %1" :: "v"((unsigned)(size_t)(P_)), "v"(V_) : "memory")
#if EXP_LDSW == 2
#define XDUP0(PS) do { XW((PS), ra0); XW((PS) + 4096, ra1); XW((PS) + 8192, ra2); XW((PS) + 12288, ra3); XW((PS) + 16384, rb0); XW((PS) + 20480, rb1); XW((PS) + 24576, rb2); XW((PS) + 28672, rb3); } while (0)
#define XDUP1(PS) do { XW((PS), rc0); XW((PS) + 4096, rc1); XW((PS) + 8192, rc2); XW((PS) + 12288, rc3); XW((PS) + 16384, rd0); XW((PS) + 20480, rd1); XW((PS) + 24576, rd2); XW((PS) + 28672, rd3); } while (0)
#else
#define XDUP0(PS) do { } while (0)
#define XDUP1(PS) do { } while (0)
#endif
#define LSTORE0(PS) do { XDUP0(PS); for (int rep_ = 0; rep_ < LSREP; ++rep_) { *(LSQ)(PS) = ra0; *(LSQ)((PS) + 4096) = ra1; *(LSQ)((PS) + 8192) = ra2; *(LSQ)((PS) + 12288) = ra3; \
                         *(LSQ)((PS) + 16384) = rb0; *(LSQ)((PS) + 20480) = rb1; *(LSQ)((PS) + 24576) = rb2; *(LSQ)((PS) + 28672) = rb3; } } while (0)
#define LSTORE1(PS) do { XDUP1(PS); for (int rep_ = 0; rep_ < LSREP; ++rep_) { *(LSQ)(PS) = rc0; *(LSQ)((PS) + 4096) = rc1; *(LSQ)((PS) + 8192) = rc2; *(LSQ)((PS) + 12288) = rc3; \
                         *(LSQ)((PS) + 16384) = rd0; *(LSQ)((PS) + 20480) = rd1; *(LSQ)((PS) + 24576) = rd2; *(LSQ)((PS) + 28672) = rd3; } } while (0)
#define COMPUTE(BO) do { _Pragma("unroll") for (int ks = 0; ks < 2; ++ks) { \
      bf16x8 af[4], bfr[4]; \
      const char* pa = smem + (BO) + (a_off ^ (ks * 64)); \
      const char* pb = smem + (BO) + (b_off ^ (ks * 64)); \
      _Pragma("unroll") for (int m = 0; m < 4; ++m) af[m] = *(const bf16x8*)(pa + m * 2048); \
      _Pragma("unroll") for (int n = 0; n < 4; ++n) bfr[n] = *(const bf16x8*)(pb + n * 2048); \
      _Pragma("unroll") for (int m = 0; m < 4; ++m) \
        _Pragma("unroll") for (int n = 0; n < 4; ++n) acc[m][n] = __builtin_amdgcn_mfma_f32_16x16x32_bf16(bfr[n], af[m], acc[m][n], 0, 0, 0); } } while (0)
  GLOAD0(ap, bp);
  GLOAD1(ap + kstepA, bp + 64);
  LSTORE0(smem + st_off);
  __syncthreads();
#pragma nounroll
  for (int kt = 0; kt < nk; kt += 2) {
    { const int t2 = (kt + 2 < nk) ? kt + 2 : nk - 1; const bf16_t* ap2 = ap + t2 * kstepA; const bf16_t* bp2 = bp + t2 * 64; GLOAD0(ap2, bp2); }
    __builtin_amdgcn_sched_barrier(0);
    COMPUTE(0);
    LSTORE1(smem + 32768 + st_off);
    __syncthreads();
    { const int t3 = (kt + 3 < nk) ? kt + 3 : nk - 1; const bf16_t* ap2 = ap + t3 * kstepA; const bf16_t* bp2 = bp + t3 * 64; GLOAD1(ap2, bp2); }
    __builtin_amdgcn_sched_barrier(0);
    COMPUTE(32768);
    LSTORE0(smem + st_off);
    __syncthreads();
  }
#undef GLOAD0
#undef GLOAD1
#undef LSTORE0
#undef LSTORE1
#undef COMPUTE
#undef GLQ
#undef LSQ
#undef GLREP
#undef LSREP
}

__device__ __forceinline__ void gemm_main_shallow(const bf16_t* __restrict__ A, int lda, const bf16_t* __restrict__ Bt, int ldb, int K, f32x4 (&acc)[4][4], char* smem) {
  const int tid = TIDX, lane = tid & 63, wave = tid >> 6, wr = wave >> 1, wc = wave & 1, l15 = lane & 15, q4 = lane >> 4;
  const int lrow = tid >> 3, lch = tid & 7;
  const bf16_t* ap = A + (size_t)lrow * lda + lch * 8;
  const bf16_t* bp = Bt + (size_t)lrow * ldb + lch * 8;
  const size_t sa = (size_t)32 * lda, sb = (size_t)32 * ldb;
  uint4 ra0, ra1, ra2, ra3, rb0, rb1, rb2, rb3;
  int nk = K >> 6;
  asm volatile("" : "+s"(nk));
  const int st_off = lds_off(lrow, lch);
  const int sw = (l15 >> 1) & 7;
  const int fr0 = l15 * 128 + (((q4 ^ (sw & 3)) << 4) | ((sw >> 2) << 6));
  const int a_off = wr * 8192 + fr0, b_off = 16384 + wc * 8192 + fr0;
#define GLOAD(AP, BP) do { ra0 = *(const uint4*)(AP); ra1 = *(const uint4*)((AP) + sa); ra2 = *(const uint4*)((AP) + 2 * sa); ra3 = *(const uint4*)((AP) + 3 * sa); \
                           rb0 = *(const uint4*)(BP); rb1 = *(const uint4*)((BP) + sb); rb2 = *(const uint4*)((BP) + 2 * sb); rb3 = *(const uint4*)((BP) + 3 * sb); } while (0)
#define LSTORE(PS) do { *(uint4*)(PS) = ra0; *(uint4*)((PS) + 4096) = ra1; *(uint4*)((PS) + 8192) = ra2; *(uint4*)((PS) + 12288) = ra3; \
                        *(uint4*)((PS) + 16384) = rb0; *(uint4*)((PS) + 20480) = rb1; *(uint4*)((PS) + 24576) = rb2; *(uint4*)((PS) + 28672) = rb3; } while (0)
  GLOAD(ap, bp);
  LSTORE(smem + st_off);
  __syncthreads();
#pragma nounroll
  for (int kt = 0; kt < nk; ++kt) {
    const int bo = (kt & 1) * 32768;
    const bool more = kt + 1 < nk;
    if (more) { const bf16_t* ap2 = ap + (kt + 1) * 64; const bf16_t* bp2 = bp + (kt + 1) * 64; GLOAD(ap2, bp2); }
#pragma unroll
    for (int ks = 0; ks < 2; ++ks) {
      bf16x8 af[4], bfr[4];
      const char* pa = smem + bo + (a_off ^ (ks * 64));
      const char* pb = smem + bo + (b_off ^ (ks * 64));
#pragma unroll
      for (int m = 0; m < 4; ++m) af[m] = *(const bf16x8*)(pa + m * 2048);
#pragma unroll
      for (int n = 0; n < 4; ++n) bfr[n] = *(const bf16x8*)(pb + n * 2048);
#pragma unroll
      for (int m = 0; m < 4; ++m)
#pragma unroll
        for (int n = 0; n < 4; ++n) acc[m][n] = __builtin_amdgcn_mfma_f32_16x16x32_bf16(bfr[n], af[m], acc[m][n], 0, 0, 0);
    }
    if (more) { char* ps = smem + (bo ^ 32768) + st_off; LSTORE(ps); }
    __syncthreads();
  }
#undef GLOAD
#undef LSTORE
}

__device__ __forceinline__ void zero_acc(f32x4 (&acc)[4][4]) {
#pragma unroll
  for (int m = 0; m < 4; ++m)
#pragma unroll
    for (int n = 0; n < 4; ++n) acc[m][n] = (f32x4){0.f, 0.f, 0.f, 0.f};
}
__device__ __forceinline__ bool tile_coords(int u, int nN, int& tm, int& tn) {
  const int xcd = u & 7, loc = u >> 3;
  const int sb = loc >> 6, mi = loc & 7, ni = (loc >> 3) & 7;
  tm = xcd * 16 + (sb & 1) * 8 + mi; tn = (sb >> 1) * 8 + ni;
  return tn < nN;
}
__device__ __forceinline__ int tile_slots(int nN) { return 128 * ((nN + 7) & ~7); }
#define EPI_SETUP const int lane_ = TIDX & 63, wave_ = TIDX >> 6; const int rbase = tm * 128 + (wave_ >> 1) * 64 + (lane_ & 15); const int cbase = tn * 128 + (wave_ & 1) * 64 + (lane_ >> 4) * 4;

__device__ void phase_gemm_in(const Params& P, char* smem) {
  for (int u = BIDX; u < tile_slots(51); u += gridDim.x) {
    int tm, tn; if (!tile_coords(u, 51, tm, tn)) continue;
    f32x4 acc[4][4]; zero_acc(acc);
    gemm_main(P.hbuf + (size_t)tm * 128 * LDH, LDH, P.Wt_in + (size_t)tn * 128 * LDH, LDH, DM, acc, smem);
    EPI_SETUP
    const bool is_gate = (tn >= ZC_MIX / 128) && (tn < ZC_NG / 128);
#pragma unroll
    for (int m = 0; m < 4; ++m)
#pragma unroll
      for (int n = 0; n < 4; ++n) {
        const int row = rbase + m * 16, col = cbase + n * 16;
        f32x4 v = acc[m][n];
        if (is_gate) { v[0] = sigmoidf_(v[0]); v[1] = sigmoidf_(v[1]); v[2] = sigmoidf_(v[2]); v[3] = sigmoidf_(v[3]); }
        uint2 w; w.x = pack2(v[0], v[1]); w.y = pack2(v[2], v[3]);
        *(uint2*)(smem + (row - tm * 128) * 272 + (col - tn * 128) * 2) = w;
      }
    __syncthreads();
    {
      const int tid = TIDX;
#pragma unroll
      for (int i = 0; i < 8; ++i) {
        const int id = tid + 256 * i, r = id >> 4, c16 = id & 15;
        const uint4 v = *(const uint4*)(smem + r * 272 + c16 * 16);
        *(uint4*)(P.z + (size_t)(tm * 128 + r) * ZLD + tn * 128 + c16 * 8) = v;
      }
    }
    __syncthreads();
  }
}
__device__ void phase_gemm_resid(const Params& P, const bf16_t* A, int lda, const bf16_t* Bt, int K, char* smem, float alpha = 1.0f) {
  for (int u = BIDX; u < tile_slots(8); u += gridDim.x) {
    int tm, tn; if (!tile_coords(u, 8, tm, tn)) continue;
    f32x4 acc[4][4]; zero_acc(acc);
    gemm_main(A + (size_t)tm * 128 * lda, lda, Bt + (size_t)tn * 128 * (K + 64), K + 64, K, acc, smem);
    EPI_SETUP
#pragma unroll
    for (int m = 0; m < 4; ++m)
#pragma unroll
      for (int n = 0; n < 4; ++n) {
        const int row = rbase + m * 16, col = cbase + n * 16;
        float4* p = (float4*)(P.x + (size_t)row * DM + col);
        float4 v = *p;
        v.x += alpha * acc[m][n][0]; v.y += alpha * acc[m][n][1]; v.z += alpha * acc[m][n][2]; v.w += alpha * acc[m][n][3];
        *p = v;
      }
  }
}
__device__ void phase_gemm_gateup(const Params& P, char* smem) {
  bf16_t* act = P.z;
  for (int u = BIDX; u < tile_slots(44); u += gridDim.x) {
    int tm, tn; if (!tile_coords(u, 44, tm, tn)) continue;
    f32x4 acc[4][4]; zero_acc(acc);
    gemm_main(P.hbuf + (size_t)tm * 128 * LDH, LDH, P.Wt_gu + (size_t)tn * 128 * LDH, LDH, DM, acc, smem);
    const int lane_ = TIDX & 63, wave_ = TIDX >> 6;
    const int rbase = tm * 128 + (wave_ >> 1) * 64 + (lane_ & 15);
    const int cbase = tn * 64 + (wave_ & 1) * 32 + (lane_ >> 4) * 4;
#pragma unroll
    for (int m = 0; m < 4; ++m)
#pragma unroll
      for (int n = 0; n < 2; ++n) {
        const int row = rbase + m * 16, col = cbase + n * 16;
        float o[4];
#pragma unroll
        for (int r = 0; r < 4; ++r) { const float gq = acc[m][n][r]; o[r] = gq * sigmoidf_(gq) * acc[m][n + 2][r]; }
        uint2 w; w.x = pack2(o[0], o[1]); w.y = pack2(o[2], o[3]);
        *(uint2*)(smem + (row - tm * 128) * 144 + (col - tn * 64) * 2) = w;
      }
    __syncthreads();
    {
      const int tid = TIDX;
#pragma unroll
      for (int i = 0; i < 4; ++i) {
        const int id = tid + 256 * i, r = id >> 3, c8 = id & 7;
        const uint4 v = *(const uint4*)(smem + r * 144 + c8 * 16);
        *(uint4*)(act + (size_t)(tm * 128 + r) * LDA + tn * 64 + c8 * 8) = v;
      }
    }
    __syncthreads();
  }
}
__device__ void phase_gemm_cmp1(const Params& P, char* smem, int u0, int ustride) {
  for (int u = u0; u < 32; u += ustride) {
    const int which = u >> 4, rem = u & 15, tm = rem & 7, tn = rem >> 3;
    f32x4 acc[4][4]; zero_acc(acc);
    const int tid = TIDX, lrow = tid >> 3, lch = tid & 7;
    const bf16_t* ap = P.z + ((size_t)(tm * 64 + (lrow >> 1)) * 32) * ZLD + (which ? ZC_VC : ZC_KC) + (lrow & 1) * 64 + lch * 8;
    gemm_main<true>(ap, (size_t)512 * ZLD, P.Wt_c1 + (size_t)which * 256 * LDC + (size_t)tn * 128 * LDC, LDC, 2048, acc, smem, (size_t)ZLD);
    EPI_SETUP
#pragma unroll
    for (int m = 0; m < 4; ++m)
#pragma unroll
      for (int n = 0; n < 4; ++n) {
        const int row = rbase + m * 16, col = cbase + n * 16;
        const float4 bb = *(const float4*)(P.cbias + which * 256 + col);
        uint2 w; w.x = pack2(gelu_tanh(acc[m][n][0] + bb.x), gelu_tanh(acc[m][n][1] + bb.y)); w.y = pack2(gelu_tanh(acc[m][n][2] + bb.z), gelu_tanh(acc[m][n][3] + bb.w));
        *(uint2*)(P.hid + (size_t)which * 1024 * 256 + (size_t)row * 256 + col) = w;
      }
  }
}
__device__ void phase_cmp_bias(const Params& P, int layer) {
  const int lane = TIDX & 63, wave = TIDX >> 6;
  for (int o = BIDX * 4 + wave; o < 512; o += gridDim.x * 4) {
    const int which = o >> 8, col = o & 255;
    const float* pe = P.in[16] + (size_t)(layer * 2 + which) * 2048;
    const float* w1 = P.in[17] + (size_t)(layer * 2 + which) * 2048 * 256 + col;
    float acc = 0.f;
    for (int k = lane; k < 2048; k += 64) acc += pe[k] * w1[(size_t)k * 256];
#pragma unroll
    for (int o2 = 32; o2 >= 1; o2 >>= 1) acc += __shfl_xor(acc, o2);
    if (lane == 0) P.cbias[o] = acc;
  }
}
__device__ void phase_merge(const Params& P, char* smem) {
  for (int u = BIDX; u < tile_slots(8); u += gridDim.x) {
    int tm, tn; if (!tile_coords(u, 8, tm, tn)) continue;
    EPI_SETUP
    const unsigned eoff = (unsigned)rbase * ZLD + (unsigned)cbase;
    const unsigned hoff = (unsigned)rbase * LDH + (unsigned)cbase;
    {
      f32x4 a0[4][4], a1[4][4]; zero_acc(a0); zero_acc(a1);
      gemm_main_shallow(P.ys + (size_t)tm * 128 * LD5, LD5, P.Wt_glu + (size_t)tn * 128 * LD5, LD5, 512, a0, smem);
      gemm_main_shallow(P.ys + (size_t)tm * 128 * LD5, LD5, P.Wt_glu + (size_t)(1024 + tn * 128) * LD5, LD5, 512, a1, smem);
      const bf16_t* zg = P.z + ZC_MIX;
#pragma unroll
      for (int m = 0; m < 4; ++m)
#pragma unroll
        for (int n = 0; n < 4; ++n) {
          const uint2 gw = *(const uint2*)(zg + (eoff + (unsigned)(m * 16 * ZLD + n * 16)));
          uint2 w;
          w.x = pack2(lo2f(gw.x) * a0[m][n][0] * sigmoidf_(a1[m][n][0]), hi2f(gw.x) * a0[m][n][1] * sigmoidf_(a1[m][n][1]));
          w.y = pack2(lo2f(gw.y) * a0[m][n][2] * sigmoidf_(a1[m][n][2]), hi2f(gw.y) * a0[m][n][3] * sigmoidf_(a1[m][n][3]));
          *(uint2*)(P.hbuf + (hoff + (unsigned)(m * 16 * LDH + n * 16))) = w;
        }
    }
    int nbr = 3;
    asm volatile("" : "+s"(nbr));
    for (int br = 1; br < nbr; ++br) {
      f32x4 a1[4][4]; zero_acc(a1);
      const bf16_t* A = (br == 1) ? P.cv : P.ob;
      const bf16_t* B = (br == 1) ? P.Wt_conv : P.Wt_o;
      gemm_main_shallow(A + (size_t)tm * 128 * LD5, LD5, B + (size_t)tn * 128 * LD5, LD5, 512, a1, smem);
      const bf16_t* zg = P.z + ZC_MIX + br * 1024;
#pragma unroll
      for (int m = 0; m < 4; ++m)
#pragma unroll
        for (int n = 0; n < 4; ++n) {
          const uint2 gw = *(const uint2*)(zg + (eoff + (unsigned)(m * 16 * ZLD + n * 16)));
          uint2* hp = (uint2*)(P.hbuf + (hoff + (unsigned)(m * 16 * LDH + n * 16)));
          const uint2 hv = *hp;
          uint2 w;
          w.x = pack2(lo2f(hv.x) + lo2f(gw.x) * a1[m][n][0], hi2f(hv.x) + hi2f(gw.x) * a1[m][n][1]);
          w.y = pack2(lo2f(hv.y) + lo2f(gw.y) * a1[m][n][2], hi2f(hv.y) + hi2f(gw.y) * a1[m][n][3]);
          *hp = w;
        }
    }
  }
}

__device__ void s5_unit(const Params& P, int layer, int unit, char* smem) {
  const int b = unit >> 5, g = unit & 31;
  const int tid = TIDX, lane = tid & 63, w = tid >> 6, l15 = lane & 15, q4 = lane >> 4;
  const int p = lane, q = w;
  float* bu = (float*)smem;
  bf16_t* stb = (bf16_t*)(smem + 33280);
  float2* send = (float2*)(smem + 33280 + 17408);
  bf16_t* usb = (bf16_t*)(smem + 33280 + 17408 + 2048);
  const float* lam_re = P.in[3] + (size_t)layer * 32 * 64 + g * 64, *lam_im = P.in[4] + (size_t)layer * 32 * 64 + g * 64;
  const float* b_re = P.in[5] + ((size_t)layer * 32 + g) * 64 * 16, *b_im = P.in[6] + ((size_t)layer * 32 + g) * 64 * 16;
  const float* c_re = P.in[7] + ((size_t)layer * 32 + g) * 16 * 64, *c_im = P.in[8] + ((size_t)layer * 32 + g) * 16 * 64;
  const float dk = P.in[9][(size_t)layer * 512 + g * 16 + l15];
  const float dt = expf(P.in[10][layer * 32 + g]);
  float lbr, lbi, l16r, l16i;
  {
    const float lr = lam_re[p], li = lam_im[p];
    float sn, cs_; sincosf(li * dt, &sn, &cs_);
    const float e = expf(lr * dt);
    lbr = e * cs_; lbi = e * sn;
    l16r = lbr; l16i = lbi;
#pragma unroll
    for (int i = 0; i < 4; ++i) { const float tr = l16r * l16r - l16i * l16i, ti = 2.f * l16r * l16i; l16r = tr; l16i = ti; }
  }
  bf16x8 bB[2];
#pragma unroll
  for (int nt = 0; nt < 2; ++nt) {
    const int pp = (2 * w + nt) * 16 + l15, ps = pp >> 1, cpl = pp & 1;
    const float lr = lam_re[ps], li = lam_im[ps];
    float sn, cs_; sincosf(li * dt, &sn, &cs_);
    const float e = expf(lr * dt);
    const float nr = e * cs_ - 1.0f, ni = e * sn, den = lr * lr + li * li;
    const float cfr = (nr * lr + ni * li) / den, cfi = (ni * lr - nr * li) / den;
    float v[8];
#pragma unroll
    for (int j = 0; j < 8; ++j) {
      const int h = (q4 & 1) * 8 + j;
      const float br = b_re[ps * 16 + h], bi = b_im[ps * 16 + h];
      const float val = cpl ? (cfr * bi + cfi * br) : (cfr * br - cfi * bi);
      v[j] = (q4 < 2) ? val : 0.f;
    }
    union { uint32_t u[4]; bf16x8 x; } cv; cv.u[0] = pack2(v[0], v[1]); cv.u[1] = pack2(v[2], v[3]); cv.u[2] = pack2(v[4], v[5]); cv.u[3] = pack2(v[6], v[7]);
    bB[nt] = cv.x;
  }
  bf16x8 cB[4];
#pragma unroll
  for (int ks = 0; ks < 4; ++ks) {
    float v[8];
#pragma unroll
    for (int j = 0; j < 8; ++j) {
      const int pp = ks * 32 + q4 * 8 + j, ps = pp >> 1;
      v[j] = (pp & 1) ? -c_im[l15 * 64 + ps] : c_re[l15 * 64 + ps];
    }
    union { uint32_t u[4]; bf16x8 x; } cv; cv.u[0] = pack2(v[0], v[1]); cv.u[1] = pack2(v[2], v[3]); cv.u[2] = pack2(v[4], v[5]); cv.u[3] = pack2(v[6], v[7]);
    cB[ks] = cv.x;
  }
  float car_r = 0.f, car_i = 0.f;
  bf16x8 un0, un1, un2, un3;
  {
    const bf16_t* zp = P.z + ((size_t)b * SEQL + l15) * ZLD + ZC_U + g * 16 + (q4 & 1) * 8;
    un0 = *(const bf16x8*)(zp); un1 = *(const bf16x8*)(zp + (size_t)16 * ZLD); un2 = *(const bf16x8*)(zp + (size_t)32 * ZLD); un3 = *(const bf16x8*)(zp + (size_t)48 * ZLD);
  }
  for (int chunk = 0; chunk < 64; ++chunk) {
    const size_t tok0 = (size_t)b * SEQL + chunk * 64;
    {
      bf16x8 ua[4];
      const bf16x8 zz = (bf16x8){0, 0, 0, 0, 0, 0, 0, 0};
      ua[0] = (q4 < 2) ? un0 : zz; ua[1] = (q4 < 2) ? un1 : zz; ua[2] = (q4 < 2) ? un2 : zz; ua[3] = (q4 < 2) ? un3 : zz;
      if (w == 0 && q4 < 2) {
#pragma unroll
        for (int mt = 0; mt < 4; ++mt) *(bf16x8*)(usb + (chunk & 1) * 1024 + (mt * 16 + l15) * 16 + q4 * 8) = ua[mt];
      }
      if (chunk + 1 < 64) {
        const bf16_t* zp = P.z + (tok0 + 64 + l15) * ZLD + ZC_U + g * 16 + (q4 & 1) * 8;
        un0 = *(const bf16x8*)(zp); un1 = *(const bf16x8*)(zp + (size_t)16 * ZLD); un2 = *(const bf16x8*)(zp + (size_t)32 * ZLD); un3 = *(const bf16x8*)(zp + (size_t)48 * ZLD);
      }
#pragma unroll
      for (int mt = 0; mt < 4; ++mt)
#pragma unroll
        for (int nt = 0; nt < 2; ++nt) {
          const f32x4 acc = __builtin_amdgcn_mfma_f32_16x16x32_bf16(ua[mt], bB[nt], (f32x4){0.f, 0.f, 0.f, 0.f}, 0, 0, 0);
          float* dst = bu + (mt * 16 + q4 * 4) * 130 + (2 * w + nt) * 16 + l15;
          dst[0] = acc[0]; dst[130] = acc[1]; dst[260] = acc[2]; dst[390] = acc[3];
        }
    }
    __syncthreads();
    float locr[16], loci[16];
    float sr = 0.f, si = 0.f;
#pragma unroll
    for (int i = 0; i < 16; ++i) {
      const float2 v = *(const float2*)(bu + (q * 16 + i) * 130 + 2 * p);
      const float nsr = lbr * sr - lbi * si + v.x, nsi = lbr * si + lbi * sr + v.y;
      sr = nsr; si = nsi; locr[i] = sr; loci[i] = si;
    }
    send[q * 64 + p] = make_float2(sr, si);
    __syncthreads();
    float cur_r = car_r, cur_i = car_i, mine_r = 0.f, mine_i = 0.f;
#pragma unroll
    for (int qq = 0; qq < 4; ++qq) {
      if (qq == q) { mine_r = cur_r; mine_i = cur_i; }
      const float2 ev = send[qq * 64 + p];
      const float tr = l16r * cur_r - l16i * cur_i + ev.x, ti = l16r * cur_i + l16i * cur_r + ev.y;
      cur_r = tr; cur_i = ti;
    }
    car_r = cur_r; car_i = cur_i;
    float cpr = lbr * mine_r - lbi * mine_i, cpi = lbr * mine_i + lbi * mine_r;
#pragma unroll
    for (int i = 0; i < 16; ++i) {
      *(uint32_t*)(stb + (q * 16 + i) * 136 + 2 * p) = pack2(locr[i] + cpr, loci[i] + cpi);
      const float tr = lbr * cpr - lbi * cpi, ti = lbr * cpi + lbi * cpr;
      cpr = tr; cpi = ti;
    }
    __syncthreads();
    {
      f32x4 acc = (f32x4){0.f, 0.f, 0.f, 0.f};
#pragma unroll
      for (int ks = 0; ks < 4; ++ks) {
        const bf16x8 as = *(const bf16x8*)(stb + (w * 16 + l15) * 136 + ks * 32 + q4 * 8);
        acc = __builtin_amdgcn_mfma_f32_16x16x32_bf16(as, cB[ks], acc, 0, 0, 0);
      }
#pragma unroll
      for (int r = 0; r < 4; ++r) {
        const size_t t = tok0 + w * 16 + q4 * 4 + r;
        const float uval = bf2f(usb[(chunk & 1) * 1024 + (w * 16 + q4 * 4 + r) * 16 + l15]);
        const float y = gelu_tanh(acc[r] + dk * uval);
        P.ys[t * LD5 + g * 16 + l15] = (bf16_t)(pack2(y, 0.f) & 0xffffu);
      }
    }
  }
}

__device__ __forceinline__ void load8(const bf16_t* p, float (&f)[8]) {
  const uint4 w = *(const uint4*)p;
  f[0] = lo2f(w.x); f[1] = hi2f(w.x); f[2] = lo2f(w.y); f[3] = hi2f(w.y); f[4] = lo2f(w.z); f[5] = hi2f(w.z); f[6] = lo2f(w.w); f[7] = hi2f(w.w);
}
__device__ __forceinline__ void store8(bf16_t* p, const float (&f)[8]) {
  uint4 w; w.x = pack2(f[0], f[1]); w.y = pack2(f[2], f[3]); w.z = pack2(f[4], f[5]); w.w = pack2(f[6], f[7]);
  *(uint4*)p = w;
}
__device__ void prep_unit(const Params& P, int layer, int ck, char* smem) {
  const int tid = TIDX;
  const int tok0 = ck * 64, b = tok0 >> 12, s0 = tok0 & 4095;
  const bf16_t* z = P.z;
  {
    const float* cw = P.in[12] + (size_t)layer * 3 * 512;
    const int c2 = tid * 2;
    const float w00 = cw[c2], w01 = cw[c2 + 1], w10 = cw[512 + c2], w11 = cw[512 + c2 + 1], w20 = cw[1024 + c2], w21 = cw[1024 + c2 + 1];
    float p2a = 0.f, p2b = 0.f, p1a = 0.f, p1b = 0.f;
    if (s0 >= 2) {
      const uint32_t cc2 = *(const uint32_t*)(z + (size_t)(tok0 - 2) * ZLD + ZC_CC + c2), cx2 = *(const uint32_t*)(z + (size_t)(tok0 - 2) * ZLD + ZC_CX + c2);
      const uint32_t cc1 = *(const uint32_t*)(z + (size_t)(tok0 - 1) * ZLD + ZC_CC + c2), cx1 = *(const uint32_t*)(z + (size_t)(tok0 - 1) * ZLD + ZC_CX + c2);
      p2a = lo2f(cc2) * lo2f(cx2); p2b = hi2f(cc2) * hi2f(cx2); p1a = lo2f(cc1) * lo2f(cx1); p1b = hi2f(cc1) * hi2f(cx1);
    }
#pragma unroll 4
    for (int t = 0; t < 64; ++t) {
      const size_t ro = (size_t)(tok0 + t) * ZLD;
      const uint32_t cb = *(const uint32_t*)(z + ro + ZC_CB + c2), cc = *(const uint32_t*)(z + ro + ZC_CC + c2), cx = *(const uint32_t*)(z + ro + ZC_CX + c2);
      const float p0a = lo2f(cc) * lo2f(cx), p0b = hi2f(cc) * hi2f(cx);
      const float oa = lo2f(cb) * (w00 * p2a + w10 * p1a + w20 * p0a), ob_ = hi2f(cb) * (w01 * p2b + w11 * p1b + w21 * p0b);
      *(uint32_t*)(P.cv + (size_t)(tok0 + t) * LD5 + c2) = pack2(oa, ob_);
      p2a = p1a; p2b = p1b; p1a = p0a; p1b = p0b;
    }
  }
  {
    const float* qg = P.in[14] + (size_t)layer * 64;
    const int d8 = (tid & 7) * 8;
    float gq[8];
#pragma unroll
    for (int j = 0; j < 8; ++j) gq[j] = qg[d8 + j] * (0.125f * 1.44269504089f);
#pragma unroll 2
    for (int it = 0; it < 16; ++it) {
      const int row = it * 32 + (tid >> 3), t = row >> 3, h = row & 7;
      float f[8]; load8(z + (size_t)(tok0 + t) * ZLD + ZC_Q + h * 64 + d8, f);
      float ss = 0.f;
#pragma unroll
      for (int j = 0; j < 8; ++j) ss += f[j] * f[j];
      ss += __shfl_xor(ss, 1); ss += __shfl_xor(ss, 2); ss += __shfl_xor(ss, 4);
      const float r = rsqrtf(ss * (1.0f / 64.f) + RMS_EPS);
#pragma unroll
      for (int j = 0; j < 8; ++j) f[j] = f[j] * r * gq[j];
      store8(P.qn + (size_t)(tok0 + t) * 512 + h * 64 + d8, f);
    }
  }
  {
    const float* kg = P.in[15] + (size_t)layer * 3 * 64;
    const int d8 = (tid & 7) * 8;
#pragma unroll 2
    for (int it = 0; it < 8; ++it) {
      const int row = it * 32 + (tid >> 3), which = row >> 7, t = (row >> 1) & 63, kvh = row & 1;
      float f[8]; load8(z + (size_t)(tok0 + t) * ZLD + (which ? ZC_KW : ZC_KS) + kvh * 64 + d8, f);
      float ss = 0.f;
#pragma unroll
      for (int j = 0; j < 8; ++j) ss += f[j] * f[j];
      ss += __shfl_xor(ss, 1); ss += __shfl_xor(ss, 2); ss += __shfl_xor(ss, 4);
      const float r = rsqrtf(ss * (1.0f / 64.f) + RMS_EPS);
#pragma unroll
      for (int j = 0; j < 8; ++j) f[j] = f[j] * r * kg[(1 + which) * 64 + d8 + j];
      bf16_t* dst = (which ? P.kwn : P.ksn) + ((size_t)(b * 2 + kvh) * SEQL + s0 + t) * 64 + d8;
      store8(dst, f);
    }
  }
  {
    bf16_t* lt = (bf16_t*)smem;
    for (int which = 0; which < 2; ++which) {
      __syncthreads();
      {
        const int c8 = (tid & 15) * 8;
#pragma unroll
        for (int it = 0; it < 4; ++it) {
          const int t = it * 16 + (tid >> 4);
          const uint4 w = *(const uint4*)(z + (size_t)(tok0 + t) * ZLD + (which ? ZC_VW : ZC_VS) + c8);
          uint32_t* d = (uint32_t*)(lt + t * 130 + c8);
          d[0] = w.x; d[1] = w.y; d[2] = w.z; d[3] = w.w;
        }
      }
      __syncthreads();
      const int lane = tid & 63, wave = tid >> 6;
      bf16_t* dstb = which ? P.vwT : P.vsT;
#pragma unroll 4
      for (int it = 0; it < 32; ++it) {
        const int row = it * 4 + wave;
        dstb[((size_t)(b * 2) * 64 + row) * LDV + s0 + lane] = lt[lane * 130 + row];
      }
    }
  }
}
__device__ void phase_prep(const Params& P, int layer, char* smem) {
  const int bid = BIDX;
  if (bid < 32) phase_gemm_cmp1(P, smem, bid, 32);
  else if (bid < 288) { prep_unit(P, layer, bid - 32, smem); }
  else phase_convert_late(P, layer, smem, bid - 288, gridDim.x - 288);
}

__device__ void phase_cmp2(const Params& P, int layer) {
  const int lane = TIDX & 63, wave = TIDX >> 6;
  for (int wu = BIDX * 4 + wave; wu < 2048; wu += gridDim.x * 4) {
    const int which = wu >> 10, row = wu & 1023;
    const float* w2 = P.in[18] + (size_t)(layer * 2 + which) * 256 * 64;
    const bf16_t* hr = P.hid + (size_t)which * 1024 * 256 + (size_t)row * 256;
    float acc = 0.f;
#pragma unroll 8
    for (int k = 0; k < 256; ++k) acc += bf2f(hr[k]) * w2[k * 64 + lane];
    const int kvh = row & 1, bc = row >> 1, b = bc >> 7, c = bc & 127;
    if (which == 0) {
      float ss = acc * acc;
#pragma unroll
      for (int o = 32; o >= 1; o >>= 1) ss += __shfl_xor(ss, o);
      const float r = rsqrtf(ss * (1.0f / 64.f) + RMS_EPS);
      const float v = acc * r * P.in[15][(size_t)layer * 3 * 64 + lane];
      P.kc[((size_t)(b * 2 + kvh) * 128 + c) * 64 + lane] = (bf16_t)(pack2(v, 0.f) & 0xffff);
    } else {
      P.vcT[((size_t)(b * 2 + kvh) * 64 + lane) * 128 + c] = (bf16_t)(pack2(acc, 0.f) & 0xffff);
    }
  }
}

#define NEGBIG (-1e30f)
#define NQ 2
__device__ __forceinline__ void attn_load_tiles(const bf16_t* __restrict__ Kp, const bf16_t* __restrict__ Vp, int vstride, char* KT, char* VT) {
  const int tid = TIDX;
  const int row = tid >> 3, ch = tid & 7;
  const int so = lds_off(row, ch);
  const uint4 k0 = *(const uint4*)(Kp + (size_t)row * 64 + ch * 8), k1 = *(const uint4*)(Kp + (size_t)(row + 32) * 64 + ch * 8);
  const uint4 v0 = *(const uint4*)(Vp + (size_t)row * vstride + ch * 8), v1 = *(const uint4*)(Vp + (size_t)(row + 32) * vstride + ch * 8);
  *(uint4*)(KT + so) = k0; *(uint4*)(KT + so + 4096) = k1;
  *(uint4*)(VT + so) = v0; *(uint4*)(VT + so + 4096) = v1;
}
#define KV_ISSUE(Kp, Vp, vstride) do { const int tid_ = TIDX; const int row_ = tid_ >> 3, ch_ = tid_ & 7; \
    rk0 = *(const uint4*)((Kp) + (size_t)row_ * 64 + ch_ * 8); rk1 = *(const uint4*)((Kp) + (size_t)(row_ + 32) * 64 + ch_ * 8); \
    rv0 = *(const uint4*)((Vp) + (size_t)row_ * (vstride) + ch_ * 8); rv1 = *(const uint4*)((Vp) + (size_t)(row_ + 32) * (vstride) + ch_ * 8); } while (0)
#define KV_STORE() do { const int tid_ = TIDX; const int so_ = lds_off(tid_ >> 3, tid_ & 7); \
    *(uint4*)(KT + so_) = rk0; *(uint4*)(KT + so_ + 4096) = rk1; *(uint4*)(VT + so_) = rv0; *(uint4*)(VT + so_ + 4096) = rv1; } while (0)
__device__ __forceinline__ void attn_scores(const char* KT, int kfr0, const bf16x8 (&qf)[NQ][2], f32x4 (&S)[4][NQ]) {
#pragma unroll
  for (int mk = 0; mk < 4; ++mk)
#pragma unroll
    for (int nq = 0; nq < NQ; ++nq) S[mk][nq] = (f32x4){0.f, 0.f, 0.f, 0.f};
#pragma unroll
  for (int ks = 0; ks < 2; ++ks) {
    const char* pk = KT + (kfr0 ^ (ks * 64));
#pragma unroll
    for (int mk = 0; mk < 4; ++mk) {
      const bf16x8 kf = *(const bf16x8*)(pk + mk * 2048);
#pragma unroll
      for (int nq = 0; nq < NQ; ++nq) S[mk][nq] = __builtin_amdgcn_mfma_f32_16x16x32_bf16(kf, qf[nq][ks], S[mk][nq], 0, 0, 0);
    }
  }
}
__device__ __forceinline__ void attn_pv(const char* VT, int vfr0, const f32x4 (&S)[4][NQ], f32x4 (&O)[4][NQ]) {
#pragma unroll
  for (int s2 = 0; s2 < 2; ++s2) {
    bf16x8 pf[NQ];
#pragma unroll
    for (int nq = 0; nq < NQ; ++nq) {
      union { uint32_t u[4]; bf16x8 v; } cvt;
      cvt.u[0] = pack2(S[2 * s2][nq][0], S[2 * s2][nq][1]); cvt.u[1] = pack2(S[2 * s2][nq][2], S[2 * s2][nq][3]);
      cvt.u[2] = pack2(S[2 * s2 + 1][nq][0], S[2 * s2 + 1][nq][1]); cvt.u[3] = pack2(S[2 * s2 + 1][nq][2], S[2 * s2 + 1][nq][3]);
      pf[nq] = cvt.v;
    }
    const char* pv0 = VT + (vfr0 ^ (s2 * 64));
    const char* pv1 = VT + (vfr0 ^ (s2 * 64) ^ 32);
#pragma unroll
    for (int md = 0; md < 4; ++md) {
      union { uint2 h[2]; bf16x8 v; } vv;
      vv.h[0] = *(const uint2*)(pv0 + md * 2048);
      vv.h[1] = *(const uint2*)(pv1 + md * 2048);
#pragma unroll
      for (int nq = 0; nq < NQ; ++nq) O[md][nq] = __builtin_amdgcn_mfma_f32_16x16x32_bf16(vv.v, pf[nq], O[md][nq], 0, 0, 0);
    }
  }
}
__device__ __forceinline__ void attn_mask(f32x4 (&S)[4][NQ], int mode, int selbits, int hb, int posbase, int kbase, int l15, int q4) {
#pragma unroll
  for (int nq = 0; nq < NQ; ++nq) {
    const int rr = nq * 16 + l15;
    const bool rs = (selbits >> nq) & 1;
    const int lim = (posbase + rr + 1) >> 5;
#pragma unroll
    for (int mk = 0; mk < 4; ++mk)
#pragma unroll
      for (int r = 0; r < 4; ++r) {
        const int kk = mk * 16 + q4 * 4 + r;
        bool valid = rs;
        if (mode == 1) valid = valid && (kk <= hb + rr);
        else if (mode == 2) valid = valid && (kk > hb + rr);
        else if (mode == 3) valid = valid && (kbase + kk < lim);
        S[mk][nq][r] = valid ? S[mk][nq][r] : NEGBIG;
      }
  }
}
__device__ __forceinline__ void attn_softmax_step(f32x4 (&S)[4][NQ], float (&m)[NQ], float (&l)[NQ], f32x4 (&O)[4][NQ], bool rescale) {
#pragma unroll
  for (int nq = 0; nq < NQ; ++nq) {
    float mx = NEGBIG;
#pragma unroll
    for (int mk = 0; mk < 4; ++mk)
#pragma unroll
      for (int r = 0; r < 4; ++r) mx = fmaxf(mx, S[mk][nq][r]);
    mx = fmaxf(mx, __shfl_xor(mx, 16)); mx = fmaxf(mx, __shfl_xor(mx, 32));
    const float mnew = fmaxf(m[nq], mx);
    const float alpha = __builtin_amdgcn_exp2f(m[nq] - mnew);
    m[nq] = mnew;
    const float muse = fmaxf(mnew, -1e28f);
    float ps = 0.f;
#pragma unroll
    for (int mk = 0; mk < 4; ++mk)
#pragma unroll
      for (int r = 0; r < 4; ++r) {
        const float pv = __builtin_amdgcn_exp2f(S[mk][nq][r] - muse);
        ps += pv; S[mk][nq][r] = pv;
      }
    l[nq] = l[nq] * alpha + ps;
    if (rescale && __ballot(alpha != 1.0f) != 0ull) {
#pragma unroll
      for (int md = 0; md < 4; ++md) O[md][nq] *= alpha;
    }
  }
}
__device__ __forceinline__ void attn_reset(float (&m)[NQ], float (&l)[NQ], f32x4 (&O)[4][NQ]) {
#pragma unroll
  for (int nq = 0; nq < NQ; ++nq) { m[nq] = NEGBIG; l[nq] = 0.f; }
#pragma unroll
  for (int md = 0; md < 4; ++md)
#pragma unroll
    for (int nq = 0; nq < NQ; ++nq) O[md][nq] = (f32x4){0.f, 0.f, 0.f, 0.f};
}

__device__ void attn_unit(const Params& P, int unit, char* smem) {
  const int c32 = 127 - (unit >> 3);
  const int bk = unit & 7, b = bk >> 1, kvh = bk & 1;
  const int c = c32 >> 1, hb = (c32 & 1) * 32, posbase = c32 * 32;
  const int tid = TIDX, lane = tid & 63, g = tid >> 6, l15 = lane & 15, q4 = lane >> 4;
  const int h = kvh * 4 + g;
  const size_t tok0 = (size_t)b * SEQL + posbase;
  char* KT = smem;
  char* VT = smem + 8192;
  float* IMP = (float*)(smem + 16384);
  uint32_t* MASK = (uint32_t*)(smem + 16384 + 32 * 65 * 4);
  float* scratch = (float*)P.hbuf;
  const int sw = (l15 >> 1) & 7;
  const int kfr0 = l15 * 128 + (((q4 ^ (sw & 3)) << 4) | ((sw >> 2) << 6));
  const int vfr0 = l15 * 128 + ((((q4 >> 1) ^ (sw & 1)) | (sw & 6)) << 4) + (q4 & 1) * 8;

  bf16x8 qf[NQ][2];
#pragma unroll
  for (int nq = 0; nq < NQ; ++nq)
#pragma unroll
    for (int ks = 0; ks < 2; ++ks) qf[nq][ks] = *(const bf16x8*)(P.qn + (tok0 + nq * 16 + l15) * 512 + h * 64 + ks * 32 + q4 * 8);

  f32x4 S[4][NQ], O[4][NQ];
  float m[NQ], l[NQ];
  const bf16_t* kcb = P.kc + (size_t)(b * 2 + kvh) * 128 * 64;
  const bf16_t* vcb = P.vcT + (size_t)(b * 2 + kvh) * 64 * 128;
  const int njb = (c32 + 1 + 63) >> 6;
  attn_reset(m, l, O);

  uint4 rk0, rk1, rv0, rv1;
  KV_ISSUE(kcb, vcb, 128);
  for (int jb = 0; jb < njb; ++jb) {
    __syncthreads();
    KV_STORE();
    __syncthreads();
    { const int jn = (jb + 1 < njb) ? jb + 1 : 0; KV_ISSUE(kcb + (size_t)jn * 64 * 64, vcb + jn * 64, 128); }
    __builtin_amdgcn_sched_barrier(0);
    attn_scores(KT, kfr0, qf, S);
    attn_mask(S, 3, 3, hb, posbase, jb * 64, l15, q4);
    attn_softmax_step(S, m, l, O, false);
  }
  float invl[NQ];
#pragma unroll
  for (int nq = 0; nq < NQ; ++nq) { float lt = l[nq]; lt += __shfl_xor(lt, 16); lt += __shfl_xor(lt, 32); invl[nq] = 1.0f / fmaxf(lt, 1e-30f); }
  for (int jb = 0; jb < njb; ++jb) {
    __syncthreads();
    KV_STORE();
    __syncthreads();
    { const int jn = (jb + 1 < njb) ? jb + 1 : jb; KV_ISSUE(kcb + (size_t)jn * 64 * 64, vcb + jn * 64, 128); }
    __builtin_amdgcn_sched_barrier(0);
    attn_scores(KT, kfr0, qf, S);
    attn_mask(S, 3, 3, hb, posbase, jb * 64, l15, q4);
#pragma unroll
    for (int nq = 0; nq < NQ; ++nq)
#pragma unroll
      for (int mk = 0; mk < 4; ++mk)
#pragma unroll
        for (int r = 0; r < 4; ++r) S[mk][nq][r] = __builtin_amdgcn_exp2f(S[mk][nq][r] - fmaxf(m[nq], -1e28f)) * invl[nq];
    for (int gg = 0; gg < 4; ++gg) {
      if (g == gg) {
#pragma unroll
        for (int nq = 0; nq < NQ; ++nq)
#pragma unroll
          for (int mk = 0; mk < 4; ++mk) {
            float* ip = IMP + (nq * 16 + l15) * 65 + jb * 32 + mk * 8 + q4 * 2;
            const float v0 = S[mk][nq][0] + S[mk][nq][1], v1 = S[mk][nq][2] + S[mk][nq][3];
            if (gg == 0) { ip[0] = v0; ip[1] = v1; } else { ip[0] += v0; ip[1] += v1; }
          }
      }
      __syncthreads();
    }
    attn_pv(VT, vfr0, S, O);
  }
#pragma unroll
  for (int nq = 0; nq < NQ; ++nq) {
    const float g0 = sigmoidf_(bf2f(P.z[(tok0 + nq * 16 + l15) * ZLD + ZC_NG + h * 3 + 0]));
#pragma unroll
    for (int md = 0; md < 4; ++md) {
      float4 v; v.x = O[md][nq][0] * g0; v.y = O[md][nq][1] * g0; v.z = O[md][nq][2] * g0; v.w = O[md][nq][3] * g0;
      *(float4*)(scratch + (tok0 + nq * 16 + l15) * LDS_F + h * 64 + md * 16 + q4 * 4) = v;
    }
  }
  __syncthreads();
  for (int i = 0; i < 8; ++i) {
    const int rr = g * 8 + i;
    const float v = IMP[rr * 65 + lane];
    const bool visible = lane <= c;
    const bool forced = (lane == 0) || (lane == c) || (lane == c - 1);
    const float val = forced ? 1e4f : (visible ? v : -INFINITY);
    int rank = 0;
#pragma unroll
    for (int j = 0; j < 64; ++j) {
      const float vj = __int_as_float(__builtin_amdgcn_readlane(__float_as_int(val), j));
      rank += ((vj > val) || (vj == val && j < lane)) ? 1 : 0;
    }
    const bool sel = (rank < 16) && visible;
    const unsigned long long mk = __ballot(sel);
    if (lane == 0) { MASK[rr * 2] = (uint32_t)mk; MASK[rr * 2 + 1] = (uint32_t)(mk >> 32); }
  }
  __syncthreads();
  uint32_t ulo = MASK[(lane & 31) * 2], uhi = MASK[(lane & 31) * 2 + 1];
#pragma unroll
  for (int o = 16; o >= 1; o >>= 1) { ulo |= __shfl_xor(ulo, o); uhi |= __shfl_xor(uhi, o); }
  ulo = __builtin_amdgcn_readfirstlane(ulo); uhi = __builtin_amdgcn_readfirstlane(uhi);
  unsigned long long rem = ((unsigned long long)uhi << 32) | ulo;
  unsigned long long mrow[NQ];
#pragma unroll
  for (int nq = 0; nq < NQ; ++nq) mrow[nq] = ((unsigned long long)MASK[(nq * 16 + l15) * 2 + 1] << 32) | MASK[(nq * 16 + l15) * 2];

  attn_reset(m, l, O);
  {
    const bf16_t* kb = P.ksn + (size_t)(b * 2 + kvh) * SEQL * 64;
    const bf16_t* vb = P.vsT + (size_t)(b * 2 + kvh) * 64 * LDV;
    int j = __builtin_ctzll(rem);
    rem &= rem - 1;
    KV_ISSUE(kb + (size_t)j * 64 * 64, vb + j * 64, LDV);
    __syncthreads();
    KV_STORE();
    bool last = (rem == 0);
    int jn = last ? j : __builtin_ctzll(rem);
    rem &= rem - 1;
    KV_ISSUE(kb + (size_t)jn * 64 * 64, vb + jn * 64, LDV);
    __syncthreads();
    int pb = 0;
    for (;;) {
      const char* KTc = smem + pb * 32768; const char* VTc = KTc + 8192;
      __builtin_amdgcn_sched_barrier(0);
      attn_scores(KTc, kfr0, qf, S);
      int selbits = 0;
#pragma unroll
      for (int nq = 0; nq < NQ; ++nq) selbits |= (int)((mrow[nq] >> j) & 1ull) << nq;
      if (j == c) attn_mask(S, 1, selbits, hb, posbase, 0, l15, q4); else attn_mask(S, 0, selbits, hb, posbase, 0, l15, q4);
      attn_softmax_step(S, m, l, O, true);
      attn_pv(VTc, vfr0, S, O);
      if (last) break;
      { char* KT = smem + (pb ^ 1) * 32768; char* VT = KT + 8192; KV_STORE(); }
      j = jn; last = (rem == 0); jn = last ? j : __builtin_ctzll(rem); rem &= rem - 1;
      KV_ISSUE(kb + (size_t)jn * 64 * 64, vb + jn * 64, LDV);
      __syncthreads();
      pb ^= 1;
    }
  }
#pragma unroll
  for (int nq = 0; nq < NQ; ++nq) {
    float lt = l[nq]; lt += __shfl_xor(lt, 16); lt += __shfl_xor(lt, 32);
    const float sc = sigmoidf_(bf2f(P.z[(tok0 + nq * 16 + l15) * ZLD + ZC_NG + h * 3 + 1])) / fmaxf(lt, 1e-30f);
#pragma unroll
    for (int md = 0; md < 4; ++md) {
      float4* p = (float4*)(scratch + (tok0 + nq * 16 + l15) * LDS_F + h * 64 + md * 16 + q4 * 4);
      float4 v = *p;
      v.x += O[md][nq][0] * sc; v.y += O[md][nq][1] * sc; v.z += O[md][nq][2] * sc; v.w += O[md][nq][3] * sc;
      *p = v;
    }
  }
  attn_reset(m, l, O);
  {
    const bf16_t* kb = P.kwn + (size_t)(b * 2 + kvh) * SEQL * 64;
    const bf16_t* vb = P.vwT + (size_t)(b * 2 + kvh) * 64 * LDV;
    const int j0 = (c - 8 > 0) ? (c - 8) : 0;
    int j = j0;
    KV_ISSUE(kb + (size_t)j * 64 * 64, vb + j * 64, LDV);
    __syncthreads();
    KV_STORE();
    int jn = (j < c) ? j + 1 : j;
    KV_ISSUE(kb + (size_t)jn * 64 * 64, vb + jn * 64, LDV);
    __syncthreads();
    int pb = 0;
    for (;;) {
      const char* KTc = smem + pb * 32768; const char* VTc = KTc + 8192;
      __builtin_amdgcn_sched_barrier(0);
      attn_scores(KTc, kfr0, qf, S);
      if (j == c) attn_mask(S, 1, 3, hb, posbase, 0, l15, q4);
      else if (j == c - 8) attn_mask(S, 2, 3, hb, posbase, 0, l15, q4);
      attn_softmax_step(S, m, l, O, true);
      attn_pv(VTc, vfr0, S, O);
      if (j == c) break;
      { char* KT = smem + (pb ^ 1) * 32768; char* VT = KT + 8192; KV_STORE(); }
      j = jn; jn = (j < c) ? j + 1 : j;
      KV_ISSUE(kb + (size_t)jn * 64 * 64, vb + jn * 64, LDV);
      __syncthreads();
      pb ^= 1;
    }
  }
#pragma unroll
  for (int nq = 0; nq < NQ; ++nq) {
    float lt = l[nq]; lt += __shfl_xor(lt, 16); lt += __shfl_xor(lt, 32);
    const float sc = sigmoidf_(bf2f(P.z[(tok0 + nq * 16 + l15) * ZLD + ZC_NG + h * 3 + 2])) / fmaxf(lt, 1e-30f);
#pragma unroll
    for (int md = 0; md < 4; ++md) {
      const float4 v = *(const float4*)(scratch + (tok0 + nq * 16 + l15) * LDS_F + h * 64 + md * 16 + q4 * 4);
      uint2 w; w.x = pack2(v.x + O[md][nq][0] * sc, v.y + O[md][nq][1] * sc); w.y = pack2(v.z + O[md][nq][2] * sc, v.w + O[md][nq][3] * sc);
      *(uint2*)(P.ob + (tok0 + nq * 16 + l15) * LD5 + h * 64 + md * 16 + q4 * 4) = w;
    }
  }
}
__device__ void phase_attn_s5(const Params& P, int layer, char* smem, int pass) {
  if (BIDX < 128) { s5_unit(P, layer, BIDX, smem); }
  unsigned* ctr = P.bar + 3600 + (layer * 2 + pass) * 56;
  volatile int* slot = (volatile int*)(smem + 65024);
  for (;;) {
    __syncthreads();
    if (threadIdx.x == 0) *slot = (int)atomicAdd(ctr, 1u);
    __syncthreads();
    const int u = __builtin_amdgcn_readfirstlane(*slot);
    if (u >= 1024) break;
    attn_unit(P, u, smem);
  }
}

#define NPHASE 11
__device__ __forceinline__ void run_phase(const Params& P, int layer, int ph, char* smem, float alpha = 1.0f) {
  switch (ph) {
    case 0: phase_convert(P, layer, smem); phase_cmp_bias(P, layer);
            phase_rmsnorm(layer == 0 ? P.in[0] : P.x, layer == 0 ? P.x : nullptr, P.in[1] + (size_t)layer * DM, P.hbuf); break;
    case 1: phase_gemm_in(P, smem); break;
    case 2: phase_prep(P, layer, smem); break;
    case 3: break;
    case 4: phase_cmp2(P, layer); break;
    case 5: phase_attn_s5(P, layer, smem, alpha == 0.0f ? 1 : 0); break;
    case 6: phase_merge(P, smem); break;
    case 7: phase_gemm_resid(P, P.hbuf, LDH, P.Wt_out, DM, smem, alpha); break;
    case 8: phase_rmsnorm(P.x, nullptr, P.in[21] + (size_t)layer * DM, P.hbuf); break;
    case 9: phase_gemm_gateup(P, smem); break;
    case 10: phase_gemm_resid(P, P.z, LDA, P.Wt_down, DFF, smem, alpha); break;
  }
}

#ifndef REPEAT_MASK
#define REPEAT_MASK 0
#endif
#if !MEGA
__global__ void __launch_bounds__(256, 2) k_phase(Params P, int layer, int ph) {
  __shared__ __attribute__((aligned(16))) char smem[65536];
  run_phase(P, layer, ph, smem);
}
#else
#define XB_TMO      128
#define XB_XCNT(j)  (256  + 64 * (j))
#define XB_XSUB(j)  (1280 + 64 * (j))
#define XB_XGEN(j)  (2304 + 64 * (j))
#define XB_TOP      3328
#define XB_TOPGEN   3392
#define XCD_BAR_WORDS 3456
#define XB_SPIN_CAP (1u << 22)
__device__ __forceinline__ unsigned xb_ld(unsigned* p)              { return __hip_atomic_load(p, __ATOMIC_RELAXED, __HIP_MEMORY_SCOPE_AGENT); }
__device__ __forceinline__ unsigned xb_add(unsigned* p, unsigned v) { return __hip_atomic_fetch_add(p, v, __ATOMIC_RELAXED, __HIP_MEMORY_SCOPE_AGENT); }
__device__ __forceinline__ unsigned xb_xcc_id() { return (unsigned)__builtin_amdgcn_s_getreg((3 << 11) | 20) & 0xFu; }
#define XB_SPIN(cond, bar) do { unsigned _sp = 0; while (cond) { __builtin_amdgcn_s_sleep(1); \
    if ((++_sp & 255u) == 0u) { if (xb_ld(&(bar)[XB_TMO])) break; if (_sp > XB_SPIN_CAP) { atomicAdd(&(bar)[XB_TMO], 1u); break; } } } } while (0)
struct XcdBarrier { unsigned* bar; unsigned x, nloc, nx; };
__device__ __forceinline__ void xcd_barrier_complete(unsigned* bar, unsigned x, unsigned& nloc, unsigned& nx) {
  const unsigned G = gridDim.x;
  unsigned sum, cnt, mine, sp = 0u;
  for (;;) {
    sum = 0u; cnt = 0u; mine = 0u;
#pragma unroll
    for (unsigned j = 0; j < 16; ++j) { const unsigned c = xb_ld(&bar[XB_XCNT(j)]); sum += c; cnt += (c > 0u) ? 1u : 0u; mine = (j == x) ? c : mine; }
    if (sum == G) break;
    __builtin_amdgcn_s_sleep(1);
    if ((++sp & 255u) == 0u) { if (xb_ld(&bar[XB_TMO])) break; if (sp > XB_SPIN_CAP) { atomicAdd(&bar[XB_TMO], 1u); break; } }
  }
  nloc = mine > 0u ? mine : 1u; nx = cnt > 0u ? cnt : 1u;
}
__device__ __forceinline__ void xcd_barrier(const XcdBarrier& b) {
  asm volatile("s_waitcnt vmcnt(0)" ::: "memory");
  __syncthreads();
  if (threadIdx.x == 0) {
    unsigned* bar = b.bar;
    __builtin_amdgcn_s_waitcnt(0);
    const unsigned nloc = b.nloc, nx = b.nx;
    const unsigned old = xb_add(&bar[XB_XSUB(b.x)], 1u);
    const unsigned gen = old / nloc;
    if (old + 1u == (gen + 1u) * nloc) {
      __builtin_amdgcn_fence(__ATOMIC_RELEASE, "agent");
      asm volatile("s_waitcnt vmcnt(0)" ::: "memory");
      const unsigned og = xb_add(&bar[XB_TOP], 1u);
      const unsigned tg = og / nx;
      if (og + 1u == (tg + 1u) * nx) xb_add(&bar[XB_TOPGEN], 1u);
      else XB_SPIN(xb_ld(&bar[XB_TOPGEN]) == tg, bar);
      __builtin_amdgcn_fence(__ATOMIC_ACQUIRE, "agent");
      xb_add(&bar[XB_XGEN(b.x)], 1u);
      asm volatile("s_waitcnt vmcnt(0)" ::: "memory");
    } else {
      XB_SPIN(xb_ld(&bar[XB_XGEN(b.x)]) == gen, bar);
      __builtin_amdgcn_fence(__ATOMIC_ACQUIRE, "agent");
      asm volatile("s_waitcnt vmcnt(0)" ::: "memory");
    }
  }
  __syncthreads();
}

__global__ void __launch_bounds__(256, 2) k_mega(Params P) {
  __shared__ __attribute__((aligned(16))) char smem[65536];
  if (P.x == nullptr) { cg::this_grid().sync(); }
  XcdBarrier xb; xb.bar = P.bar; xb.x = xb_xcc_id(); xb.nloc = 1u; xb.nx = 1u;
  if (threadIdx.x == 0) { (void)xb_add(&P.bar[XB_XCNT(xb.x)], 1u); xcd_barrier_complete(P.bar, xb.x, xb.nloc, xb.nx); }
  for (int layer = 0; layer < DEPTH; ++layer) {
    for (int ph = 0; ph < NPHASE; ++ph) {
      if (ph == 3) continue;
      run_phase(P, layer, ph, smem);
      if ((REPEAT_MASK >> ph) & 1) { xcd_barrier(xb); run_phase(P, layer, ph, smem, 0.0f); }
      if (!(layer == DEPTH - 1 && ph == NPHASE - 1)) xcd_barrier(xb);
    }
  }
}
#endif

extern "C" void kernel_launch(void* const* d_in, const int* in_sizes, int n_in, void* d_out, int out_size, void* d_ws, size_t ws_size, hipStream_t stream) {
  Params P;
  memset(&P, 0, sizeof(P));
  for (int i = 0; i < 24; ++i) P.in[i] = (const float*)d_in[i];
  P.x = (float*)d_out;
  char* w = (char*)d_ws;
  size_t off = 0;
  auto take = [&](size_t bytes) { char* p = w + off; off += (bytes + 255) & ~(size_t)255; return (bf16_t*)p; };
  P.Wt_in = take((size_t)ZLD * LDH * 2);
  P.Wt_glu = take((size_t)2048 * LD5 * 2);
  P.Wt_conv = take((size_t)1024 * LD5 * 2);
  P.Wt_o = take((size_t)1024 * LD5 * 2);
  P.Wt_out = take((size_t)1024 * LDH * 2);
  P.Wt_gu = take((size_t)5632 * LDH * 2);
  P.Wt_down = take((size_t)1024 * LDA * 2);
  P.Wt_c1 = take((size_t)512 * LDC * 2);
  P.z = take((size_t)T_TOK * ZLD * 2);
  P.hbuf = take((size_t)T_TOK * LDH * 2);
  P.ys = take((size_t)T_TOK * LD5 * 2);
  P.cv = take((size_t)T_TOK * LD5 * 2);
  P.ob = take((size_t)T_TOK * LD5 * 2);
  P.qn = take((size_t)T_TOK * 512 * 2);
  P.ksn = take((size_t)T_TOK * 128 * 2);
  P.kwn = take((size_t)T_TOK * 128 * 2);
  P.vsT = take((size_t)8 * 64 * LDV * 2);
  P.vwT = take((size_t)8 * 64 * LDV * 2);
  P.acmp = take((size_t)2 * 1024 * LDC * 2);
  P.hid = take((size_t)2 * 1024 * 256 * 2);
  P.kc = take((size_t)8 * 128 * 64 * 2);
  P.vcT = take((size_t)8 * 64 * 128 * 2);
  P.bar = (unsigned*)take((size_t)4096 * 4);
  P.cbias = (float*)take((size_t)512 * 4);
  if (off > ws_size) { fprintf(stderr, "kernel_launch: workspace too small: need %zu have %zu\n", off, ws_size); return; }
#if MEGA
  static int grid_blocks = 0;
  if (!grid_blocks) {
    int dev = 0, cus = 0, per_cu = 0;
    hipGetDevice(&dev);
    hipDeviceGetAttribute(&cus, hipDeviceAttributeMultiprocessorCount, dev);
    hipOccupancyMaxActiveBlocksPerMultiprocessor(&per_cu, k_mega, 256, 0);
    (void)per_cu;
    grid_blocks = cus * 2;
  }
  hipMemsetAsync(P.bar, 0, 4096 * 4, stream);
  void* args[] = {&P};
  hipError_t e = hipLaunchCooperativeKernel((void*)k_mega, dim3(grid_blocks), dim3(256), args, 0, stream);
  if (e != hipSuccess) fprintf(stderr, "cooperative launch failed: %s (grid %d)\n", hipGetErrorString(e), grid_blocks);
#else
  for (int layer = 0; layer < DEPTH; ++layer)
    for (int ph = 0; ph < NPHASE; ++ph) {
      hipLaunchKernelGGL(k_phase, dim3(512), dim3(256), 0, stream, P, layer, ph);
      if ((REPEAT_MASK >> ph) & 1) hipLaunchKernelGGL(k_phase, dim3(512), dim3(256), 0, stream, P, layer, ph);
    }
#endif
}
```

```cpp
#include <hip/hip_runtime.h>
#include <hip/hip_cooperative_groups.h>
#include <stdint.h>
#include <cstdio>
#include <cstring>
namespace cg = cooperative_groups;

#ifndef MEGA
#define MEGA 1
#endif

typedef unsigned short bf16_t;
typedef short bf16x8 __attribute__((ext_vector_type(8)));
typedef float f32x4 __attribute__((ext_vector_type(4)));

#define T_TOK 16384
#define SEQL 4096
#define DM 1024
#define ZLD 6528
#define NIN 6424
#define DFF 2816
#define DEPTH 4
#define LDH 1088
#define LD5 576
#define LDA 2880
#define LDC 2112
#define LDV 4160
#define LDS_F 544
#define ZC_U 0
#define ZC_CB 512
#define ZC_CC 1024
#define ZC_CX 1536
#define ZC_Q 2048
#define ZC_KC 2560
#define ZC_VC 2688
#define ZC_KS 2816
#define ZC_VS 2944
#define ZC_KW 3072
#define ZC_VW 3200
#define ZC_MIX 3328
#define ZC_NG 6400
#define RMS_EPS 1e-6f

struct Params {
  const float* in[24];
  float* x;
  bf16_t *Wt_in, *Wt_glu, *Wt_conv, *Wt_o, *Wt_out, *Wt_gu, *Wt_down, *Wt_c1;
  bf16_t *z, *hbuf, *ys, *cv, *ob, *qn, *ksn, *kwn, *vsT, *vwT, *acmp, *hid, *kc, *vcT;
  unsigned* bar;
  float* cbias;
};

__device__ __forceinline__ int tidx_() { int t = threadIdx.x; asm volatile("" : "+v"(t)); return t; }
__device__ __forceinline__ int bidx_() { int t = blockIdx.x; asm volatile("" : "+s"(t)); return t; }
#define TIDX tidx_()
#define BIDX bidx_()
__device__ __forceinline__ float bf2f(bf16_t b) { return __uint_as_float(((uint32_t)b) << 16); }
__device__ __forceinline__ uint32_t pack2(float lo, float hi) {
  uint32_t r; asm("v_cvt_pk_bf16_f32 %0, %1, %2" : "=v"(r) : "v"(lo), "v"(hi)); return r;
}
__device__ __forceinline__ float lo2f(uint32_t w) { return __uint_as_float(w << 16); }
__device__ __forceinline__ float hi2f(uint32_t w) { return __uint_as_float(w & 0xffff0000u); }
__device__ __forceinline__ float sigmoidf_(float x) { return __builtin_amdgcn_rcpf(1.0f + __expf(-x)); }
__device__ __forceinline__ float gelu_tanh(float x) { return x * sigmoidf_(1.5957691216f * (x + 0.044715f * x * x * x)); }
__device__ __forceinline__ int lds_off(int row, int ch) { return row * 128 + ((ch ^ ((row >> 1) & 7)) << 4); }

__device__ void conv_job(const float* __restrict__ src, int K, int Nsrc, int col0, int ncols, bf16_t* __restrict__ dst, int drow0, float* lt, int b0, int bs, int mode = 0) {
  const int tid = TIDX;
  const int kt = K >> 6, nt = (ncols + 63) >> 6;
  for (int tile = b0; tile < kt * nt; tile += bs) {
    const int tk = tile % kt, tn = tile / kt;
    const int nl = tid & 63, kl = tid >> 6;
    const int n = tn * 64 + nl;
#pragma unroll
    for (int i = 0; i < 16; ++i) {
      const int k = kl + 4 * i;
      int sc = col0 + n;
      if (mode == 1) { const int t = n >> 7, r = n & 127, wc = r >> 6, nn = (r & 63) >> 4, ii = r & 15; sc = ((nn < 2) ? 0 : DFF) + t * 64 + wc * 32 + (nn & 1) * 16 + ii; }
      float v = (n < ncols) ? src[(size_t)(tk * 64 + k) * Nsrc + sc] : 0.f;
      lt[nl * 65 + k] = v;
    }
    __syncthreads();
    const int k8 = (tid & 7) * 8, n2 = tid >> 3;
#pragma unroll
    for (int i = 0; i < 2; ++i) {
      const int nn = n2 + 32 * i;
      if (tn * 64 + nn < ncols) {
        const float* r = lt + nn * 65 + k8;
        uint4 w;
        w.x = pack2(r[0], r[1]); w.y = pack2(r[2], r[3]); w.z = pack2(r[4], r[5]); w.w = pack2(r[6], r[7]);
        *(uint4*)(dst + (size_t)(drow0 + tn * 64 + nn) * (K + 64) + tk * 64 + k8) = w;
      }
    }
    __syncthreads();
  }
}

__device__ void phase_convert(const Params& P, int layer, char* smem) {
  float* lt = (float*)smem;
  const int b0 = BIDX, bs = gridDim.x;
  const float* w_in = P.in[2] + (size_t)layer * DM * NIN;
  conv_job(w_in, DM, NIN, 0, 3328, P.Wt_in, 0, lt, b0, bs);
  conv_job(w_in, DM, NIN, 3352, 3072, P.Wt_in, ZC_MIX, lt, b0, bs);
  conv_job(w_in, DM, NIN, 3328, 24, P.Wt_in, ZC_NG, lt, b0, bs);
  conv_job(P.in[17] + (size_t)(layer * 2 + 0) * 2048 * 256, 2048, 256, 0, 256, P.Wt_c1, 0, lt, b0, bs);
  conv_job(P.in[17] + (size_t)(layer * 2 + 1) * 2048 * 256, 2048, 256, 0, 256, P.Wt_c1, 256, lt, b0, bs);
}
__device__ void phase_convert_late(const Params& P, int layer, char* smem, int b0, int bs) {
  float* lt = (float*)smem;
  conv_job(P.in[11] + (size_t)layer * 512 * 2048, 512, 2048, 0, 2048, P.Wt_glu, 0, lt, b0, bs);
  conv_job(P.in[13] + (size_t)layer * 512 * 1024, 512, 1024, 0, 1024, P.Wt_conv, 0, lt, b0, bs);
  conv_job(P.in[19] + (size_t)layer * 512 * 1024, 512, 1024, 0, 1024, P.Wt_o, 0, lt, b0, bs);
  conv_job(P.in[20] + (size_t)layer * 1024 * 1024, 1024, 1024, 0, 1024, P.Wt_out, 0, lt, b0, bs);
  conv_job(P.in[22] + (size_t)layer * 1024 * 5632, 1024, 5632, 0, 5632, P.Wt_gu, 0, lt, b0, bs, 1);
  conv_job(P.in[23] + (size_t)layer * DFF * 1024, DFF, 1024, 0, 1024, P.Wt_down, 0, lt, b0, bs);
}

__device__ void phase_rmsnorm(const float* __restrict__ xin, float* __restrict__ xcopy, const float* __restrict__ g, bf16_t* __restrict__ out) {
  const int lane = TIDX & 63, wave = TIDX >> 6;
  for (int tok = BIDX * 4 + wave; tok < T_TOK; tok += gridDim.x * 4) {
    const float4* xr = (const float4*)(xin + (size_t)tok * DM);
    float4 v[4];
    float ss = 0.f;
#pragma unroll
    for (int i = 0; i < 4; ++i) { v[i] = xr[lane + 64 * i]; ss += v[i].x * v[i].x + v[i].y * v[i].y + v[i].z * v[i].z + v[i].w * v[i].w; }
#pragma unroll
    for (int o = 32; o >= 1; o >>= 1) ss += __shfl_xor(ss, o);
    const float r = rsqrtf(ss * (1.0f / DM) + RMS_EPS);
    if (xcopy) {
      float4* xc = (float4*)(xcopy + (size_t)tok * DM);
#pragma unroll
      for (int i = 0; i < 4; ++i) xc[lane + 64 * i] = v[i];
    }
#pragma unroll
    for (int i = 0; i < 4; ++i) {
      const float4 gg = ((const float4*)g)[lane + 64 * i];
      uint2 w; w.x = pack2(v[i].x * r * gg.x, v[i].y * r * gg.y); w.y = pack2(v[i].z * r * gg.z, v[i].w * r * gg.w);
      *(uint2*)(out + (size_t)tok * LDH + (lane + 64 * i) * 4) = w;
    }
  }
}

template <bool A_GATHER = false>
__device__ __forceinline__ void gemm_main(const bf16_t* __restrict__ A, size_t lda, const bf16_t* __restrict__ Bt, int ldb, int K, f32x4 (&acc)[4][4], char* smem, size_t kstepA = 64) {
  const int tid = TIDX, lane = tid & 63, wave = tid >> 6, wr = wave >> 1, wc = wave & 1, l15 = lane & 15, q4 = lane >> 4;
  const int lrow = tid >> 3, lch = tid & 7;
  const bf16_t* ap = A_GATHER ? A : A + (size_t)lrow * lda + lch * 8;
  const bf16_t* bp = Bt + (size_t)lrow * ldb + lch * 8;
  const size_t sa = A_GATHER ? lda : (size_t)32 * lda, sb = (size_t)32 * ldb;
  typedef unsigned u32x4 __attribute__((ext_vector_type(4)));
  u32x4 ra0, ra1, ra2, ra3, rb0, rb1, rb2, rb3;
  u32x4 rc0, rc1, rc2, rc3, rd0, rd1, rd2, rd3;
  int nk = K >> 6;
  asm volatile("" : "+s"(nk));
  const int st_off = lds_off(lrow, lch);
  const int sw = (l15 >> 1) & 7;
  const int fr0 = l15 * 128 + (((q4 ^ (sw & 3)) << 4) | ((sw >> 2) << 6));
  const int a_off = wr * 8192 + fr0, b_off = 16384 + wc * 8192 + fr0;
#ifndef EXP_GL
#define EXP_GL 0
#endif
#ifndef EXP_LDSW
#define EXP_LDSW 0
#endif
#if EXP_GL
#define GLQ const volatile u32x4*
#define GLREP 2
#else
#define GLQ const u32x4*
#define GLREP 1
#endif
#if EXP_LDSW == 1
#define LSQ volatile u32x4*
#define LSREP 2
#else
#define LSQ u32x4*
#define LSREP 1
#endif
#define GLOAD0(AP, BP) do { for (int rep_ = 0; rep_ < GLREP; ++rep_) { ra0 = *(GLQ)(AP); ra1 = *(GLQ)((AP) + sa); ra2 = *(GLQ)((AP) + 2 * sa); ra3 = *(GLQ)((AP) + 3 * sa); \
                            rb0 = *(GLQ)(BP); rb1 = *(GLQ)((BP) + sb); rb2 = *(GLQ)((BP) + 2 * sb); rb3 = *(GLQ)((BP) + 3 * sb); } } while (0)
#define GLOAD1(AP, BP) do { for (int rep_ = 0; rep_ < GLREP; ++rep_) { rc0 = *(GLQ)(AP); rc1 = *(GLQ)((AP) + sa); rc2 = *(GLQ)((AP) + 2 * sa); rc3 = *(GLQ)((AP) + 3 * sa); \
                            rd0 = *(GLQ)(BP); rd1 = *(GLQ)((BP) + sb); rd2 = *(GLQ)((BP) + 2 * sb); rd3 = *(GLQ)((BP) + 3 * sb); } } while (0)
#define XW(P_, V_) asm volatile("ds_write_b128 %0, %1" :: "v"((unsigned)(size_t)(P_)), "v"(V_) : "memory")
#if EXP_LDSW == 2
#define XDUP0(PS) do { XW((PS), ra0); XW((PS) + 4096, ra1); XW((PS) + 8192, ra2); XW((PS) + 12288, ra3); XW((PS) + 16384, rb0); XW((PS) + 20480, rb1); XW((PS) + 24576, rb2); XW((PS) + 28672, rb3); } while (0)
#define XDUP1(PS) do { XW((PS), rc0); XW((PS) + 4096, rc1); XW((PS) + 8192, rc2); XW((PS) + 12288, rc3); XW((PS) + 16384, rd0); XW((PS) + 20480, rd1); XW((PS) + 24576, rd2); XW((PS) + 28672, rd3); } while (0)
#else
#define XDUP0(PS) do { } while (0)
#define XDUP1(PS) do { } while (0)
#endif
#define LSTORE0(PS) do { XDUP0(PS); for (int rep_ = 0; rep_ < LSREP; ++rep_) { *(LSQ)(PS) = ra0; *(LSQ)((PS) + 4096) = ra1; *(LSQ)((PS) + 8192) = ra2; *(LSQ)((PS) + 12288) = ra3; \
                         *(LSQ)((PS) + 16384) = rb0; *(LSQ)((PS) + 20480) = rb1; *(LSQ)((PS) + 24576) = rb2; *(LSQ)((PS) + 28672) = rb3; } } while (0)
#define LSTORE1(PS) do { XDUP1(PS); for (int rep_ = 0; rep_ < LSREP; ++rep_) { *(LSQ)(PS) = rc0; *(LSQ)((PS) + 4096) = rc1; *(LSQ)((PS) + 8192) = rc2; *(LSQ)((PS) + 12288) = rc3; \
                         *(LSQ)((PS) + 16384) = rd0; *(LSQ)((PS) + 20480) = rd1; *(LSQ)((PS) + 24576) = rd2; *(LSQ)((PS) + 28672) = rd3; } } while (0)
#define COMPUTE(BO) do { _Pragma("unroll") for (int ks = 0; ks < 2; ++ks) { \
      bf16x8 af[4], bfr[4]; \
      const char* pa = smem + (BO) + (a_off ^ (ks * 64)); \
      const char* pb = smem + (BO) + (b_off ^ (ks * 64)); \
      _Pragma("unroll") for (int m = 0; m < 4; ++m) af[m] = *(const bf16x8*)(pa + m * 2048); \
      _Pragma("unroll") for (int n = 0; n < 4; ++n) bfr[n] = *(const bf16x8*)(pb + n * 2048); \
      _Pragma("unroll") for (int m = 0; m < 4; ++m) \
        _Pragma("unroll") for (int n = 0; n < 4; ++n) acc[m][n] = __builtin_amdgcn_mfma_f32_16x16x32_bf16(bfr[n], af[m], acc[m][n], 0, 0, 0); } } while (0)
  GLOAD0(ap, bp);
  GLOAD1(ap + kstepA, bp + 64);
  LSTORE0(smem + st_off);
  __syncthreads();
#pragma nounroll
  for (int kt = 0; kt < nk; kt += 2) {
    { const int t2 = (kt + 2 < nk) ? kt + 2 : nk - 1; const bf16_t* ap2 = ap + t2 * kstepA; const bf16_t* bp2 = bp + t2 * 64; GLOAD0(ap2, bp2); }
    __builtin_amdgcn_sched_barrier(0);
    COMPUTE(0);
    LSTORE1(smem + 32768 + st_off);
    __syncthreads();
    { const int t3 = (kt + 3 < nk) ? kt + 3 : nk - 1; const bf16_t* ap2 = ap + t3 * kstepA; const bf16_t* bp2 = bp + t3 * 64; GLOAD1(ap2, bp2); }
    __builtin_amdgcn_sched_barrier(0);
    COMPUTE(32768);
    LSTORE0(smem + st_off);
    __syncthreads();
  }
#undef GLOAD0
#undef GLOAD1
#undef LSTORE0
#undef LSTORE1
#undef COMPUTE
#undef GLQ
#undef LSQ
#undef GLREP
#undef LSREP
}

__device__ __forceinline__ void gemm_main_shallow(const bf16_t* __restrict__ A, int lda, const bf16_t* __restrict__ Bt, int ldb, int K, f32x4 (&acc)[4][4], char* smem) {
  const int tid = TIDX, lane = tid & 63, wave = tid >> 6, wr = wave >> 1, wc = wave & 1, l15 = lane & 15, q4 = lane >> 4;
  const int lrow = tid >> 3, lch = tid & 7;
  const bf16_t* ap = A + (size_t)lrow * lda + lch * 8;
  const bf16_t* bp = Bt + (size_t)lrow * ldb + lch * 8;
  const size_t sa = (size_t)32 * lda, sb = (size_t)32 * ldb;
  uint4 ra0, ra1, ra2, ra3, rb0, rb1, rb2, rb3;
  int nk = K >> 6;
  asm volatile("" : "+s"(nk));
  const int st_off = lds_off(lrow, lch);
  const int sw = (l15 >> 1) & 7;
  const int fr0 = l15 * 128 + (((q4 ^ (sw & 3)) << 4) | ((sw >> 2) << 6));
  const int a_off = wr * 8192 + fr0, b_off = 16384 + wc * 8192 + fr0;
#define GLOAD(AP, BP) do { ra0 = *(const uint4*)(AP); ra1 = *(const uint4*)((AP) + sa); ra2 = *(const uint4*)((AP) + 2 * sa); ra3 = *(const uint4*)((AP) + 3 * sa); \
                           rb0 = *(const uint4*)(BP); rb1 = *(const uint4*)((BP) + sb); rb2 = *(const uint4*)((BP) + 2 * sb); rb3 = *(const uint4*)((BP) + 3 * sb); } while (0)
#define LSTORE(PS) do { *(uint4*)(PS) = ra0; *(uint4*)((PS) + 4096) = ra1; *(uint4*)((PS) + 8192) = ra2; *(uint4*)((PS) + 12288) = ra3; \
                        *(uint4*)((PS) + 16384) = rb0; *(uint4*)((PS) + 20480) = rb1; *(uint4*)((PS) + 24576) = rb2; *(uint4*)((PS) + 28672) = rb3; } while (0)
  GLOAD(ap, bp);
  LSTORE(smem + st_off);
  __syncthreads();
#pragma nounroll
  for (int kt = 0; kt < nk; ++kt) {
    const int bo = (kt & 1) * 32768;
    const bool more = kt + 1 < nk;
    if (more) { const bf16_t* ap2 = ap + (kt + 1) * 64; const bf16_t* bp2 = bp + (kt + 1) * 64; GLOAD(ap2, bp2); }
#pragma unroll
    for (int ks = 0; ks < 2; ++ks) {
      bf16x8 af[4], bfr[4];
      const char* pa = smem + bo + (a_off ^ (ks * 64));
      const char* pb = smem + bo + (b_off ^ (ks * 64));
#pragma unroll
      for (int m = 0; m < 4; ++m) af[m] = *(const bf16x8*)(pa + m * 2048);
#pragma unroll
      for (int n = 0; n < 4; ++n) bfr[n] = *(const bf16x8*)(pb + n * 2048);
#pragma unroll
      for (int m = 0; m < 4; ++m)
#pragma unroll
        for (int n = 0; n < 4; ++n) acc[m][n] = __builtin_amdgcn_mfma_f32_16x16x32_bf16(bfr[n], af[m], acc[m][n], 0, 0, 0);
    }
    if (more) { char* ps = smem + (bo ^ 32768) + st_off; LSTORE(ps); }
    __syncthreads();
  }
#undef GLOAD
#undef LSTORE
}

__device__ __forceinline__ void zero_acc(f32x4 (&acc)[4][4]) {
#pragma unroll
  for (int m = 0; m < 4; ++m)
#pragma unroll
    for (int n = 0; n < 4; ++n) acc[m][n] = (f32x4){0.f, 0.f, 0.f, 0.f};
}
__device__ __forceinline__ bool tile_coords(int u, int nN, int& tm, int& tn) {
  const int xcd = u & 7, loc = u >> 3;
  const int sb = loc >> 6, mi = loc & 7, ni = (loc >> 3) & 7;
  tm = xcd * 16 + (sb & 1) * 8 + mi; tn = (sb >> 1) * 8 + ni;
  return tn < nN;
}
__device__ __forceinline__ int tile_slots(int nN) { return 128 * ((nN + 7) & ~7); }
#define EPI_SETUP const int lane_ = TIDX & 63, wave_ = TIDX >> 6; const int rbase = tm * 128 + (wave_ >> 1) * 64 + (lane_ & 15); const int cbase = tn * 128 + (wave_ & 1) * 64 + (lane_ >> 4) * 4;

__device__ void phase_gemm_in(const Params& P, char* smem) {
  for (int u = BIDX; u < tile_slots(51); u += gridDim.x) {
    int tm, tn; if (!tile_coords(u, 51, tm, tn)) continue;
    f32x4 acc[4][4]; zero_acc(acc);
    gemm_main(P.hbuf + (size_t)tm * 128 * LDH, LDH, P.Wt_in + (size_t)tn * 128 * LDH, LDH, DM, acc, smem);
    EPI_SETUP
    const bool is_gate = (tn >= ZC_MIX / 128) && (tn < ZC_NG / 128);
#pragma unroll
    for (int m = 0; m < 4; ++m)
#pragma unroll
      for (int n = 0; n < 4; ++n) {
        const int row = rbase + m * 16, col = cbase + n * 16;
        f32x4 v = acc[m][n];
        if (is_gate) { v[0] = sigmoidf_(v[0]); v[1] = sigmoidf_(v[1]); v[2] = sigmoidf_(v[2]); v[3] = sigmoidf_(v[3]); }
        uint2 w; w.x = pack2(v[0], v[1]); w.y = pack2(v[2], v[3]);
        *(uint2*)(smem + (row - tm * 128) * 272 + (col - tn * 128) * 2) = w;
      }
    __syncthreads();
    {
      const int tid = TIDX;
#pragma unroll
      for (int i = 0; i < 8; ++i) {
        const int id = tid + 256 * i, r = id >> 4, c16 = id & 15;
        const uint4 v = *(const uint4*)(smem + r * 272 + c16 * 16);
        *(uint4*)(P.z + (size_t)(tm * 128 + r) * ZLD + tn * 128 + c16 * 8) = v;
      }
    }
    __syncthreads();
  }
}
__device__ void phase_gemm_resid(const Params& P, const bf16_t* A, int lda, const bf16_t* Bt, int K, char* smem, float alpha = 1.0f) {
  for (int u = BIDX; u < tile_slots(8); u += gridDim.x) {
    int tm, tn; if (!tile_coords(u, 8, tm, tn)) continue;
    f32x4 acc[4][4]; zero_acc(acc);
    gemm_main(A + (size_t)tm * 128 * lda, lda, Bt + (size_t)tn * 128 * (K + 64), K + 64, K, acc, smem);
    EPI_SETUP
#pragma unroll
    for (int m = 0; m < 4; ++m)
#pragma unroll
      for (int n = 0; n < 4; ++n) {
        const int row = rbase + m * 16, col = cbase + n * 16;
        float4* p = (float4*)(P.x + (size_t)row * DM + col);
        float4 v = *p;
        v.x += alpha * acc[m][n][0]; v.y += alpha * acc[m][n][1]; v.z += alpha * acc[m][n][2]; v.w += alpha * acc[m][n][3];
        *p = v;
      }
  }
}
__device__ void phase_gemm_gateup(const Params& P, char* smem) {
  bf16_t* act = P.z;
  for (int u = BIDX; u < tile_slots(44); u += gridDim.x) {
    int tm, tn; if (!tile_coords(u, 44, tm, tn)) continue;
    f32x4 acc[4][4]; zero_acc(acc);
    gemm_main(P.hbuf + (size_t)tm * 128 * LDH, LDH, P.Wt_gu + (size_t)tn * 128 * LDH, LDH, DM, acc, smem);
    const int lane_ = TIDX & 63, wave_ = TIDX >> 6;
    const int rbase = tm * 128 + (wave_ >> 1) * 64 + (lane_ & 15);
    const int cbase = tn * 64 + (wave_ & 1) * 32 + (lane_ >> 4) * 4;
#pragma unroll
    for (int m = 0; m < 4; ++m)
#pragma unroll
      for (int n = 0; n < 2; ++n) {
        const int row = rbase + m * 16, col = cbase + n * 16;
        float o[4];
#pragma unroll
        for (int r = 0; r < 4; ++r) { const float gq = acc[m][n][r]; o[r] = gq * sigmoidf_(gq) * acc[m][n + 2][r]; }
        uint2 w; w.x = pack2(o[0], o[1]); w.y = pack2(o[2], o[3]);
        *(uint2*)(smem + (row - tm * 128) * 144 + (col - tn * 64) * 2) = w;
      }
    __syncthreads();
    {
      const int tid = TIDX;
#pragma unroll
      for (int i = 0; i < 4; ++i) {
        const int id = tid + 256 * i, r = id >> 3, c8 = id & 7;
        const uint4 v = *(const uint4*)(smem + r * 144 + c8 * 16);
        *(uint4*)(act + (size_t)(tm * 128 + r) * LDA + tn * 64 + c8 * 8) = v;
      }
    }
    __syncthreads();
  }
}
__device__ void phase_gemm_cmp1(const Params& P, char* smem, int u0, int ustride) {
  for (int u = u0; u < 32; u += ustride) {
    const int which = u >> 4, rem = u & 15, tm = rem & 7, tn = rem >> 3;
    f32x4 acc[4][4]; zero_acc(acc);
    const int tid = TIDX, lrow = tid >> 3, lch = tid & 7;
    const bf16_t* ap = P.z + ((size_t)(tm * 64 + (lrow >> 1)) * 32) * ZLD + (which ? ZC_VC : ZC_KC) + (lrow & 1) * 64 + lch * 8;
    gemm_main<true>(ap, (size_t)512 * ZLD, P.Wt_c1 + (size_t)which * 256 * LDC + (size_t)tn * 128 * LDC, LDC, 2048, acc, smem, (size_t)ZLD);
    EPI_SETUP
#pragma unroll
    for (int m = 0; m < 4; ++m)
#pragma unroll
      for (int n = 0; n < 4; ++n) {
        const int row = rbase + m * 16, col = cbase + n * 16;
        const float4 bb = *(const float4*)(P.cbias + which * 256 + col);
        uint2 w; w.x = pack2(gelu_tanh(acc[m][n][0] + bb.x), gelu_tanh(acc[m][n][1] + bb.y)); w.y = pack2(gelu_tanh(acc[m][n][2] + bb.z), gelu_tanh(acc[m][n][3] + bb.w));
        *(uint2*)(P.hid + (size_t)which * 1024 * 256 + (size_t)row * 256 + col) = w;
      }
  }
}
__device__ void phase_cmp_bias(const Params& P, int layer) {
  const int lane = TIDX & 63, wave = TIDX >> 6;
  for (int o = BIDX * 4 + wave; o < 512; o += gridDim.x * 4) {
    const int which = o >> 8, col = o & 255;
    const float* pe = P.in[16] + (size_t)(layer * 2 + which) * 2048;
    const float* w1 = P.in[17] + (size_t)(layer * 2 + which) * 2048 * 256 + col;
    float acc = 0.f;
    for (int k = lane; k < 2048; k += 64) acc += pe[k] * w1[(size_t)k * 256];
#pragma unroll
    for (int o2 = 32; o2 >= 1; o2 >>= 1) acc += __shfl_xor(acc, o2);
    if (lane == 0) P.cbias[o] = acc;
  }
}
__device__ __forceinline__ void merge_stage_gates(const bf16_t* __restrict__ zg, int tm, int tn, char* smem) {
  const int tid = TIDX;
#pragma unroll
  for (int i = 0; i < 8; ++i) {
    const int id = tid + 256 * i, r = id >> 4, c16 = id & 15;
    *(uint4*)(smem + r * 272 + c16 * 16) = *(const uint4*)(zg + (size_t)(tm * 128 + r) * ZLD + tn * 128 + c16 * 8);
  }
}
__device__ void phase_merge(const Params& P, char* smem) {
  for (int u = BIDX; u < tile_slots(8); u += gridDim.x) {
    int tm, tn; if (!tile_coords(u, 8, tm, tn)) continue;
    const int lane_ = TIDX & 63, wave_ = TIDX >> 6;
    const int loff = ((wave_ >> 1) * 64 + (lane_ & 15)) * 272 + ((wave_ & 1) * 64 + (lane_ >> 4) * 4) * 2;
    uint2 hreg[4][4];
    {
      f32x4 a0[4][4], a1[4][4]; zero_acc(a0); zero_acc(a1);
      gemm_main_shallow(P.ys + (size_t)tm * 128 * LD5, LD5, P.Wt_glu + (size_t)tn * 128 * LD5, LD5, 512, a0, smem);
      gemm_main_shallow(P.ys + (size_t)tm * 128 * LD5, LD5, P.Wt_glu + (size_t)(1024 + tn * 128) * LD5, LD5, 512, a1, smem);
      merge_stage_gates(P.z + ZC_MIX, tm, tn, smem);
      __syncthreads();
#pragma unroll
      for (int m = 0; m < 4; ++m)
#pragma unroll
        for (int n = 0; n < 4; ++n) {
          const uint2 gw = *(const uint2*)(smem + loff + m * 16 * 272 + n * 32);
          hreg[m][n].x = pack2(lo2f(gw.x) * a0[m][n][0] * sigmoidf_(a1[m][n][0]), hi2f(gw.x) * a0[m][n][1] * sigmoidf_(a1[m][n][1]));
          hreg[m][n].y = pack2(lo2f(gw.y) * a0[m][n][2] * sigmoidf_(a1[m][n][2]), hi2f(gw.y) * a0[m][n][3] * sigmoidf_(a1[m][n][3]));
        }
      __syncthreads();
    }
    int nbr = 3;
    asm volatile("" : "+s"(nbr));
    for (int br = 1; br < nbr; ++br) {
      f32x4 a1[4][4]; zero_acc(a1);
      const bf16_t* A = (br == 1) ? P.cv : P.ob;
      const bf16_t* B = (br == 1) ? P.Wt_conv : P.Wt_o;
      gemm_main_shallow(A + (size_t)tm * 128 * LD5, LD5, B + (size_t)tn * 128 * LD5, LD5, 512, a1, smem);
      merge_stage_gates(P.z + ZC_MIX + br * 1024, tm, tn, smem);
      __syncthreads();
#pragma unroll
      for (int m = 0; m < 4; ++m)
#pragma unroll
        for (int n = 0; n < 4; ++n) {
          const uint2 gw = *(const uint2*)(smem + loff + m * 16 * 272 + n * 32);
          const uint2 hv = hreg[m][n];
          hreg[m][n].x = pack2(lo2f(hv.x) + lo2f(gw.x) * a1[m][n][0], hi2f(hv.x) + hi2f(gw.x) * a1[m][n][1]);
          hreg[m][n].y = pack2(lo2f(hv.y) + lo2f(gw.y) * a1[m][n][2], hi2f(hv.y) + hi2f(gw.y) * a1[m][n][3]);
        }
      __syncthreads();
    }
#pragma unroll
    for (int m = 0; m < 4; ++m)
#pragma unroll
      for (int n = 0; n < 4; ++n) *(uint2*)(smem + loff + m * 16 * 272 + n * 32) = hreg[m][n];
    __syncthreads();
    {
      const int tid = TIDX;
#pragma unroll
      for (int i = 0; i < 8; ++i) {
        const int id = tid + 256 * i, r = id >> 4, c16 = id & 15;
        *(uint4*)(P.hbuf + (size_t)(tm * 128 + r) * LDH + tn * 128 + c16 * 8) = *(const uint4*)(smem + r * 272 + c16 * 16);
      }
    }
    __syncthreads();
  }
}

__device__ void s5_unit(const Params& P, int layer, int unit, char* smem) {
  const int b = unit >> 5, g = unit & 31;
  const int tid = TIDX, lane = tid & 63, w = tid >> 6, l15 = lane & 15, q4 = lane >> 4;
  const int p = lane, q = w;
  float* bu = (float*)smem;
  bf16_t* stb = (bf16_t*)(smem + 33280);
  float2* send = (float2*)(smem + 33280 + 17408);
  bf16_t* usb = (bf16_t*)(smem + 33280 + 17408 + 2048);
  const float* lam_re = P.in[3] + (size_t)layer * 32 * 64 + g * 64, *lam_im = P.in[4] + (size_t)layer * 32 * 64 + g * 64;
  const float* b_re = P.in[5] + ((size_t)layer * 32 + g) * 64 * 16, *b_im = P.in[6] + ((size_t)layer * 32 + g) * 64 * 16;
  const float* c_re = P.in[7] + ((size_t)layer * 32 + g) * 16 * 64, *c_im = P.in[8] + ((size_t)layer * 32 + g) * 16 * 64;
  const float dk = P.in[9][(size_t)layer * 512 + g * 16 + l15];
  const float dt = expf(P.in[10][layer * 32 + g]);
  float lbr, lbi, l16r, l16i;
  {
    const float lr = lam_re[p], li = lam_im[p];
    float sn, cs_; sincosf(li * dt, &sn, &cs_);
    const float e = expf(lr * dt);
    lbr = e * cs_; lbi = e * sn;
    l16r = lbr; l16i = lbi;
#pragma unroll
    for (int i = 0; i < 4; ++i) { const float tr = l16r * l16r - l16i * l16i, ti = 2.f * l16r * l16i; l16r = tr; l16i = ti; }
  }
  bf16x8 bB[2];
#pragma unroll
  for (int nt = 0; nt < 2; ++nt) {
    const int pp = (2 * w + nt) * 16 + l15, ps = pp >> 1, cpl = pp & 1;
    const float lr = lam_re[ps], li = lam_im[ps];
    float sn, cs_; sincosf(li * dt, &sn, &cs_);
    const float e = expf(lr * dt);
    const float nr = e * cs_ - 1.0f, ni = e * sn, den = lr * lr + li * li;
    const float cfr = (nr * lr + ni * li) / den, cfi = (ni * lr - nr * li) / den;
    float v[8];
#pragma unroll
    for (int j = 0; j < 8; ++j) {
      const int h = (q4 & 1) * 8 + j;
      const float br = b_re[ps * 16 + h], bi = b_im[ps * 16 + h];
      const float val = cpl ? (cfr * bi + cfi * br) : (cfr * br - cfi * bi);
      v[j] = (q4 < 2) ? val : 0.f;
    }
    union { uint32_t u[4]; bf16x8 x; } cv; cv.u[0] = pack2(v[0], v[1]); cv.u[1] = pack2(v[2], v[3]); cv.u[2] = pack2(v[4], v[5]); cv.u[3] = pack2(v[6], v[7]);
    bB[nt] = cv.x;
  }
  bf16x8 cB[4];
#pragma unroll
  for (int ks = 0; ks < 4; ++ks) {
    float v[8];
#pragma unroll
    for (int j = 0; j < 8; ++j) {
      const int pp = ks * 32 + q4 * 8 + j, ps = pp >> 1;
      v[j] = (pp & 1) ? -c_im[l15 * 64 + ps] : c_re[l15 * 64 + ps];
    }
    union { uint32_t u[4]; bf16x8 x; } cv; cv.u[0] = pack2(v[0], v[1]); cv.u[1] = pack2(v[2], v[3]); cv.u[2] = pack2(v[4], v[5]); cv.u[3] = pack2(v[6], v[7]);
    cB[ks] = cv.x;
  }
  float car_r = 0.f, car_i = 0.f;
  bf16x8 un0, un1, un2, un3;
  {
    const bf16_t* zp = P.z + ((size_t)b * SEQL + l15) * ZLD + ZC_U + g * 16 + (q4 & 1) * 8;
    un0 = *(const bf16x8*)(zp); un1 = *(const bf16x8*)(zp + (size_t)16 * ZLD); un2 = *(const bf16x8*)(zp + (size_t)32 * ZLD); un3 = *(const bf16x8*)(zp + (size_t)48 * ZLD);
  }
  for (int chunk = 0; chunk < 64; ++chunk) {
    const size_t tok0 = (size_t)b * SEQL + chunk * 64;
    {
      bf16x8 ua[4];
      const bf16x8 zz = (bf16x8){0, 0, 0, 0, 0, 0, 0, 0};
      ua[0] = (q4 < 2) ? un0 : zz; ua[1] = (q4 < 2) ? un1 : zz; ua[2] = (q4 < 2) ? un2 : zz; ua[3] = (q4 < 2) ? un3 : zz;
      if (w == 0 && q4 < 2) {
#pragma unroll
        for (int mt = 0; mt < 4; ++mt) *(bf16x8*)(usb + (chunk & 1) * 1024 + (mt * 16 + l15) * 16 + q4 * 8) = ua[mt];
      }
      if (chunk + 1 < 64) {
        const bf16_t* zp = P.z + (tok0 + 64 + l15) * ZLD + ZC_U + g * 16 + (q4 & 1) * 8;
        un0 = *(const bf16x8*)(zp); un1 = *(const bf16x8*)(zp + (size_t)16 * ZLD); un2 = *(const bf16x8*)(zp + (size_t)32 * ZLD); un3 = *(const bf16x8*)(zp + (size_t)48 * ZLD);
      }
#pragma unroll
      for (int mt = 0; mt < 4; ++mt)
#pragma unroll
        for (int nt = 0; nt < 2; ++nt) {
          const f32x4 acc = __builtin_amdgcn_mfma_f32_16x16x32_bf16(ua[mt], bB[nt], (f32x4){0.f, 0.f, 0.f, 0.f}, 0, 0, 0);
          float* dst = bu + (mt * 16 + q4 * 4) * 130 + (2 * w + nt) * 16 + l15;
          dst[0] = acc[0]; dst[130] = acc[1]; dst[260] = acc[2]; dst[390] = acc[3];
        }
    }
    __syncthreads();
    float locr[16], loci[16];
    float sr = 0.f, si = 0.f;
#pragma unroll
    for (int i = 0; i < 16; ++i) {
      const float2 v = *(const float2*)(bu + (q * 16 + i) * 130 + 2 * p);
      const float nsr = lbr * sr - lbi * si + v.x, nsi = lbr * si + lbi * sr + v.y;
      sr = nsr; si = nsi; locr[i] = sr; loci[i] = si;
    }
    send[q * 64 + p] = make_float2(sr, si);
    __syncthreads();
    float cur_r = car_r, cur_i = car_i, mine_r = 0.f, mine_i = 0.f;
#pragma unroll
    for (int qq = 0; qq < 4; ++qq) {
      if (qq == q) { mine_r = cur_r; mine_i = cur_i; }
      const float2 ev = send[qq * 64 + p];
      const float tr = l16r * cur_r - l16i * cur_i + ev.x, ti = l16r * cur_i + l16i * cur_r + ev.y;
      cur_r = tr; cur_i = ti;
    }
    car_r = cur_r; car_i = cur_i;
    float cpr = lbr * mine_r - lbi * mine_i, cpi = lbr * mine_i + lbi * mine_r;
#pragma unroll
    for (int i = 0; i < 16; ++i) {
      *(uint32_t*)(stb + (q * 16 + i) * 136 + 2 * p) = pack2(locr[i] + cpr, loci[i] + cpi);
      const float tr = lbr * cpr - lbi * cpi, ti = lbr * cpi + lbi * cpr;
      cpr = tr; cpi = ti;
    }
    __syncthreads();
    {
      f32x4 acc = (f32x4){0.f, 0.f, 0.f, 0.f};
#pragma unroll
      for (int ks = 0; ks < 4; ++ks) {
        const bf16x8 as = *(const bf16x8*)(stb + (w * 16 + l15) * 136 + ks * 32 + q4 * 8);
        acc = __builtin_amdgcn_mfma_f32_16x16x32_bf16(as, cB[ks], acc, 0, 0, 0);
      }
#pragma unroll
      for (int r = 0; r < 4; ++r) {
        const size_t t = tok0 + w * 16 + q4 * 4 + r;
        const float uval = bf2f(usb[(chunk & 1) * 1024 + (w * 16 + q4 * 4 + r) * 16 + l15]);
        const float y = gelu_tanh(acc[r] + dk * uval);
        P.ys[t * LD5 + g * 16 + l15] = (bf16_t)(pack2(y, 0.f) & 0xffffu);
      }
    }
  }
}

__device__ __forceinline__ void load8(const bf16_t* p, float (&f)[8]) {
  const uint4 w = *(const uint4*)p;
  f[0] = lo2f(w.x); f[1] = hi2f(w.x); f[2] = lo2f(w.y); f[3] = hi2f(w.y); f[4] = lo2f(w.z); f[5] = hi2f(w.z); f[6] = lo2f(w.w); f[7] = hi2f(w.w);
}
__device__ __forceinline__ void store8(bf16_t* p, const float (&f)[8]) {
  uint4 w; w.x = pack2(f[0], f[1]); w.y = pack2(f[2], f[3]); w.z = pack2(f[4], f[5]); w.w = pack2(f[6], f[7]);
  *(uint4*)p = w;
}
__device__ void prep_unit(const Params& P, int layer, int ck, char* smem) {
  const int tid = TIDX;
  const int tok0 = ck * 64, b = tok0 >> 12, s0 = tok0 & 4095;
  const bf16_t* z = P.z;
  {
    const float* cw = P.in[12] + (size_t)layer * 3 * 512;
    const int c2 = tid * 2;
    const float w00 = cw[c2], w01 = cw[c2 + 1], w10 = cw[512 + c2], w11 = cw[512 + c2 + 1], w20 = cw[1024 + c2], w21 = cw[1024 + c2 + 1];
    float p2a = 0.f, p2b = 0.f, p1a = 0.f, p1b = 0.f;
    if (s0 >= 2) {
      const uint32_t cc2 = *(const uint32_t*)(z + (size_t)(tok0 - 2) * ZLD + ZC_CC + c2), cx2 = *(const uint32_t*)(z + (size_t)(tok0 - 2) * ZLD + ZC_CX + c2);
      const uint32_t cc1 = *(const uint32_t*)(z + (size_t)(tok0 - 1) * ZLD + ZC_CC + c2), cx1 = *(const uint32_t*)(z + (size_t)(tok0 - 1) * ZLD + ZC_CX + c2);
      p2a = lo2f(cc2) * lo2f(cx2); p2b = hi2f(cc2) * hi2f(cx2); p1a = lo2f(cc1) * lo2f(cx1); p1b = hi2f(cc1) * hi2f(cx1);
    }
#pragma unroll 4
    for (int t = 0; t < 64; ++t) {
      const size_t ro = (size_t)(tok0 + t) * ZLD;
      const uint32_t cb = *(const uint32_t*)(z + ro + ZC_CB + c2), cc = *(const uint32_t*)(z + ro + ZC_CC + c2), cx = *(const uint32_t*)(z + ro + ZC_CX + c2);
      const float p0a = lo2f(cc) * lo2f(cx), p0b = hi2f(cc) * hi2f(cx);
      const float oa = lo2f(cb) * (w00 * p2a + w10 * p1a + w20 * p0a), ob_ = hi2f(cb) * (w01 * p2b + w11 * p1b + w21 * p0b);
      *(uint32_t*)(P.cv + (size_t)(tok0 + t) * LD5 + c2) = pack2(oa, ob_);
      p2a = p1a; p2b = p1b; p1a = p0a; p1b = p0b;
    }
  }
  {
    const float* qg = P.in[14] + (size_t)layer * 64;
    const int d8 = (tid & 7) * 8;
    float gq[8];
#pragma unroll
    for (int j = 0; j < 8; ++j) gq[j] = qg[d8 + j] * (0.125f * 1.44269504089f);
#pragma unroll 2
    for (int it = 0; it < 16; ++it) {
      const int row = it * 32 + (tid >> 3), t = row >> 3, h = row & 7;
      float f[8]; load8(z + (size_t)(tok0 + t) * ZLD + ZC_Q + h * 64 + d8, f);
      float ss = 0.f;
#pragma unroll
      for (int j = 0; j < 8; ++j) ss += f[j] * f[j];
      ss += __shfl_xor(ss, 1); ss += __shfl_xor(ss, 2); ss += __shfl_xor(ss, 4);
      const float r = rsqrtf(ss * (1.0f / 64.f) + RMS_EPS);
#pragma unroll
      for (int j = 0; j < 8; ++j) f[j] = f[j] * r * gq[j];
      store8(P.qn + (size_t)(tok0 + t) * 512 + h * 64 + d8, f);
    }
  }
  {
    const float* kg = P.in[15] + (size_t)layer * 3 * 64;
    const int d8 = (tid & 7) * 8;
#pragma unroll 2
    for (int it = 0; it < 8; ++it) {
      const int row = it * 32 + (tid >> 3), which = row >> 7, t = (row >> 1) & 63, kvh = row & 1;
      float f[8]; load8(z + (size_t)(tok0 + t) * ZLD + (which ? ZC_KW : ZC_KS) + kvh * 64 + d8, f);
      float ss = 0.f;
#pragma unroll
      for (int j = 0; j < 8; ++j) ss += f[j] * f[j];
      ss += __shfl_xor(ss, 1); ss += __shfl_xor(ss, 2); ss += __shfl_xor(ss, 4);
      const float r = rsqrtf(ss * (1.0f / 64.f) + RMS_EPS);
#pragma unroll
      for (int j = 0; j < 8; ++j) f[j] = f[j] * r * kg[(1 + which) * 64 + d8 + j];
      bf16_t* dst = (which ? P.kwn : P.ksn) + ((size_t)(b * 2 + kvh) * SEQL + s0 + t) * 64 + d8;
      store8(dst, f);
    }
  }
  {
    bf16_t* lt = (bf16_t*)smem;
    for (int which = 0; which < 2; ++which) {
      __syncthreads();
      {
        const int c8 = (tid & 15) * 8;
#pragma unroll
        for (int it = 0; it < 4; ++it) {
          const int t = it * 16 + (tid >> 4);
          const uint4 w = *(const uint4*)(z + (size_t)(tok0 + t) * ZLD + (which ? ZC_VW : ZC_VS) + c8);
          uint32_t* d = (uint32_t*)(lt + t * 130 + c8);
          d[0] = w.x; d[1] = w.y; d[2] = w.z; d[3] = w.w;
        }
      }
      __syncthreads();
      const int lane = tid & 63, wave = tid >> 6;
      bf16_t* dstb = which ? P.vwT : P.vsT;
#pragma unroll 4
      for (int it = 0; it < 32; ++it) {
        const int row = it * 4 + wave;
        dstb[((size_t)(b * 2) * 64 + row) * LDV + s0 + lane] = lt[lane * 130 + row];
      }
    }
  }
}
__device__ void phase_prep(const Params& P, int layer, char* smem) {
  const int bid = BIDX;
  if (bid < 32) phase_gemm_cmp1(P, smem, bid, 32);
  else if (bid < 288) { prep_unit(P, layer, bid - 32, smem); }
  else phase_convert_late(P, layer, smem, bid - 288, gridDim.x - 288);
}

__device__ void phase_cmp2(const Params& P, int layer) {
  const int lane = TIDX & 63, wave = TIDX >> 6;
  for (int wu = BIDX * 4 + wave; wu < 2048; wu += gridDim.x * 4) {
    const int which = wu >> 10, row = wu & 1023;
    const float* w2 = P.in[18] + (size_t)(layer * 2 + which) * 256 * 64;
    const bf16_t* hr = P.hid + (size_t)which * 1024 * 256 + (size_t)row * 256;
    float acc = 0.f;
#pragma unroll 8
    for (int k = 0; k < 256; ++k) acc += bf2f(hr[k]) * w2[k * 64 + lane];
    const int kvh = row & 1, bc = row >> 1, b = bc >> 7, c = bc & 127;
    if (which == 0) {
      float ss = acc * acc;
#pragma unroll
      for (int o = 32; o >= 1; o >>= 1) ss += __shfl_xor(ss, o);
      const float r = rsqrtf(ss * (1.0f / 64.f) + RMS_EPS);
      const float v = acc * r * P.in[15][(size_t)layer * 3 * 64 + lane];
      P.kc[((size_t)(b * 2 + kvh) * 128 + c) * 64 + lane] = (bf16_t)(pack2(v, 0.f) & 0xffff);
    } else {
      P.vcT[((size_t)(b * 2 + kvh) * 64 + lane) * 128 + c] = (bf16_t)(pack2(acc, 0.f) & 0xffff);
    }
  }
}

#define NEGBIG (-1e30f)
#define NQ 2
__device__ __forceinline__ void attn_load_tiles(const bf16_t* __restrict__ Kp, const bf16_t* __restrict__ Vp, int vstride, char* KT, char* VT) {
  const int tid = TIDX;
  const int row = tid >> 3, ch = tid & 7;
  const int so = lds_off(row, ch);
  const uint4 k0 = *(const uint4*)(Kp + (size_t)row * 64 + ch * 8), k1 = *(const uint4*)(Kp + (size_t)(row + 32) * 64 + ch * 8);
  const uint4 v0 = *(const uint4*)(Vp + (size_t)row * vstride + ch * 8), v1 = *(const uint4*)(Vp + (size_t)(row + 32) * vstride + ch * 8);
  *(uint4*)(KT + so) = k0; *(uint4*)(KT + so + 4096) = k1;
  *(uint4*)(VT + so) = v0; *(uint4*)(VT + so + 4096) = v1;
}
#define KV_ISSUE(Kp, Vp, vstride) do { const int tid_ = TIDX; const int row_ = tid_ >> 3, ch_ = tid_ & 7; \
    rk0 = *(const uint4*)((Kp) + (size_t)row_ * 64 + ch_ * 8); rk1 = *(const uint4*)((Kp) + (size_t)(row_ + 32) * 64 + ch_ * 8); \
    rv0 = *(const uint4*)((Vp) + (size_t)row_ * (vstride) + ch_ * 8); rv1 = *(const uint4*)((Vp) + (size_t)(row_ + 32) * (vstride) + ch_ * 8); } while (0)
#define KV_STORE() do { const int tid_ = TIDX; const int so_ = lds_off(tid_ >> 3, tid_ & 7); \
    *(uint4*)(KT + so_) = rk0; *(uint4*)(KT + so_ + 4096) = rk1; *(uint4*)(VT + so_) = rv0; *(uint4*)(VT + so_ + 4096) = rv1; } while (0)
__device__ __forceinline__ void attn_scores(const char* KT, int kfr0, const bf16x8 (&qf)[NQ][2], f32x4 (&S)[4][NQ]) {
#pragma unroll
  for (int mk = 0; mk < 4; ++mk)
#pragma unroll
    for (int nq = 0; nq < NQ; ++nq) S[mk][nq] = (f32x4){0.f, 0.f, 0.f, 0.f};
#pragma unroll
  for (int ks = 0; ks < 2; ++ks) {
    const char* pk = KT + (kfr0 ^ (ks * 64));
#pragma unroll
    for (int mk = 0; mk < 4; ++mk) {
      const bf16x8 kf = *(const bf16x8*)(pk + mk * 2048);
#pragma unroll
      for (int nq = 0; nq < NQ; ++nq) S[mk][nq] = __builtin_amdgcn_mfma_f32_16x16x32_bf16(kf, qf[nq][ks], S[mk][nq], 0, 0, 0);
    }
  }
}
__device__ __forceinline__ void attn_pv(const char* VT, int vfr0, const f32x4 (&S)[4][NQ], f32x4 (&O)[4][NQ]) {
#pragma unroll
  for (int s2 = 0; s2 < 2; ++s2) {
    bf16x8 pf[NQ];
#pragma unroll
    for (int nq = 0; nq < NQ; ++nq) {
      union { uint32_t u[4]; bf16x8 v; } cvt;
      cvt.u[0] = pack2(S[2 * s2][nq][0], S[2 * s2][nq][1]); cvt.u[1] = pack2(S[2 * s2][nq][2], S[2 * s2][nq][3]);
      cvt.u[2] = pack2(S[2 * s2 + 1][nq][0], S[2 * s2 + 1][nq][1]); cvt.u[3] = pack2(S[2 * s2 + 1][nq][2], S[2 * s2 + 1][nq][3]);
      pf[nq] = cvt.v;
    }
    const char* pv0 = VT + (vfr0 ^ (s2 * 64));
    const char* pv1 = VT + (vfr0 ^ (s2 * 64) ^ 32);
#pragma unroll
    for (int md = 0; md < 4; ++md) {
      union { uint2 h[2]; bf16x8 v; } vv;
      vv.h[0] = *(const uint2*)(pv0 + md * 2048);
      vv.h[1] = *(const uint2*)(pv1 + md * 2048);
#pragma unroll
      for (int nq = 0; nq < NQ; ++nq) O[md][nq] = __builtin_amdgcn_mfma_f32_16x16x32_bf16(vv.v, pf[nq], O[md][nq], 0, 0, 0);
    }
  }
}
__device__ __forceinline__ void attn_mask(f32x4 (&S)[4][NQ], int mode, int selbits, int hb, int posbase, int kbase, int l15, int q4) {
#pragma unroll
  for (int nq = 0; nq < NQ; ++nq) {
    const int rr = nq * 16 + l15;
    const bool rs = (selbits >> nq) & 1;
    const int lim = (posbase + rr + 1) >> 5;
#pragma unroll
    for (int mk = 0; mk < 4; ++mk)
#pragma unroll
      for (int r = 0; r < 4; ++r) {
        const int kk = mk * 16 + q4 * 4 + r;
        bool valid = rs;
        if (mode == 1) valid = valid && (kk <= hb + rr);
        else if (mode == 2) valid = valid && (kk > hb + rr);
        else if (mode == 3) valid = valid && (kbase + kk < lim);
        S[mk][nq][r] = valid ? S[mk][nq][r] : NEGBIG;
      }
  }
}
__device__ __forceinline__ void attn_softmax_step(f32x4 (&S)[4][NQ], float (&m)[NQ], float (&l)[NQ], f32x4 (&O)[4][NQ], bool rescale) {
#pragma unroll
  for (int nq = 0; nq < NQ; ++nq) {
    float mx = NEGBIG;
#pragma unroll
    for (int mk = 0; mk < 4; ++mk)
#pragma unroll
      for (int r = 0; r < 4; ++r) mx = fmaxf(mx, S[mk][nq][r]);
    mx = fmaxf(mx, __shfl_xor(mx, 16)); mx = fmaxf(mx, __shfl_xor(mx, 32));
    const float mnew = fmaxf(m[nq], mx);
    const float alpha = __builtin_amdgcn_exp2f(m[nq] - mnew);
    m[nq] = mnew;
    const float muse = fmaxf(mnew, -1e28f);
    float ps = 0.f;
#pragma unroll
    for (int mk = 0; mk < 4; ++mk)
#pragma unroll
      for (int r = 0; r < 4; ++r) {
        const float pv = __builtin_amdgcn_exp2f(S[mk][nq][r] - muse);
        ps += pv; S[mk][nq][r] = pv;
      }
    l[nq] = l[nq] * alpha + ps;
    if (rescale && __ballot(alpha != 1.0f) != 0ull) {
#pragma unroll
      for (int md = 0; md < 4; ++md) O[md][nq] *= alpha;
    }
  }
}
__device__ __forceinline__ void attn_reset(float (&m)[NQ], float (&l)[NQ], f32x4 (&O)[4][NQ]) {
#pragma unroll
  for (int nq = 0; nq < NQ; ++nq) { m[nq] = NEGBIG; l[nq] = 0.f; }
#pragma unroll
  for (int md = 0; md < 4; ++md)
#pragma unroll
    for (int nq = 0; nq < NQ; ++nq) O[md][nq] = (f32x4){0.f, 0.f, 0.f, 0.f};
}

__device__ void attn_unit(const Params& P, int unit, char* smem) {
  const int c32 = 127 - (unit >> 3);
  const int bk = unit & 7, b = bk >> 1, kvh = bk & 1;
  const int c = c32 >> 1, hb = (c32 & 1) * 32, posbase = c32 * 32;
  const int tid = TIDX, lane = tid & 63, g = tid >> 6, l15 = lane & 15, q4 = lane >> 4;
  const int h = kvh * 4 + g;
  const size_t tok0 = (size_t)b * SEQL + posbase;
  char* KT = smem;
  char* VT = smem + 8192;
  float* IMP = (float*)(smem + 16384);
  uint32_t* MASK = (uint32_t*)(smem + 16384 + 32 * 65 * 4);
  const int sw = (l15 >> 1) & 7;
  const int kfr0 = l15 * 128 + (((q4 ^ (sw & 3)) << 4) | ((sw >> 2) << 6));
  const int vfr0 = l15 * 128 + ((((q4 >> 1) ^ (sw & 1)) | (sw & 6)) << 4) + (q4 & 1) * 8;

  bf16x8 qf[NQ][2];
#pragma unroll
  for (int nq = 0; nq < NQ; ++nq)
#pragma unroll
    for (int ks = 0; ks < 2; ++ks) qf[nq][ks] = *(const bf16x8*)(P.qn + (tok0 + nq * 16 + l15) * 512 + h * 64 + ks * 32 + q4 * 8);

  f32x4 S[4][NQ], O[4][NQ];
  float m[NQ], l[NQ];
  const bf16_t* kcb = P.kc + (size_t)(b * 2 + kvh) * 128 * 64;
  const bf16_t* vcb = P.vcT + (size_t)(b * 2 + kvh) * 64 * 128;
  const int njb = (c32 + 1 + 63) >> 6;
  attn_reset(m, l, O);

  uint4 rk0, rk1, rv0, rv1;
  KV_ISSUE(kcb, vcb, 128);
  for (int jb = 0; jb < njb; ++jb) {
    __syncthreads();
    KV_STORE();
    __syncthreads();
    { const int jn = (jb + 1 < njb) ? jb + 1 : 0; KV_ISSUE(kcb + (size_t)jn * 64 * 64, vcb + jn * 64, 128); }
    __builtin_amdgcn_sched_barrier(0);
    attn_scores(KT, kfr0, qf, S);
    attn_mask(S, 3, 3, hb, posbase, jb * 64, l15, q4);
    attn_softmax_step(S, m, l, O, false);
  }
  float invl[NQ];
#pragma unroll
  for (int nq = 0; nq < NQ; ++nq) { float lt = l[nq]; lt += __shfl_xor(lt, 16); lt += __shfl_xor(lt, 32); invl[nq] = 1.0f / fmaxf(lt, 1e-30f); }
  for (int jb = 0; jb < njb; ++jb) {
    __syncthreads();
    KV_STORE();
    __syncthreads();
    { const int jn = (jb + 1 < njb) ? jb + 1 : jb; KV_ISSUE(kcb + (size_t)jn * 64 * 64, vcb + jn * 64, 128); }
    __builtin_amdgcn_sched_barrier(0);
    attn_scores(KT, kfr0, qf, S);
    attn_mask(S, 3, 3, hb, posbase, jb * 64, l15, q4);
#pragma unroll
    for (int nq = 0; nq < NQ; ++nq)
#pragma unroll
      for (int mk = 0; mk < 4; ++mk)
#pragma unroll
        for (int r = 0; r < 4; ++r) S[mk][nq][r] = __builtin_amdgcn_exp2f(S[mk][nq][r] - fmaxf(m[nq], -1e28f)) * invl[nq];
    for (int gg = 0; gg < 4; ++gg) {
      if (g == gg) {
#pragma unroll
        for (int nq = 0; nq < NQ; ++nq)
#pragma unroll
          for (int mk = 0; mk < 4; ++mk) {
            float* ip = IMP + (nq * 16 + l15) * 65 + jb * 32 + mk * 8 + q4 * 2;
            const float v0 = S[mk][nq][0] + S[mk][nq][1], v1 = S[mk][nq][2] + S[mk][nq][3];
            if (gg == 0) { ip[0] = v0; ip[1] = v1; } else { ip[0] += v0; ip[1] += v1; }
          }
      }
      __syncthreads();
    }
    attn_pv(VT, vfr0, S, O);
  }
  uint2 oreg[4][NQ];
#pragma unroll
  for (int nq = 0; nq < NQ; ++nq) {
    const float g0 = sigmoidf_(bf2f(P.z[(tok0 + nq * 16 + l15) * ZLD + ZC_NG + h * 3 + 0]));
#pragma unroll
    for (int md = 0; md < 4; ++md) {
      oreg[md][nq].x = pack2(O[md][nq][0] * g0, O[md][nq][1] * g0); oreg[md][nq].y = pack2(O[md][nq][2] * g0, O[md][nq][3] * g0);
    }
  }
  __syncthreads();
  for (int i = 0; i < 8; ++i) {
    const int rr = g * 8 + i;
    const float v = IMP[rr * 65 + lane];
    const bool visible = lane <= c;
    const bool forced = (lane == 0) || (lane == c) || (lane == c - 1);
    const float val = forced ? 1e4f : (visible ? v : -INFINITY);
    int rank = 0;
#pragma unroll
    for (int j = 0; j < 64; ++j) {
      const float vj = __int_as_float(__builtin_amdgcn_readlane(__float_as_int(val), j));
      rank += ((vj > val) || (vj == val && j < lane)) ? 1 : 0;
    }
    const bool sel = (rank < 16) && visible;
    const unsigned long long mk = __ballot(sel);
    if (lane == 0) { MASK[rr * 2] = (uint32_t)mk; MASK[rr * 2 + 1] = (uint32_t)(mk >> 32); }
  }
  __syncthreads();
  uint32_t ulo = MASK[(lane & 31) * 2], uhi = MASK[(lane & 31) * 2 + 1];
#pragma unroll
  for (int o = 16; o >= 1; o >>= 1) { ulo |= __shfl_xor(ulo, o); uhi |= __shfl_xor(uhi, o); }
  ulo = __builtin_amdgcn_readfirstlane(ulo); uhi = __builtin_amdgcn_readfirstlane(uhi);
  unsigned long long rem = ((unsigned long long)uhi << 32) | ulo;
  unsigned long long mrow[NQ];
#pragma unroll
  for (int nq = 0; nq < NQ; ++nq) mrow[nq] = ((unsigned long long)MASK[(nq * 16 + l15) * 2 + 1] << 32) | MASK[(nq * 16 + l15) * 2];

  attn_reset(m, l, O);
  {
    const bf16_t* kb = P.ksn + (size_t)(b * 2 + kvh) * SEQL * 64;
    const bf16_t* vb = P.vsT + (size_t)(b * 2 + kvh) * 64 * LDV;
    int j = __builtin_ctzll(rem);
    rem &= rem - 1;
    KV_ISSUE(kb + (size_t)j * 64 * 64, vb + j * 64, LDV);
    __syncthreads();
    KV_STORE();
    bool last = (rem == 0);
    int jn = last ? j : __builtin_ctzll(rem);
    rem &= rem - 1;
    KV_ISSUE(kb + (size_t)jn * 64 * 64, vb + jn * 64, LDV);
    __syncthreads();
    int pb = 0;
    for (;;) {
      const char* KTc = smem + pb * 32768; const char* VTc = KTc + 8192;
      __builtin_amdgcn_sched_barrier(0);
      attn_scores(KTc, kfr0, qf, S);
      int selbits = 0;
#pragma unroll
      for (int nq = 0; nq < NQ; ++nq) selbits |= (int)((mrow[nq] >> j) & 1ull) << nq;
      if (j == c) attn_mask(S, 1, selbits, hb, posbase, 0, l15, q4); else attn_mask(S, 0, selbits, hb, posbase, 0, l15, q4);
      attn_softmax_step(S, m, l, O, true);
      attn_pv(VTc, vfr0, S, O);
      if (last) break;
      { char* KT = smem + (pb ^ 1) * 32768; char* VT = KT + 8192; KV_STORE(); }
      j = jn; last = (rem == 0); jn = last ? j : __builtin_ctzll(rem); rem &= rem - 1;
      KV_ISSUE(kb + (size_t)jn * 64 * 64, vb + jn * 64, LDV);
      __syncthreads();
      pb ^= 1;
    }
  }
#pragma unroll
  for (int nq = 0; nq < NQ; ++nq) {
    float lt = l[nq]; lt += __shfl_xor(lt, 16); lt += __shfl_xor(lt, 32);
    const float sc = sigmoidf_(bf2f(P.z[(tok0 + nq * 16 + l15) * ZLD + ZC_NG + h * 3 + 1])) / fmaxf(lt, 1e-30f);
#pragma unroll
    for (int md = 0; md < 4; ++md) {
      const uint2 ov = oreg[md][nq];
      oreg[md][nq].x = pack2(lo2f(ov.x) + O[md][nq][0] * sc, hi2f(ov.x) + O[md][nq][1] * sc);
      oreg[md][nq].y = pack2(lo2f(ov.y) + O[md][nq][2] * sc, hi2f(ov.y) + O[md][nq][3] * sc);
    }
  }
  attn_reset(m, l, O);
  {
    const bf16_t* kb = P.kwn + (size_t)(b * 2 + kvh) * SEQL * 64;
    const bf16_t* vb = P.vwT + (size_t)(b * 2 + kvh) * 64 * LDV;
    const int j0 = (c - 8 > 0) ? (c - 8) : 0;
    int j = j0;
    KV_ISSUE(kb + (size_t)j * 64 * 64, vb + j * 64, LDV);
    __syncthreads();
    KV_STORE();
    int jn = (j < c) ? j + 1 : j;
    KV_ISSUE(kb + (size_t)jn * 64 * 64, vb + jn * 64, LDV);
    __syncthreads();
    int pb = 0;
    for (;;) {
      const char* KTc = smem + pb * 32768; const char* VTc = KTc + 8192;
      __builtin_amdgcn_sched_barrier(0);
      attn_scores(KTc, kfr0, qf, S);
      if (j == c) attn_mask(S, 1, 3, hb, posbase, 0, l15, q4);
      else if (j == c - 8) attn_mask(S, 2, 3, hb, posbase, 0, l15, q4);
      attn_softmax_step(S, m, l, O, true);
      attn_pv(VTc, vfr0, S, O);
      if (j == c) break;
      { char* KT = smem + (pb ^ 1) * 32768; char* VT = KT + 8192; KV_STORE(); }
      j = jn; jn = (j < c) ? j + 1 : j;
      KV_ISSUE(kb + (size_t)jn * 64 * 64, vb + jn * 64, LDV);
      __syncthreads();
      pb ^= 1;
    }
  }
#pragma unroll
  for (int nq = 0; nq < NQ; ++nq) {
    float lt = l[nq]; lt += __shfl_xor(lt, 16); lt += __shfl_xor(lt, 32);
    const float sc = sigmoidf_(bf2f(P.z[(tok0 + nq * 16 + l15) * ZLD + ZC_NG + h * 3 + 2])) / fmaxf(lt, 1e-30f);
#pragma unroll
    for (int md = 0; md < 4; ++md) {
      const uint2 ov = oreg[md][nq];
      uint2 w; w.x = pack2(lo2f(ov.x) + O[md][nq][0] * sc, hi2f(ov.x) + O[md][nq][1] * sc); w.y = pack2(lo2f(ov.y) + O[md][nq][2] * sc, hi2f(ov.y) + O[md][nq][3] * sc);
      *(uint2*)(P.ob + (tok0 + nq * 16 + l15) * LD5 + h * 64 + md * 16 + q4 * 4) = w;
    }
  }
}
__device__ void phase_attn_s5(const Params& P, int layer, char* smem, int pass) {
  if (BIDX < 128) { s5_unit(P, layer, BIDX, smem); }
  unsigned* ctr = P.bar + 3600 + (layer * 2 + pass) * 56;
  volatile int* slot = (volatile int*)(smem + 65024);
  for (;;) {
    __syncthreads();
    if (threadIdx.x == 0) *slot = (int)atomicAdd(ctr, 1u);
    __syncthreads();
    const int u = __builtin_amdgcn_readfirstlane(*slot);
    if (u >= 1024) break;
    attn_unit(P, u, smem);
  }
}

#define NPHASE 11
__device__ __forceinline__ void run_phase(const Params& P, int layer, int ph, char* smem, float alpha = 1.0f) {
  switch (ph) {
    case 0: phase_convert(P, layer, smem); phase_cmp_bias(P, layer);
            phase_rmsnorm(layer == 0 ? P.in[0] : P.x, layer == 0 ? P.x : nullptr, P.in[1] + (size_t)layer * DM, P.hbuf); break;
    case 1: phase_gemm_in(P, smem); break;
    case 2: phase_prep(P, layer, smem); break;
    case 3: break;
    case 4: phase_cmp2(P, layer); break;
    case 5: phase_attn_s5(P, layer, smem, alpha == 0.0f ? 1 : 0); break;
    case 6: phase_merge(P, smem); break;
    case 7: phase_gemm_resid(P, P.hbuf, LDH, P.Wt_out, DM, smem, alpha); break;
    case 8: phase_rmsnorm(P.x, nullptr, P.in[21] + (size_t)layer * DM, P.hbuf); break;
    case 9: phase_gemm_gateup(P, smem); break;
    case 10: phase_gemm_resid(P, P.z, LDA, P.Wt_down, DFF, smem, alpha); break;
  }
}

#ifndef REPEAT_MASK
#define REPEAT_MASK 0
#endif
#if !MEGA
__global__ void __launch_bounds__(256, 2) k_phase(Params P, int layer, int ph) {
  __shared__ __attribute__((aligned(16))) char smem[65536];
  run_phase(P, layer, ph, smem);
}
#else
#define XB_TMO      128
#define XB_XCNT(j)  (256  + 64 * (j))
#define XB_XSUB(j)  (1280 + 64 * (j))
#define XB_XGEN(j)  (2304 + 64 * (j))
#define XB_TOP      3328
#define XB_TOPGEN   3392
#define XCD_BAR_WORDS 3456
#define XB_SPIN_CAP (1u << 22)
__device__ __forceinline__ unsigned xb_ld(unsigned* p)              { return __hip_atomic_load(p, __ATOMIC_RELAXED, __HIP_MEMORY_SCOPE_AGENT); }
__device__ __forceinline__ unsigned xb_add(unsigned* p, unsigned v) { return __hip_atomic_fetch_add(p, v, __ATOMIC_RELAXED, __HIP_MEMORY_SCOPE_AGENT); }
__device__ __forceinline__ unsigned xb_xcc_id() { return (unsigned)__builtin_amdgcn_s_getreg((3 << 11) | 20) & 0xFu; }
#define XB_SPIN(cond, bar) do { unsigned _sp = 0; while (cond) { __builtin_amdgcn_s_sleep(1); \
    if ((++_sp & 255u) == 0u) { if (xb_ld(&(bar)[XB_TMO])) break; if (_sp > XB_SPIN_CAP) { atomicAdd(&(bar)[XB_TMO], 1u); break; } } } } while (0)
struct XcdBarrier { unsigned* bar; unsigned x, nloc, nx; };
__device__ __forceinline__ void xcd_barrier_complete(unsigned* bar, unsigned x, unsigned& nloc, unsigned& nx) {
  const unsigned G = gridDim.x;
  unsigned sum, cnt, mine, sp = 0u;
  for (;;) {
    sum = 0u; cnt = 0u; mine = 0u;
#pragma unroll
    for (unsigned j = 0; j < 16; ++j) { const unsigned c = xb_ld(&bar[XB_XCNT(j)]); sum += c; cnt += (c > 0u) ? 1u : 0u; mine = (j == x) ? c : mine; }
    if (sum == G) break;
    __builtin_amdgcn_s_sleep(1);
    if ((++sp & 255u) == 0u) { if (xb_ld(&bar[XB_TMO])) break; if (sp > XB_SPIN_CAP) { atomicAdd(&bar[XB_TMO], 1u); break; } }
  }
  nloc = mine > 0u ? mine : 1u; nx = cnt > 0u ? cnt : 1u;
}
__device__ __forceinline__ void xcd_barrier(const XcdBarrier& b) {
  asm volatile("s_waitcnt vmcnt(0)" ::: "memory");
  __syncthreads();
  if (threadIdx.x == 0) {
    unsigned* bar = b.bar;
    __builtin_amdgcn_s_waitcnt(0);
    const unsigned nloc = b.nloc, nx = b.nx;
    const unsigned old = xb_add(&bar[XB_XSUB(b.x)], 1u);
    const unsigned gen = old / nloc;
    if (old + 1u == (gen + 1u) * nloc) {
      __builtin_amdgcn_fence(__ATOMIC_RELEASE, "agent");
      asm volatile("s_waitcnt vmcnt(0)" ::: "memory");
      const unsigned og = xb_add(&bar[XB_TOP], 1u);
      const unsigned tg = og / nx;
      if (og + 1u == (tg + 1u) * nx) xb_add(&bar[XB_TOPGEN], 1u);
      else XB_SPIN(xb_ld(&bar[XB_TOPGEN]) == tg, bar);
      __builtin_amdgcn_fence(__ATOMIC_ACQUIRE, "agent");
      xb_add(&bar[XB_XGEN(b.x)], 1u);
      asm volatile("s_waitcnt vmcnt(0)" ::: "memory");
    } else {
      XB_SPIN(xb_ld(&bar[XB_XGEN(b.x)]) == gen, bar);
      __builtin_amdgcn_fence(__ATOMIC_ACQUIRE, "agent");
      asm volatile("s_waitcnt vmcnt(0)" ::: "memory");
    }
  }
  __syncthreads();
}

__global__ void __launch_bounds__(256, 2) k_mega(Params P) {
  __shared__ __attribute__((aligned(16))) char smem[65536];
  if (P.x == nullptr) { cg::this_grid().sync(); }
  XcdBarrier xb; xb.bar = P.bar; xb.x = xb_xcc_id(); xb.nloc = 1u; xb.nx = 1u;
  if (threadIdx.x == 0) { (void)xb_add(&P.bar[XB_XCNT(xb.x)], 1u); xcd_barrier_complete(P.bar, xb.x, xb.nloc, xb.nx); }
  for (int layer = 0; layer < DEPTH; ++layer) {
    for (int ph = 0; ph < NPHASE; ++ph) {
      if (ph == 3) continue;
      run_phase(P, layer, ph, smem);
      if ((REPEAT_MASK >> ph) & 1) { xcd_barrier(xb); run_phase(P, layer, ph, smem, 0.0f); }
      if (!(layer == DEPTH - 1 && ph == NPHASE - 1)) xcd_barrier(xb);
    }
  }
}
#endif

extern "C" void kernel_launch(void* const* d_in, const int* in_sizes, int n_in, void* d_out, int out_size, void* d_ws, size_t ws_size, hipStream_t stream) {
  Params P;
  memset(&P, 0, sizeof(P));
  for (int i = 0; i < 24; ++i) P.in[i] = (const float*)d_in[i];
  P.x = (float*)d_out;
  char* w = (char*)d_ws;
  size_t off = 0;
  auto take = [&](size_t bytes) { char* p = w + off; off += (bytes + 255) & ~(size_t)255; return (bf16_t*)p; };
  P.Wt_in = take((size_t)ZLD * LDH * 2);
  P.Wt_glu = take((size_t)2048 * LD5 * 2);
  P.Wt_conv = take((size_t)1024 * LD5 * 2);
  P.Wt_o = take((size_t)1024 * LD5 * 2);
  P.Wt_out = take((size_t)1024 * LDH * 2);
  P.Wt_gu = take((size_t)5632 * LDH * 2);
  P.Wt_down = take((size_t)1024 * LDA * 2);
  P.Wt_c1 = take((size_t)512 * LDC * 2);
  P.z = take((size_t)T_TOK * ZLD * 2);
  P.hbuf = take((size_t)T_TOK * LDH * 2);
  P.ys = take((size_t)T_TOK * LD5 * 2);
  P.cv = take((size_t)T_TOK * LD5 * 2);
  P.ob = take((size_t)T_TOK * LD5 * 2);
  P.qn = take((size_t)T_TOK * 512 * 2);
  P.ksn = take((size_t)T_TOK * 128 * 2);
  P.kwn = take((size_t)T_TOK * 128 * 2);
  P.vsT = take((size_t)8 * 64 * LDV * 2);
  P.vwT = take((size_t)8 * 64 * LDV * 2);
  P.acmp = take((size_t)2 * 1024 * LDC * 2);
  P.hid = take((size_t)2 * 1024 * 256 * 2);
  P.kc = take((size_t)8 * 128 * 64 * 2);
  P.vcT = take((size_t)8 * 64 * 128 * 2);
  P.bar = (unsigned*)take((size_t)4096 * 4);
  P.cbias = (float*)take((size_t)512 * 4);
  if (off > ws_size) { fprintf(stderr, "kernel_launch: workspace too small: need %zu have %zu\n", off, ws_size); return; }
#if MEGA
  static int grid_blocks = 0;
  if (!grid_blocks) {
    int dev = 0, cus = 0, per_cu = 0;
    hipGetDevice(&dev);
    hipDeviceGetAttribute(&cus, hipDeviceAttributeMultiprocessorCount, dev);
    hipOccupancyMaxActiveBlocksPerMultiprocessor(&per_cu, k_mega, 256, 0);
    (void)per_cu;
    grid_blocks = cus * 2;
  }
  hipMemsetAsync(P.bar, 0, 4096 * 4, stream);
  void* args[] = {&P};
  hipError_t e = hipLaunchCooperativeKernel((void*)k_mega, dim3(grid_blocks), dim3(256), args, 0, stream);
  if (e != hipSuccess) fprintf(stderr, "cooperative launch failed: %s (grid %d)\n", hipGetErrorString(e), grid_blocks);
#else
  for (int layer = 0; layer < DEPTH; ++layer)
    for (int ph = 0; ph < NPHASE; ++ph) {
      hipLaunchKernelGGL(k_phase, dim3(512), dim3(256), 0, stream, P, layer, ph);
      if ((REPEAT_MASK >> ph) & 1) hipLaunchKernelGGL(k_phase, dim3(512), dim3(256), 0, stream, P, layer, ph);
    }
#endif
}
```

```cpp
#include <hip/hip_runtime.h>
#include <hip/hip_cooperative_groups.h>
#include <stdint.h>
#include <cstdio>
#include <cstring>
namespace cg = cooperative_groups;

#ifndef MEGA
#define MEGA 1
#endif

typedef unsigned short bf16_t;
typedef short bf16x8 __attribute__((ext_vector_type(8)));
typedef float f32x4 __attribute__((ext_vector_type(4)));

#define T_TOK 16384
#define SEQL 4096
#define DM 1024
#define ZLD 6528
#define NIN 6424
#define DFF 2816
#define DEPTH 4
#define LDH 1088
#define LD5 576
#define LDA 2880
#define LDC 2112
#define LDV 4160
#define LDS_F 544
#define ZC_U 0
#define ZC_CB 512
#define ZC_CC 1024
#define ZC_CX 1536
#define ZC_Q 2048
#define ZC_KC 2560
#define ZC_VC 2688
#define ZC_KS 2816
#define ZC_VS 2944
#define ZC_KW 3072
#define ZC_VW 3200
#define ZC_MIX 3328
#define ZC_NG 6400
#define RMS_EPS 1e-6f

struct Params {
  const float* in[24];
  float* x;
  bf16_t *Wt_in, *Wt_glu, *Wt_conv, *Wt_o, *Wt_out, *Wt_gu, *Wt_down, *Wt_c1;
  bf16_t *z, *hbuf, *ys, *cv, *ob, *qn, *ksn, *kwn, *vsT, *vwT, *acmp, *hid, *kc, *vcT;
  unsigned* bar;
  float* cbias;
};

__device__ __forceinline__ int tidx_() { int t = threadIdx.x; asm volatile("" : "+v"(t)); return t; }
__device__ __forceinline__ int bidx_() { int t = blockIdx.x; asm volatile("" : "+s"(t)); return t; }
#define TIDX tidx_()
#define BIDX bidx_()
__device__ __forceinline__ float bf2f(bf16_t b) { return __uint_as_float(((uint32_t)b) << 16); }
__device__ __forceinline__ uint32_t pack2(float lo, float hi) {
  uint32_t r; asm("v_cvt_pk_bf16_f32 %0, %1, %2" : "=v"(r) : "v"(lo), "v"(hi)); return r;
}
__device__ __forceinline__ float lo2f(uint32_t w) { return __uint_as_float(w << 16); }
__device__ __forceinline__ float hi2f(uint32_t w) { return __uint_as_float(w & 0xffff0000u); }
__device__ __forceinline__ float sigmoidf_(float x) { return __builtin_amdgcn_rcpf(1.0f + __expf(-x)); }
__device__ __forceinline__ float gelu_tanh(float x) { return x * sigmoidf_(1.5957691216f * (x + 0.044715f * x * x * x)); }
__device__ __forceinline__ int lds_off(int row, int ch) { return row * 128 + ((ch ^ ((row >> 1) & 7)) << 4); }

__device__ void conv_job(const float* __restrict__ src, int K, int Nsrc, int col0, int ncols, bf16_t* __restrict__ dst, int drow0, float* lt, int b0, int bs, int mode = 0) {
  const int tid = TIDX;
  const int kt = K >> 6, nt = (ncols + 63) >> 6;
  for (int tile = b0; tile < kt * nt; tile += bs) {
    const int tk = tile % kt, tn = tile / kt;
    const int nl = tid & 63, kl = tid >> 6;
    const int n = tn * 64 + nl;
#pragma unroll
    for (int i = 0; i < 16; ++i) {
      const int k = kl + 4 * i;
      int sc = col0 + n;
      if (mode == 1) { const int t = n >> 7, r = n & 127, wc = r >> 6, nn = (r & 63) >> 4, ii = r & 15; sc = ((nn < 2) ? 0 : DFF) + t * 64 + wc * 32 + (nn & 1) * 16 + ii; }
      float v = (n < ncols) ? src[(size_t)(tk * 64 + k) * Nsrc + sc] : 0.f;
      lt[nl * 65 + k] = v;
    }
    __syncthreads();
    const int k8 = (tid & 7) * 8, n2 = tid >> 3;
#pragma unroll
    for (int i = 0; i < 2; ++i) {
      const int nn = n2 + 32 * i;
      if (tn * 64 + nn < ncols) {
        const float* r = lt + nn * 65 + k8;
        uint4 w;
        w.x = pack2(r[0], r[1]); w.y = pack2(r[2], r[3]); w.z = pack2(r[4], r[5]); w.w = pack2(r[6], r[7]);
        *(uint4*)(dst + (size_t)(drow0 + tn * 64 + nn) * (K + 64) + tk * 64 + k8) = w;
      }
    }
    __syncthreads();
  }
}

__device__ void phase_convert(const Params& P, int layer, char* smem) {
  float* lt = (float*)smem;
  const int b0 = BIDX, bs = gridDim.x;
  const float* w_in = P.in[2] + (size_t)layer * DM * NIN;
  conv_job(w_in, DM, NIN, 0, 3328, P.Wt_in, 0, lt, b0, bs);
  conv_job(w_in, DM, NIN, 3352, 3072, P.Wt_in, ZC_MIX, lt, b0, bs);
  conv_job(w_in, DM, NIN, 3328, 24, P.Wt_in, ZC_NG, lt, b0, bs);
  conv_job(P.in[17] + (size_t)(layer * 2 + 0) * 2048 * 256, 2048, 256, 0, 256, P.Wt_c1, 0, lt, b0, bs);
  conv_job(P.in[17] + (size_t)(layer * 2 + 1) * 2048 * 256, 2048, 256, 0, 256, P.Wt_c1, 256, lt, b0, bs);
}
__device__ void phase_convert_late(const Params& P, int layer, char* smem, int b0, int bs) {
  float* lt = (float*)smem;
  conv_job(P.in[11] + (size_t)layer * 512 * 2048, 512, 2048, 0, 2048, P.Wt_glu, 0, lt, b0, bs);
  conv_job(P.in[13] + (size_t)layer * 512 * 1024, 512, 1024, 0, 1024, P.Wt_conv, 0, lt, b0, bs);
  conv_job(P.in[19] + (size_t)layer * 512 * 1024, 512, 1024, 0, 1024, P.Wt_o, 0, lt, b0, bs);
  conv_job(P.in[20] + (size_t)layer * 1024 * 1024, 1024, 1024, 0, 1024, P.Wt_out, 0, lt, b0, bs);
  conv_job(P.in[22] + (size_t)layer * 1024 * 5632, 1024, 5632, 0, 5632, P.Wt_gu, 0, lt, b0, bs, 1);
  conv_job(P.in[23] + (size_t)layer * DFF * 1024, DFF, 1024, 0, 1024, P.Wt_down, 0, lt, b0, bs);
}

__device__ void phase_rmsnorm(const float* __restrict__ xin, float* __restrict__ xcopy, const float* __restrict__ g, bf16_t* __restrict__ out) {
  const int lane = TIDX & 63, wave = TIDX >> 6;
  for (int tok = BIDX * 4 + wave; tok < T_TOK; tok += gridDim.x * 4) {
    const float4* xr = (const float4*)(xin + (size_t)tok * DM);
    float4 v[4];
    float ss = 0.f;
#pragma unroll
    for (int i = 0; i < 4; ++i) { v[i] = xr[lane + 64 * i]; ss += v[i].x * v[i].x + v[i].y * v[i].y + v[i].z * v[i].z + v[i].w * v[i].w; }
#pragma unroll
    for (int o = 32; o >= 1; o >>= 1) ss += __shfl_xor(ss, o);
    const float r = rsqrtf(ss * (1.0f / DM) + RMS_EPS);
    if (xcopy) {
      float4* xc = (float4*)(xcopy + (size_t)tok * DM);
#pragma unroll
      for (int i = 0; i < 4; ++i) xc[lane + 64 * i] = v[i];
    }
#pragma unroll
    for (int i = 0; i < 4; ++i) {
      const float4 gg = ((const float4*)g)[lane + 64 * i];
      uint2 w; w.x = pack2(v[i].x * r * gg.x, v[i].y * r * gg.y); w.y = pack2(v[i].z * r * gg.z, v[i].w * r * gg.w);
      *(uint2*)(out + (size_t)tok * LDH + (lane + 64 * i) * 4) = w;
    }
  }
}

template <bool A_GATHER = false>
__device__ __forceinline__ void gemm_main(const bf16_t* __restrict__ A, size_t lda, const bf16_t* __restrict__ Bt, int ldb, int K, f32x4 (&acc)[4][4], char* smem, size_t kstepA = 64) {
  const int tid = TIDX, lane = tid & 63, wave = tid >> 6, wr = wave >> 1, wc = wave & 1, l15 = lane & 15, q4 = lane >> 4;
  const int lrow = tid >> 3, lch = tid & 7;
  const bf16_t* ap = A_GATHER ? A : A + (size_t)lrow * lda + lch * 8;
  const bf16_t* bp = Bt + (size_t)lrow * ldb + lch * 8;
  const size_t sa = A_GATHER ? lda : (size_t)32 * lda, sb = (size_t)32 * ldb;
  typedef unsigned u32x4 __attribute__((ext_vector_type(4)));
  u32x4 ra0, ra1, ra2, ra3, rb0, rb1, rb2, rb3;
  u32x4 rc0, rc1, rc2, rc3, rd0, rd1, rd2, rd3;
  int nk = K >> 6;
  asm volatile("" : "+s"(nk));
  const int st_off = lds_off(lrow, lch);
  const int sw = (l15 >> 1) & 7;
  const int fr0 = l15 * 128 + (((q4 ^ (sw & 3)) << 4) | ((sw >> 2) << 6));
  const int a_off = wr * 8192 + fr0, b_off = 16384 + wc * 8192 + fr0;
#ifndef EXP_GL
#define EXP_GL 0
#endif
#ifndef EXP_LDSW
#define EXP_LDSW 0
#endif
#if EXP_GL
#define GLQ const volatile u32x4*
#define GLREP 2
#else
#define GLQ const u32x4*
#define GLREP 1
#endif
#if EXP_LDSW == 1
#define LSQ volatile u32x4*
#define LSREP 2
#else
#define LSQ u32x4*
#define LSREP 1
#endif
#define GLOAD0(AP, BP) do { for (int rep_ = 0; rep_ < GLREP; ++rep_) { ra0 = *(GLQ)(AP); ra1 = *(GLQ)((AP) + sa); ra2 = *(GLQ)((AP) + 2 * sa); ra3 = *(GLQ)((AP) + 3 * sa); \
                            rb0 = *(GLQ)(BP); rb1 = *(GLQ)((BP) + sb); rb2 = *(GLQ)((BP) + 2 * sb); rb3 = *(GLQ)((BP) + 3 * sb); } } while (0)
#define GLOAD1(AP, BP) do { for (int rep_ = 0; rep_ < GLREP; ++rep_) { rc0 = *(GLQ)(AP); rc1 = *(GLQ)((AP) + sa); rc2 = *(GLQ)((AP) + 2 * sa); rc3 = *(GLQ)((AP) + 3 * sa); \
                            rd0 = *(GLQ)(BP); rd1 = *(GLQ)((BP) + sb); rd2 = *(GLQ)((BP) + 2 * sb); rd3 = *(GLQ)((BP) + 3 * sb); } } while (0)
#define XW(P_, V_) asm volatile("ds_write_b128 %0, %1" :: "v"((unsigned)(size_t)(P_)), "v"(V_) : "memory")
#if EXP_LDSW == 2
#define XDUP0(PS) do { XW((PS), ra0); XW((PS) + 4096, ra1); XW((PS) + 8192, ra2); XW((PS) + 12288, ra3); XW((PS) + 16384, rb0); XW((PS) + 20480, rb1); XW((PS) + 24576, rb2); XW((PS) + 28672, rb3); } while (0)
#define XDUP1(PS) do { XW((PS), rc0); XW((PS) + 4096, rc1); XW((PS) + 8192, rc2); XW((PS) + 12288, rc3); XW((PS) + 16384, rd0); XW((PS) + 20480, rd1); XW((PS) + 24576, rd2); XW((PS) + 28672, rd3); } while (0)
#else
#define XDUP0(PS) do { } while (0)
#define XDUP1(PS) do { } while (0)
#endif
#define LSTORE0(PS) do { XDUP0(PS); for (int rep_ = 0; rep_ < LSREP; ++rep_) { *(LSQ)(PS) = ra0; *(LSQ)((PS) + 4096) = ra1; *(LSQ)((PS) + 8192) = ra2; *(LSQ)((PS) + 12288) = ra3; \
                         *(LSQ)((PS) + 16384) = rb0; *(LSQ)((PS) + 20480) = rb1; *(LSQ)((PS) + 24576) = rb2; *(LSQ)((PS) + 28672) = rb3; } } while (0)
#define LSTORE1(PS) do { XDUP1(PS); for (int rep_ = 0; rep_ < LSREP; ++rep_) { *(LSQ)(PS) = rc0; *(LSQ)((PS) + 4096) = rc1; *(LSQ)((PS) + 8192) = rc2; *(LSQ)((PS) + 12288) = rc3; \
                         *(LSQ)((PS) + 16384) = rd0; *(LSQ)((PS) + 20480) = rd1; *(LSQ)((PS) + 24576) = rd2; *(LSQ)((PS) + 28672) = rd3; } } while (0)
#define COMPUTE(BO) do { _Pragma("unroll") for (int ks = 0; ks < 2; ++ks) { \
      bf16x8 af[4], bfr[4]; \
      const char* pa = smem + (BO) + (a_off ^ (ks * 64)); \
      const char* pb = smem + (BO) + (b_off ^ (ks * 64)); \
      _Pragma("unroll") for (int m = 0; m < 4; ++m) af[m] = *(const bf16x8*)(pa + m * 2048); \
      _Pragma("unroll") for (int n = 0; n < 4; ++n) bfr[n] = *(const bf16x8*)(pb + n * 2048); \
      _Pragma("unroll") for (int m = 0; m < 4; ++m) \
        _Pragma("unroll") for (int n = 0; n < 4; ++n) acc[m][n] = __builtin_amdgcn_mfma_f32_16x16x32_bf16(bfr[n], af[m], acc[m][n], 0, 0, 0); } } while (0)
  GLOAD0(ap, bp);
  GLOAD1(ap + kstepA, bp + 64);
  LSTORE0(smem + st_off);
  __syncthreads();
#pragma nounroll
  for (int kt = 0; kt < nk; kt += 2) {
    { const int t2 = (kt + 2 < nk) ? kt + 2 : nk - 1; const bf16_t* ap2 = ap + t2 * kstepA; const bf16_t* bp2 = bp + t2 * 64; GLOAD0(ap2, bp2); }
    __builtin_amdgcn_sched_barrier(0);
    COMPUTE(0);
    LSTORE1(smem + 32768 + st_off);
    __syncthreads();
    { const int t3 = (kt + 3 < nk) ? kt + 3 : nk - 1; const bf16_t* ap2 = ap + t3 * kstepA; const bf16_t* bp2 = bp + t3 * 64; GLOAD1(ap2, bp2); }
    __builtin_amdgcn_sched_barrier(0);
    COMPUTE(32768);
    LSTORE0(smem + st_off);
    __syncthreads();
  }
#undef GLOAD0
#undef GLOAD1
#undef LSTORE0
#undef LSTORE1
#undef COMPUTE
#undef GLQ
#undef LSQ
#undef GLREP
#undef LSREP
}

__device__ __forceinline__ void gemm_main_shallow(const bf16_t* __restrict__ A, int lda, const bf16_t* __restrict__ Bt, int ldb, int K, f32x4 (&acc)[4][4], char* smem) {
  const int tid = TIDX, lane = tid & 63, wave = tid >> 6, wr = wave >> 1, wc = wave & 1, l15 = lane & 15, q4 = lane >> 4;
  const int lrow = tid >> 3, lch = tid & 7;
  const bf16_t* ap = A + (size_t)lrow * lda + lch * 8;
  const bf16_t* bp = Bt + (size_t)lrow * ldb + lch * 8;
  const size_t sa = (size_t)32 * lda, sb = (size_t)32 * ldb;
  uint4 ra0, ra1, ra2, ra3, rb0, rb1, rb2, rb3;
  int nk = K >> 6;
  asm volatile("" : "+s"(nk));
  const int st_off = lds_off(lrow, lch);
  const int sw = (l15 >> 1) & 7;
  const int fr0 = l15 * 128 + (((q4 ^ (sw & 3)) << 4) | ((sw >> 2) << 6));
  const int a_off = wr * 8192 + fr0, b_off = 16384 + wc * 8192 + fr0;
#define GLOAD(AP, BP) do { ra0 = *(const uint4*)(AP); ra1 = *(const uint4*)((AP) + sa); ra2 = *(const uint4*)((AP) + 2 * sa); ra3 = *(const uint4*)((AP) + 3 * sa); \
                           rb0 = *(const uint4*)(BP); rb1 = *(const uint4*)((BP) + sb); rb2 = *(const uint4*)((BP) + 2 * sb); rb3 = *(const uint4*)((BP) + 3 * sb); } while (0)
#define LSTORE(PS) do { *(uint4*)(PS) = ra0; *(uint4*)((PS) + 4096) = ra1; *(uint4*)((PS) + 8192) = ra2; *(uint4*)((PS) + 12288) = ra3; \
                        *(uint4*)((PS) + 16384) = rb0; *(uint4*)((PS) + 20480) = rb1; *(uint4*)((PS) + 24576) = rb2; *(uint4*)((PS) + 28672) = rb3; } while (0)
  GLOAD(ap, bp);
  LSTORE(smem + st_off);
  __syncthreads();
#pragma nounroll
  for (int kt = 0; kt < nk; ++kt) {
    const int bo = (kt & 1) * 32768;
    const bool more = kt + 1 < nk;
    if (more) { const bf16_t* ap2 = ap + (kt + 1) * 64; const bf16_t* bp2 = bp + (kt + 1) * 64; GLOAD(ap2, bp2); }
#pragma unroll
    for (int ks = 0; ks < 2; ++ks) {
      bf16x8 af[4], bfr[4];
      const char* pa = smem + bo + (a_off ^ (ks * 64));
      const char* pb = smem + bo + (b_off ^ (ks * 64));
#pragma unroll
      for (int m = 0; m < 4; ++m) af[m] = *(const bf16x8*)(pa + m * 2048);
#pragma unroll
      for (int n = 0; n < 4; ++n) bfr[n] = *(const bf16x8*)(pb + n * 2048);
#pragma unroll
      for (int m = 0; m < 4; ++m)
#pragma unroll
        for (int n = 0; n < 4; ++n) acc[m][n] = __builtin_amdgcn_mfma_f32_16x16x32_bf16(bfr[n], af[m], acc[m][n], 0, 0, 0);
    }
    if (more) { char* ps = smem + (bo ^ 32768) + st_off; LSTORE(ps); }
    __syncthreads();
  }
#undef GLOAD
#undef LSTORE
}

__device__ __forceinline__ void zero_acc(f32x4 (&acc)[4][4]) {
#pragma unroll
  for (int m = 0; m < 4; ++m)
#pragma unroll
    for (int n = 0; n < 4; ++n) acc[m][n] = (f32x4){0.f, 0.f, 0.f, 0.f};
}
__device__ __forceinline__ bool tile_coords(int u, int nN, int& tm, int& tn) {
  const int nfull = nN >> 3, full = nfull * 1024, xcd = u & 7;
  if (u < full) {
    const int loc = u >> 3, sb = loc >> 6, mi = loc & 7, ni = (loc >> 3) & 7;
    tm = xcd * 16 + (sb & 1) * 8 + mi; tn = (sb >> 1) * 8 + ni;
    return true;
  }
  const int loc = (u - full) >> 3;
  tm = xcd * 16 + (loc & 15); tn = nfull * 8 + (loc >> 4);
  return (loc >> 4) < (nN & 7);
}
__device__ __forceinline__ int tile_slots(int nN) { return 1024 * (nN >> 3) + ((nN & 7) ? 512 : 0); }
#define EPI_SETUP const int lane_ = TIDX & 63, wave_ = TIDX >> 6; const int rbase = tm * 128 + (wave_ >> 1) * 64 + (lane_ & 15); const int cbase = tn * 128 + (wave_ & 1) * 64 + (lane_ >> 4) * 4;

__device__ void phase_gemm_in(const Params& P, char* smem) {
  for (int u = BIDX; u < tile_slots(51); u += gridDim.x) {
    int tm, tn; if (!tile_coords(u, 51, tm, tn)) continue;
    f32x4 acc[4][4]; zero_acc(acc);
    gemm_main(P.hbuf + (size_t)tm * 128 * LDH, LDH, P.Wt_in + (size_t)tn * 128 * LDH, LDH, DM, acc, smem);
    EPI_SETUP
    const bool is_gate = (tn >= ZC_MIX / 128) && (tn < ZC_NG / 128);
#pragma unroll
    for (int m = 0; m < 4; ++m)
#pragma unroll
      for (int n = 0; n < 4; ++n) {
        const int row = rbase + m * 16, col = cbase + n * 16;
        f32x4 v = acc[m][n];
        if (is_gate) { v[0] = sigmoidf_(v[0]); v[1] = sigmoidf_(v[1]); v[2] = sigmoidf_(v[2]); v[3] = sigmoidf_(v[3]); }
        uint2 w; w.x = pack2(v[0], v[1]); w.y = pack2(v[2], v[3]);
        *(uint2*)(smem + (row - tm * 128) * 272 + (col - tn * 128) * 2) = w;
      }
    __syncthreads();
    {
      const int tid = TIDX;
#pragma unroll
      for (int i = 0; i < 8; ++i) {
        const int id = tid + 256 * i, r = id >> 4, c16 = id & 15;
        const uint4 v = *(const uint4*)(smem + r * 272 + c16 * 16);
        *(uint4*)(P.z + (size_t)(tm * 128 + r) * ZLD + tn * 128 + c16 * 8) = v;
      }
    }
    __syncthreads();
  }
}
__device__ void phase_gemm_resid(const Params& P, const bf16_t* A, int lda, const bf16_t* Bt, int K, char* smem, float alpha = 1.0f) {
  for (int u = BIDX; u < tile_slots(8); u += gridDim.x) {
    int tm, tn; if (!tile_coords(u, 8, tm, tn)) continue;
    f32x4 acc[4][4]; zero_acc(acc);
    gemm_main(A + (size_t)tm * 128 * lda, lda, Bt + (size_t)tn * 128 * (K + 64), K + 64, K, acc, smem);
    EPI_SETUP
#pragma unroll
    for (int m = 0; m < 4; ++m)
#pragma unroll
      for (int n = 0; n < 4; ++n) {
        const int row = rbase + m * 16, col = cbase + n * 16;
        float4* p = (float4*)(P.x + (size_t)row * DM + col);
        float4 v = *p;
        v.x += alpha * acc[m][n][0]; v.y += alpha * acc[m][n][1]; v.z += alpha * acc[m][n][2]; v.w += alpha * acc[m][n][3];
        *p = v;
      }
  }
}
__device__ void phase_gemm_gateup(const Params& P, char* smem) {
  bf16_t* act = P.z;
  for (int u = BIDX; u < tile_slots(44); u += gridDim.x) {
    int tm, tn; if (!tile_coords(u, 44, tm, tn)) continue;
    f32x4 acc[4][4]; zero_acc(acc);
    gemm_main(P.hbuf + (size_t)tm * 128 * LDH, LDH, P.Wt_gu + (size_t)tn * 128 * LDH, LDH, DM, acc, smem);
    const int lane_ = TIDX & 63, wave_ = TIDX >> 6;
    const int rbase = tm * 128 + (wave_ >> 1) * 64 + (lane_ & 15);
    const int cbase = tn * 64 + (wave_ & 1) * 32 + (lane_ >> 4) * 4;
#pragma unroll
    for (int m = 0; m < 4; ++m)
#pragma unroll
      for (int n = 0; n < 2; ++n) {
        const int row = rbase + m * 16, col = cbase + n * 16;
        float o[4];
#pragma unroll
        for (int r = 0; r < 4; ++r) { const float gq = acc[m][n][r]; o[r] = gq * sigmoidf_(gq) * acc[m][n + 2][r]; }
        uint2 w; w.x = pack2(o[0], o[1]); w.y = pack2(o[2], o[3]);
        *(uint2*)(smem + (row - tm * 128) * 144 + (col - tn * 64) * 2) = w;
      }
    __syncthreads();
    {
      const int tid = TIDX;
#pragma unroll
      for (int i = 0; i < 4; ++i) {
        const int id = tid + 256 * i, r = id >> 3, c8 = id & 7;
        const uint4 v = *(const uint4*)(smem + r * 144 + c8 * 16);
        *(uint4*)(act + (size_t)(tm * 128 + r) * LDA + tn * 64 + c8 * 8) = v;
      }
    }
    __syncthreads();
  }
}
__device__ void phase_gemm_cmp1(const Params& P, char* smem, int u0, int ustride) {
  float* hidp = (float*)P.acmp;
  for (int u = u0; u < 128; u += ustride) {
    const int kq = u & 3, r5 = u >> 2, which = r5 >> 4, rem = r5 & 15, tm = rem & 7, tn = rem >> 3;
    f32x4 acc[4][4]; zero_acc(acc);
    const int tid = TIDX, lrow = tid >> 3, lch = tid & 7;
    const bf16_t* ap = P.z + ((size_t)(tm * 64 + (lrow >> 1)) * 32 + kq * 8) * ZLD + (which ? ZC_VC : ZC_KC) + (lrow & 1) * 64 + lch * 8;
    gemm_main<true>(ap, (size_t)512 * ZLD, P.Wt_c1 + (size_t)which * 256 * LDC + (size_t)tn * 128 * LDC + kq * 512, LDC, 512, acc, smem, (size_t)ZLD);
    EPI_SETUP
#pragma unroll
    for (int m = 0; m < 4; ++m)
#pragma unroll
      for (int n = 0; n < 4; ++n) {
        const int row = rbase + m * 16, col = cbase + n * 16;
        *(f32x4*)(hidp + ((size_t)(kq * 2 + which) * 1024 + row) * 256 + col) = acc[m][n];
      }
  }
}
__device__ void phase_cmp_bias(const Params& P, int layer) {
  const int lane = TIDX & 63, wave = TIDX >> 6;
  for (int o = BIDX * 4 + wave; o < 512; o += gridDim.x * 4) {
    const int which = o >> 8, col = o & 255;
    const float* pe = P.in[16] + (size_t)(layer * 2 + which) * 2048;
    const float* w1 = P.in[17] + (size_t)(layer * 2 + which) * 2048 * 256 + col;
    float acc = 0.f;
    for (int k = lane; k < 2048; k += 64) acc += pe[k] * w1[(size_t)k * 256];
#pragma unroll
    for (int o2 = 32; o2 >= 1; o2 >>= 1) acc += __shfl_xor(acc, o2);
    if (lane == 0) P.cbias[o] = acc;
  }
}
__device__ __forceinline__ void merge_stage_gates(const bf16_t* __restrict__ zg, int tm, int tn, char* smem) {
  const int tid = TIDX;
#pragma unroll
  for (int i = 0; i < 8; ++i) {
    const int id = tid + 256 * i, r = id >> 4, c16 = id & 15;
    *(uint4*)(smem + r * 272 + c16 * 16) = *(const uint4*)(zg + (size_t)(tm * 128 + r) * ZLD + tn * 128 + c16 * 8);
  }
}
__device__ void phase_merge(const Params& P, char* smem) {
  for (int u = BIDX; u < tile_slots(8); u += gridDim.x) {
    int tm, tn; if (!tile_coords(u, 8, tm, tn)) continue;
    const int lane_ = TIDX & 63, wave_ = TIDX >> 6;
    const int loff = ((wave_ >> 1) * 64 + (lane_ & 15)) * 272 + ((wave_ & 1) * 64 + (lane_ >> 4) * 4) * 2;
    uint2 hreg[4][4];
    {
      f32x4 a0[4][4], a1[4][4]; zero_acc(a0); zero_acc(a1);
      gemm_main_shallow(P.ys + (size_t)tm * 128 * LD5, LD5, P.Wt_glu + (size_t)tn * 128 * LD5, LD5, 512, a0, smem);
      gemm_main_shallow(P.ys + (size_t)tm * 128 * LD5, LD5, P.Wt_glu + (size_t)(1024 + tn * 128) * LD5, LD5, 512, a1, smem);
      merge_stage_gates(P.z + ZC_MIX, tm, tn, smem);
      __syncthreads();
#pragma unroll
      for (int m = 0; m < 4; ++m)
#pragma unroll
        for (int n = 0; n < 4; ++n) {
          const uint2 gw = *(const uint2*)(smem + loff + m * 16 * 272 + n * 32);
          hreg[m][n].x = pack2(lo2f(gw.x) * a0[m][n][0] * sigmoidf_(a1[m][n][0]), hi2f(gw.x) * a0[m][n][1] * sigmoidf_(a1[m][n][1]));
          hreg[m][n].y = pack2(lo2f(gw.y) * a0[m][n][2] * sigmoidf_(a1[m][n][2]), hi2f(gw.y) * a0[m][n][3] * sigmoidf_(a1[m][n][3]));
        }
      __syncthreads();
    }
    int nbr = 3;
    asm volatile("" : "+s"(nbr));
    for (int br = 1; br < nbr; ++br) {
      f32x4 a1[4][4]; zero_acc(a1);
      const bf16_t* A = (br == 1) ? P.cv : P.ob;
      const bf16_t* B = (br == 1) ? P.Wt_conv : P.Wt_o;
      gemm_main_shallow(A + (size_t)tm * 128 * LD5, LD5, B + (size_t)tn * 128 * LD5, LD5, 512, a1, smem);
      merge_stage_gates(P.z + ZC_MIX + br * 1024, tm, tn, smem);
      __syncthreads();
#pragma unroll
      for (int m = 0; m < 4; ++m)
#pragma unroll
        for (int n = 0; n < 4; ++n) {
          const uint2 gw = *(const uint2*)(smem + loff + m * 16 * 272 + n * 32);
          const uint2 hv = hreg[m][n];
          hreg[m][n].x = pack2(lo2f(hv.x) + lo2f(gw.x) * a1[m][n][0], hi2f(hv.x) + hi2f(gw.x) * a1[m][n][1]);
          hreg[m][n].y = pack2(lo2f(hv.y) + lo2f(gw.y) * a1[m][n][2], hi2f(hv.y) + hi2f(gw.y) * a1[m][n][3]);
        }
      __syncthreads();
    }
#pragma unroll
    for (int m = 0; m < 4; ++m)
#pragma unroll
      for (int n = 0; n < 4; ++n) *(uint2*)(smem + loff + m * 16 * 272 + n * 32) = hreg[m][n];
    __syncthreads();
    {
      const int tid = TIDX;
#pragma unroll
      for (int i = 0; i < 8; ++i) {
        const int id = tid + 256 * i, r = id >> 4, c16 = id & 15;
        *(uint4*)(P.hbuf + (size_t)(tm * 128 + r) * LDH + tn * 128 + c16 * 8) = *(const uint4*)(smem + r * 272 + c16 * 16);
      }
    }
    __syncthreads();
  }
}

__device__ void s5_unit(const Params& P, int layer, int unit, char* smem) {
  const int b = unit >> 5, g = unit & 31;
  const int tid = TIDX, lane = tid & 63, w = tid >> 6, l15 = lane & 15, q4 = lane >> 4;
  const int p = lane, q = w;
  float* bu = (float*)smem;
  bf16_t* stb = (bf16_t*)(smem + 33280);
  float2* send = (float2*)(smem + 33280 + 17408);
  bf16_t* usb = (bf16_t*)(smem + 33280 + 17408 + 2048);
  const float* lam_re = P.in[3] + (size_t)layer * 32 * 64 + g * 64, *lam_im = P.in[4] + (size_t)layer * 32 * 64 + g * 64;
  const float* b_re = P.in[5] + ((size_t)layer * 32 + g) * 64 * 16, *b_im = P.in[6] + ((size_t)layer * 32 + g) * 64 * 16;
  const float* c_re = P.in[7] + ((size_t)layer * 32 + g) * 16 * 64, *c_im = P.in[8] + ((size_t)layer * 32 + g) * 16 * 64;
  const float dk = P.in[9][(size_t)layer * 512 + g * 16 + l15];
  const float dt = expf(P.in[10][layer * 32 + g]);
  float lbr, lbi, l16r, l16i;
  {
    const float lr = lam_re[p], li = lam_im[p];
    float sn, cs_; sincosf(li * dt, &sn, &cs_);
    const float e = expf(lr * dt);
    lbr = e * cs_; lbi = e * sn;
    l16r = lbr; l16i = lbi;
#pragma unroll
    for (int i = 0; i < 4; ++i) { const float tr = l16r * l16r - l16i * l16i, ti = 2.f * l16r * l16i; l16r = tr; l16i = ti; }
  }
  bf16x8 bB[2];
#pragma unroll
  for (int nt = 0; nt < 2; ++nt) {
    const int pp = (2 * w + nt) * 16 + l15, ps = pp >> 1, cpl = pp & 1;
    const float lr = lam_re[ps], li = lam_im[ps];
    float sn, cs_; sincosf(li * dt, &sn, &cs_);
    const float e = expf(lr * dt);
    const float nr = e * cs_ - 1.0f, ni = e * sn, den = lr * lr + li * li;
    const float cfr = (nr * lr + ni * li) / den, cfi = (ni * lr - nr * li) / den;
    float v[8];
#pragma unroll
    for (int j = 0; j < 8; ++j) {
      const int h = (q4 & 1) * 8 + j;
      const float br = b_re[ps * 16 + h], bi = b_im[ps * 16 + h];
      const float val = cpl ? (cfr * bi + cfi * br) : (cfr * br - cfi * bi);
      v[j] = (q4 < 2) ? val : 0.f;
    }
    union { uint32_t u[4]; bf16x8 x; } cv; cv.u[0] = pack2(v[0], v[1]); cv.u[1] = pack2(v[2], v[3]); cv.u[2] = pack2(v[4], v[5]); cv.u[3] = pack2(v[6], v[7]);
    bB[nt] = cv.x;
  }
  bf16x8 cB[4];
#pragma unroll
  for (int ks = 0; ks < 4; ++ks) {
    float v[8];
#pragma unroll
    for (int j = 0; j < 8; ++j) {
      const int pp = ks * 32 + q4 * 8 + j, ps = pp >> 1;
      v[j] = (pp & 1) ? -c_im[l15 * 64 + ps] : c_re[l15 * 64 + ps];
    }
    union { uint32_t u[4]; bf16x8 x; } cv; cv.u[0] = pack2(v[0], v[1]); cv.u[1] = pack2(v[2], v[3]); cv.u[2] = pack2(v[4], v[5]); cv.u[3] = pack2(v[6], v[7]);
    cB[ks] = cv.x;
  }
  float car_r = 0.f, car_i = 0.f;
  bf16x8 un0, un1, un2, un3;
  {
    const bf16_t* zp = P.z + ((size_t)b * SEQL + l15) * ZLD + ZC_U + g * 16 + (q4 & 1) * 8;
    un0 = *(const bf16x8*)(zp); un1 = *(const bf16x8*)(zp + (size_t)16 * ZLD); un2 = *(const bf16x8*)(zp + (size_t)32 * ZLD); un3 = *(const bf16x8*)(zp + (size_t)48 * ZLD);
  }
  for (int chunk = 0; chunk < 64; ++chunk) {
    const size_t tok0 = (size_t)b * SEQL + chunk * 64;
    {
      bf16x8 ua[4];
      const bf16x8 zz = (bf16x8){0, 0, 0, 0, 0, 0, 0, 0};
      ua[0] = (q4 < 2) ? un0 : zz; ua[1] = (q4 < 2) ? un1 : zz; ua[2] = (q4 < 2) ? un2 : zz; ua[3] = (q4 < 2) ? un3 : zz;
      if (w == 0 && q4 < 2) {
#pragma unroll
        for (int mt = 0; mt < 4; ++mt) *(bf16x8*)(usb + (chunk & 1) * 1024 + (mt * 16 + l15) * 16 + q4 * 8) = ua[mt];
      }
      if (chunk + 1 < 64) {
        const bf16_t* zp = P.z + (tok0 + 64 + l15) * ZLD + ZC_U + g * 16 + (q4 & 1) * 8;
        un0 = *(const bf16x8*)(zp); un1 = *(const bf16x8*)(zp + (size_t)16 * ZLD); un2 = *(const bf16x8*)(zp + (size_t)32 * ZLD); un3 = *(const bf16x8*)(zp + (size_t)48 * ZLD);
      }
#pragma unroll
      for (int mt = 0; mt < 4; ++mt)
#pragma unroll
        for (int nt = 0; nt < 2; ++nt) {
          const f32x4 acc = __builtin_amdgcn_mfma_f32_16x16x32_bf16(ua[mt], bB[nt], (f32x4){0.f, 0.f, 0.f, 0.f}, 0, 0, 0);
          float* dst = bu + (mt * 16 + q4 * 4) * 130 + (2 * w + nt) * 16 + l15;
          dst[0] = acc[0]; dst[130] = acc[1]; dst[260] = acc[2]; dst[390] = acc[3];
        }
    }
    __syncthreads();
    float locr[16], loci[16];
    float sr = 0.f, si = 0.f;
#pragma unroll
    for (int i = 0; i < 16; ++i) {
      const float2 v = *(const float2*)(bu + (q * 16 + i) * 130 + 2 * p);
      const float nsr = lbr * sr - lbi * si + v.x, nsi = lbr * si + lbi * sr + v.y;
      sr = nsr; si = nsi; locr[i] = sr; loci[i] = si;
    }
    send[q * 64 + p] = make_float2(sr, si);
    __syncthreads();
    float cur_r = car_r, cur_i = car_i, mine_r = 0.f, mine_i = 0.f;
#pragma unroll
    for (int qq = 0; qq < 4; ++qq) {
      if (qq == q) { mine_r = cur_r; mine_i = cur_i; }
      const float2 ev = send[qq * 64 + p];
      const float tr = l16r * cur_r - l16i * cur_i + ev.x, ti = l16r * cur_i + l16i * cur_r + ev.y;
      cur_r = tr; cur_i = ti;
    }
    car_r = cur_r; car_i = cur_i;
    float cpr = lbr * mine_r - lbi * mine_i, cpi = lbr * mine_i + lbi * mine_r;
#pragma unroll
    for (int i = 0; i < 16; ++i) {
      *(uint32_t*)(stb + (q * 16 + i) * 136 + 2 * p) = pack2(locr[i] + cpr, loci[i] + cpi);
      const float tr = lbr * cpr - lbi * cpi, ti = lbr * cpi + lbi * cpr;
      cpr = tr; cpi = ti;
    }
    __syncthreads();
    {
      f32x4 acc = (f32x4){0.f, 0.f, 0.f, 0.f};
#pragma unroll
      for (int ks = 0; ks < 4; ++ks) {
        const bf16x8 as = *(const bf16x8*)(stb + (w * 16 + l15) * 136 + ks * 32 + q4 * 8);
        acc = __builtin_amdgcn_mfma_f32_16x16x32_bf16(as, cB[ks], acc, 0, 0, 0);
      }
#pragma unroll
      for (int r = 0; r < 4; ++r) {
        const size_t t = tok0 + w * 16 + q4 * 4 + r;
        const float uval = bf2f(usb[(chunk & 1) * 1024 + (w * 16 + q4 * 4 + r) * 16 + l15]);
        const float y = gelu_tanh(acc[r] + dk * uval);
        P.ys[t * LD5 + g * 16 + l15] = (bf16_t)(pack2(y, 0.f) & 0xffffu);
      }
    }
  }
}

__device__ __forceinline__ void load8(const bf16_t* p, float (&f)[8]) {
  const uint4 w = *(const uint4*)p;
  f[0] = lo2f(w.x); f[1] = hi2f(w.x); f[2] = lo2f(w.y); f[3] = hi2f(w.y); f[4] = lo2f(w.z); f[5] = hi2f(w.z); f[6] = lo2f(w.w); f[7] = hi2f(w.w);
}
__device__ __forceinline__ void store8(bf16_t* p, const float (&f)[8]) {
  uint4 w; w.x = pack2(f[0], f[1]); w.y = pack2(f[2], f[3]); w.z = pack2(f[4], f[5]); w.w = pack2(f[6], f[7]);
  *(uint4*)p = w;
}
__device__ void prep_unit(const Params& P, int layer, int ck, char* smem) {
  const int tid = TIDX;
  const int tok0 = ck * 64, b = tok0 >> 12, s0 = tok0 & 4095;
  const bf16_t* z = P.z;
  {
    const float* cw = P.in[12] + (size_t)layer * 3 * 512;
    const int c2 = tid * 2;
    const float w00 = cw[c2], w01 = cw[c2 + 1], w10 = cw[512 + c2], w11 = cw[512 + c2 + 1], w20 = cw[1024 + c2], w21 = cw[1024 + c2 + 1];
    float p2a = 0.f, p2b = 0.f, p1a = 0.f, p1b = 0.f;
    if (s0 >= 2) {
      const uint32_t cc2 = *(const uint32_t*)(z + (size_t)(tok0 - 2) * ZLD + ZC_CC + c2), cx2 = *(const uint32_t*)(z + (size_t)(tok0 - 2) * ZLD + ZC_CX + c2);
      const uint32_t cc1 = *(const uint32_t*)(z + (size_t)(tok0 - 1) * ZLD + ZC_CC + c2), cx1 = *(const uint32_t*)(z + (size_t)(tok0 - 1) * ZLD + ZC_CX + c2);
      p2a = lo2f(cc2) * lo2f(cx2); p2b = hi2f(cc2) * hi2f(cx2); p1a = lo2f(cc1) * lo2f(cx1); p1b = hi2f(cc1) * hi2f(cx1);
    }
#pragma unroll 4
    for (int t = 0; t < 64; ++t) {
      const size_t ro = (size_t)(tok0 + t) * ZLD;
      const uint32_t cb = *(const uint32_t*)(z + ro + ZC_CB + c2), cc = *(const uint32_t*)(z + ro + ZC_CC + c2), cx = *(const uint32_t*)(z + ro + ZC_CX + c2);
      const float p0a = lo2f(cc) * lo2f(cx), p0b = hi2f(cc) * hi2f(cx);
      const float oa = lo2f(cb) * (w00 * p2a + w10 * p1a + w20 * p0a), ob_ = hi2f(cb) * (w01 * p2b + w11 * p1b + w21 * p0b);
      *(uint32_t*)(P.cv + (size_t)(tok0 + t) * LD5 + c2) = pack2(oa, ob_);
      p2a = p1a; p2b = p1b; p1a = p0a; p1b = p0b;
    }
  }
  {
    const float* qg = P.in[14] + (size_t)layer * 64;
    const int d8 = (tid & 7) * 8;
    float gq[8];
#pragma unroll
    for (int j = 0; j < 8; ++j) gq[j] = qg[d8 + j] * (0.125f * 1.44269504089f);
#pragma unroll 2
    for (int it = 0; it < 16; ++it) {
      const int row = it * 32 + (tid >> 3), t = row >> 3, h = row & 7;
      float f[8]; load8(z + (size_t)(tok0 + t) * ZLD + ZC_Q + h * 64 + d8, f);
      float ss = 0.f;
#pragma unroll
      for (int j = 0; j < 8; ++j) ss += f[j] * f[j];
      ss += __shfl_xor(ss, 1); ss += __shfl_xor(ss, 2); ss += __shfl_xor(ss, 4);
      const float r = rsqrtf(ss * (1.0f / 64.f) + RMS_EPS);
#pragma unroll
      for (int j = 0; j < 8; ++j) f[j] = f[j] * r * gq[j];
      store8(P.qn + (size_t)(tok0 + t) * 512 + h * 64 + d8, f);
    }
  }
  {
    const float* kg = P.in[15] + (size_t)layer * 3 * 64;
    const int d8 = (tid & 7) * 8;
#pragma unroll 2
    for (int it = 0; it < 8; ++it) {
      const int row = it * 32 + (tid >> 3), which = row >> 7, t = (row >> 1) & 63, kvh = row & 1;
      float f[8]; load8(z + (size_t)(tok0 + t) * ZLD + (which ? ZC_KW : ZC_KS) + kvh * 64 + d8, f);
      float ss = 0.f;
#pragma unroll
      for (int j = 0; j < 8; ++j) ss += f[j] * f[j];
      ss += __shfl_xor(ss, 1); ss += __shfl_xor(ss, 2); ss += __shfl_xor(ss, 4);
      const float r = rsqrtf(ss * (1.0f / 64.f) + RMS_EPS);
#pragma unroll
      for (int j = 0; j < 8; ++j) f[j] = f[j] * r * kg[(1 + which) * 64 + d8 + j];
      bf16_t* dst = (which ? P.kwn : P.ksn) + ((size_t)(b * 2 + kvh) * SEQL + s0 + t) * 64 + d8;
      store8(dst, f);
    }
  }
  {
    bf16_t* lt = (bf16_t*)smem;
    for (int which = 0; which < 2; ++which) {
      __syncthreads();
      {
        const int c8 = (tid & 15) * 8;
#pragma unroll
        for (int it = 0; it < 4; ++it) {
          const int t = it * 16 + (tid >> 4);
          const uint4 w = *(const uint4*)(z + (size_t)(tok0 + t) * ZLD + (which ? ZC_VW : ZC_VS) + c8);
          uint32_t* d = (uint32_t*)(lt + t * 130 + c8);
          d[0] = w.x; d[1] = w.y; d[2] = w.z; d[3] = w.w;
        }
      }
      __syncthreads();
      const int lane = tid & 63, wave = tid >> 6;
      bf16_t* dstb = which ? P.vwT : P.vsT;
#pragma unroll 4
      for (int it = 0; it < 32; ++it) {
        const int row = it * 4 + wave;
        dstb[((size_t)(b * 2) * 64 + row) * LDV + s0 + lane] = lt[lane * 130 + row];
      }
    }
  }
}
__device__ void phase_prep(const Params& P, int layer, char* smem) {
  const int bid = BIDX;
  if (bid < 128) { phase_gemm_cmp1(P, smem, bid, 128); __syncthreads(); phase_convert_late(P, layer, smem, 128 + bid, 256); }
  else if (bid < 384) { prep_unit(P, layer, bid - 128, smem); }
  else phase_convert_late(P, layer, smem, bid - 384, 256);
}

__device__ void phase_cmp2(const Params& P, int layer, char* smem) {
  const int lane = TIDX & 63, wave = TIDX >> 6;
  const float* hidp = (const float*)P.acmp;
  float* hs = (float*)(smem + wave * 1024);
  for (int wu = BIDX * 4 + wave; wu < 2048; wu += gridDim.x * 4) {
    const int which = wu >> 10, row = wu & 1023;
    const float* w2 = P.in[18] + (size_t)(layer * 2 + which) * 256 * 64;
#pragma unroll
    for (int i = 0; i < 4; ++i) {
      const int k = lane + 64 * i;
      float sv = P.cbias[which * 256 + k];
#pragma unroll
      for (int kq = 0; kq < 4; ++kq) sv += hidp[((size_t)(kq * 2 + which) * 1024 + row) * 256 + k];
      hs[k] = gelu_tanh(sv);
    }
    float acc = 0.f;
#pragma unroll 8
    for (int k = 0; k < 256; ++k) acc += hs[k] * w2[k * 64 + lane];
    const int kvh = row & 1, bc = row >> 1, b = bc >> 7, c = bc & 127;
    if (which == 0) {
      float ss = acc * acc;
#pragma unroll
      for (int o = 32; o >= 1; o >>= 1) ss += __shfl_xor(ss, o);
      const float r = rsqrtf(ss * (1.0f / 64.f) + RMS_EPS);
      const float v = acc * r * P.in[15][(size_t)layer * 3 * 64 + lane];
      P.kc[((size_t)(b * 2 + kvh) * 128 + c) * 64 + lane] = (bf16_t)(pack2(v, 0.f) & 0xffff);
    } else {
      P.vcT[((size_t)(b * 2 + kvh) * 64 + lane) * 128 + c] = (bf16_t)(pack2(acc, 0.f) & 0xffff);
    }
  }
}

#define NEGBIG (-1e30f)
#define NQ 2
__device__ __forceinline__ void attn_load_tiles(const bf16_t* __restrict__ Kp, const bf16_t* __restrict__ Vp, int vstride, char* KT, char* VT) {
  const int tid = TIDX;
  const int row = tid >> 3, ch = tid & 7;
  const int so = lds_off(row, ch);
  const uint4 k0 = *(const uint4*)(Kp + (size_t)row * 64 + ch * 8), k1 = *(const uint4*)(Kp + (size_t)(row + 32) * 64 + ch * 8);
  const uint4 v0 = *(const uint4*)(Vp + (size_t)row * vstride + ch * 8), v1 = *(const uint4*)(Vp + (size_t)(row + 32) * vstride + ch * 8);
  *(uint4*)(KT + so) = k0; *(uint4*)(KT + so + 4096) = k1;
  *(uint4*)(VT + so) = v0; *(uint4*)(VT + so + 4096) = v1;
}
#define KV_ISSUE(Kp, Vp, vstride) do { const int tid_ = TIDX; const int row_ = tid_ >> 3, ch_ = tid_ & 7; \
    rk0 = *(const uint4*)((Kp) + (size_t)row_ * 64 + ch_ * 8); rk1 = *(const uint4*)((Kp) + (size_t)(row_ + 32) * 64 + ch_ * 8); \
    rv0 = *(const uint4*)((Vp) + (size_t)row_ * (vstride) + ch_ * 8); rv1 = *(const uint4*)((Vp) + (size_t)(row_ + 32) * (vstride) + ch_ * 8); } while (0)
#define KV_STORE() do { const int tid_ = TIDX; const int so_ = lds_off(tid_ >> 3, tid_ & 7); \
    *(uint4*)(KT + so_) = rk0; *(uint4*)(KT + so_ + 4096) = rk1; *(uint4*)(VT + so_) = rv0; *(uint4*)(VT + so_ + 4096) = rv1; } while (0)
__device__ __forceinline__ void attn_scores(const char* KT, int kfr0, const bf16x8 (&qf)[NQ][2], f32x4 (&S)[4][NQ]) {
#pragma unroll
  for (int mk = 0; mk < 4; ++mk)
#pragma unroll
    for (int nq = 0; nq < NQ; ++nq) S[mk][nq] = (f32x4){0.f, 0.f, 0.f, 0.f};
#pragma unroll
  for (int ks = 0; ks < 2; ++ks) {
    const char* pk = KT + (kfr0 ^ (ks * 64));
#pragma unroll
    for (int mk = 0; mk < 4; ++mk) {
      const bf16x8 kf = *(const bf16x8*)(pk + mk * 2048);
#pragma unroll
      for (int nq = 0; nq < NQ; ++nq) S[mk][nq] = __builtin_amdgcn_mfma_f32_16x16x32_bf16(kf, qf[nq][ks], S[mk][nq], 0, 0, 0);
    }
  }
}
__device__ __forceinline__ void attn_pv(const char* VT, int vfr0, const f32x4 (&S)[4][NQ], f32x4 (&O)[4][NQ]) {
#pragma unroll
  for (int s2 = 0; s2 < 2; ++s2) {
    bf16x8 pf[NQ];
#pragma unroll
    for (int nq = 0; nq < NQ; ++nq) {
      union { uint32_t u[4]; bf16x8 v; } cvt;
      cvt.u[0] = pack2(S[2 * s2][nq][0], S[2 * s2][nq][1]); cvt.u[1] = pack2(S[2 * s2][nq][2], S[2 * s2][nq][3]);
      cvt.u[2] = pack2(S[2 * s2 + 1][nq][0], S[2 * s2 + 1][nq][1]); cvt.u[3] = pack2(S[2 * s2 + 1][nq][2], S[2 * s2 + 1][nq][3]);
      pf[nq] = cvt.v;
    }
    const char* pv0 = VT + (vfr0 ^ (s2 * 64));
    const char* pv1 = VT + (vfr0 ^ (s2 * 64) ^ 32);
#pragma unroll
    for (int md = 0; md < 4; ++md) {
      union { uint2 h[2]; bf16x8 v; } vv;
      vv.h[0] = *(const uint2*)(pv0 + md * 2048);
      vv.h[1] = *(const uint2*)(pv1 + md * 2048);
#pragma unroll
      for (int nq = 0; nq < NQ; ++nq) O[md][nq] = __builtin_amdgcn_mfma_f32_16x16x32_bf16(vv.v, pf[nq], O[md][nq], 0, 0, 0);
    }
  }
}
__device__ __forceinline__ void attn_mask(f32x4 (&S)[4][NQ], int mode, int selbits, int hb, int posbase, int kbase, int l15, int q4) {
#pragma unroll
  for (int nq = 0; nq < NQ; ++nq) {
    const int rr = nq * 16 + l15;
    const bool rs = (selbits >> nq) & 1;
    const int lim = (posbase + rr + 1) >> 5;
#pragma unroll
    for (int mk = 0; mk < 4; ++mk)
#pragma unroll
      for (int r = 0; r < 4; ++r) {
        const int kk = mk * 16 + q4 * 4 + r;
        bool valid = rs;
        if (mode == 1) valid = valid && (kk <= hb + rr);
        else if (mode == 2) valid = valid && (kk > hb + rr);
        else if (mode == 3) valid = valid && (kbase + kk < lim);
        S[mk][nq][r] = valid ? S[mk][nq][r] : NEGBIG;
      }
  }
}
__device__ __forceinline__ void attn_softmax_step(f32x4 (&S)[4][NQ], float (&m)[NQ], float (&l)[NQ], f32x4 (&O)[4][NQ], bool rescale) {
#pragma unroll
  for (int nq = 0; nq < NQ; ++nq) {
    float mx = NEGBIG;
#pragma unroll
    for (int mk = 0; mk < 4; ++mk)
#pragma unroll
      for (int r = 0; r < 4; ++r) mx = fmaxf(mx, S[mk][nq][r]);
    mx = fmaxf(mx, __shfl_xor(mx, 16)); mx = fmaxf(mx, __shfl_xor(mx, 32));
    const float mnew = fmaxf(m[nq], mx);
    const float alpha = __builtin_amdgcn_exp2f(m[nq] - mnew);
    m[nq] = mnew;
    const float muse = fmaxf(mnew, -1e28f);
    float ps = 0.f;
#pragma unroll
    for (int mk = 0; mk < 4; ++mk)
#pragma unroll
      for (int r = 0; r < 4; ++r) {
        const float pv = __builtin_amdgcn_exp2f(S[mk][nq][r] - muse);
        ps += pv; S[mk][nq][r] = pv;
      }
    l[nq] = l[nq] * alpha + ps;
    if (rescale && __ballot(alpha != 1.0f) != 0ull) {
#pragma unroll
      for (int md = 0; md < 4; ++md) O[md][nq] *= alpha;
    }
  }
}
__device__ __forceinline__ void attn_reset(float (&m)[NQ], float (&l)[NQ], f32x4 (&O)[4][NQ]) {
#pragma unroll
  for (int nq = 0; nq < NQ; ++nq) { m[nq] = NEGBIG; l[nq] = 0.f; }
#pragma unroll
  for (int md = 0; md < 4; ++md)
#pragma unroll
    for (int nq = 0; nq < NQ; ++nq) O[md][nq] = (f32x4){0.f, 0.f, 0.f, 0.f};
}

__device__ void attn_unit(const Params& P, int unit, char* smem) {
  const int c32 = 127 - (unit >> 3);
  const int bk = unit & 7, b = bk >> 1, kvh = bk & 1;
  const int c = c32 >> 1, hb = (c32 & 1) * 32, posbase = c32 * 32;
  const int tid = TIDX, lane = tid & 63, g = tid >> 6, l15 = lane & 15, q4 = lane >> 4;
  const int h = kvh * 4 + g;
  const size_t tok0 = (size_t)b * SEQL + posbase;
  char* KT = smem;
  char* VT = smem + 8192;
  float* IMP = (float*)(smem + 16384);
  uint32_t* MASK = (uint32_t*)(smem + 16384 + 32 * 65 * 4);
  const int sw = (l15 >> 1) & 7;
  const int kfr0 = l15 * 128 + (((q4 ^ (sw & 3)) << 4) | ((sw >> 2) << 6));
  const int vfr0 = l15 * 128 + ((((q4 >> 1) ^ (sw & 1)) | (sw & 6)) << 4) + (q4 & 1) * 8;

  bf16x8 qf[NQ][2];
#pragma unroll
  for (int nq = 0; nq < NQ; ++nq)
#pragma unroll
    for (int ks = 0; ks < 2; ++ks) qf[nq][ks] = *(const bf16x8*)(P.qn + (tok0 + nq * 16 + l15) * 512 + h * 64 + ks * 32 + q4 * 8);

  f32x4 S[4][NQ], O[4][NQ];
  float m[NQ], l[NQ];
  const bf16_t* kcb = P.kc + (size_t)(b * 2 + kvh) * 128 * 64;
  const bf16_t* vcb = P.vcT + (size_t)(b * 2 + kvh) * 64 * 128;
  const int njb = (c32 + 1 + 63) >> 6;
  attn_reset(m, l, O);

  uint4 rk0, rk1, rv0, rv1;
  KV_ISSUE(kcb, vcb, 128);
  for (int jb = 0; jb < njb; ++jb) {
    __syncthreads();
    KV_STORE();
    __syncthreads();
    { const int jn = (jb + 1 < njb) ? jb + 1 : 0; KV_ISSUE(kcb + (size_t)jn * 64 * 64, vcb + jn * 64, 128); }
    __builtin_amdgcn_sched_barrier(0);
    attn_scores(KT, kfr0, qf, S);
    attn_mask(S, 3, 3, hb, posbase, jb * 64, l15, q4);
    attn_softmax_step(S, m, l, O, false);
  }
  float invl[NQ];
#pragma unroll
  for (int nq = 0; nq < NQ; ++nq) { float lt = l[nq]; lt += __shfl_xor(lt, 16); lt += __shfl_xor(lt, 32); invl[nq] = 1.0f / fmaxf(lt, 1e-30f); }
  for (int jb = 0; jb < njb; ++jb) {
    __syncthreads();
    KV_STORE();
    __syncthreads();
    { const int jn = (jb + 1 < njb) ? jb + 1 : jb; KV_ISSUE(kcb + (size_t)jn * 64 * 64, vcb + jn * 64, 128); }
    __builtin_amdgcn_sched_barrier(0);
    attn_scores(KT, kfr0, qf, S);
    attn_mask(S, 3, 3, hb, posbase, jb * 64, l15, q4);
#pragma unroll
    for (int nq = 0; nq < NQ; ++nq)
#pragma unroll
      for (int mk = 0; mk < 4; ++mk)
#pragma unroll
        for (int r = 0; r < 4; ++r) S[mk][nq][r] = __builtin_amdgcn_exp2f(S[mk][nq][r] - fmaxf(m[nq], -1e28f)) * invl[nq];
    for (int gg = 0; gg < 4; ++gg) {
      if (g == gg) {
#pragma unroll
        for (int nq = 0; nq < NQ; ++nq)
#pragma unroll
          for (int mk = 0; mk < 4; ++mk) {
            float* ip = IMP + (nq * 16 + l15) * 65 + jb * 32 + mk * 8 + q4 * 2;
            const float v0 = S[mk][nq][0] + S[mk][nq][1], v1 = S[mk][nq][2] + S[mk][nq][3];
            if (gg == 0) { ip[0] = v0; ip[1] = v1; } else { ip[0] += v0; ip[1] += v1; }
          }
      }
      __syncthreads();
    }
    attn_pv(VT, vfr0, S, O);
  }
  uint2 oreg[4][NQ];
#pragma unroll
  for (int nq = 0; nq < NQ; ++nq) {
    const float g0 = sigmoidf_(bf2f(P.z[(tok0 + nq * 16 + l15) * ZLD + ZC_NG + h * 3 + 0]));
#pragma unroll
    for (int md = 0; md < 4; ++md) {
      oreg[md][nq].x = pack2(O[md][nq][0] * g0, O[md][nq][1] * g0); oreg[md][nq].y = pack2(O[md][nq][2] * g0, O[md][nq][3] * g0);
    }
  }
  __syncthreads();
  for (int i = 0; i < 8; ++i) {
    const int rr = g * 8 + i;
    const float v = IMP[rr * 65 + lane];
    const bool visible = lane <= c;
    const bool forced = (lane == 0) || (lane == c) || (lane == c - 1);
    const float val = forced ? 1e4f : (visible ? v : -INFINITY);
    int rank = 0;
#pragma unroll
    for (int j = 0; j < 64; ++j) {
      const float vj = __int_as_float(__builtin_amdgcn_readlane(__float_as_int(val), j));
      rank += ((vj > val) || (vj == val && j < lane)) ? 1 : 0;
    }
    const bool sel = (rank < 16) && visible;
    const unsigned long long mk = __ballot(sel);
    if (lane == 0) { MASK[rr * 2] = (uint32_t)mk; MASK[rr * 2 + 1] = (uint32_t)(mk >> 32); }
  }
  __syncthreads();
  uint32_t ulo = MASK[(lane & 31) * 2], uhi = MASK[(lane & 31) * 2 + 1];
#pragma unroll
  for (int o = 16; o >= 1; o >>= 1) { ulo |= __shfl_xor(ulo, o); uhi |= __shfl_xor(uhi, o); }
  ulo = __builtin_amdgcn_readfirstlane(ulo); uhi = __builtin_amdgcn_readfirstlane(uhi);
  unsigned long long rem = ((unsigned long long)uhi << 32) | ulo;
  unsigned long long mrow[NQ];
#pragma unroll
  for (int nq = 0; nq < NQ; ++nq) mrow[nq] = ((unsigned long long)MASK[(nq * 16 + l15) * 2 + 1] << 32) | MASK[(nq * 16 + l15) * 2];

  attn_reset(m, l, O);
  {
    const bf16_t* kb = P.ksn + (size_t)(b * 2 + kvh) * SEQL * 64;
    const bf16_t* vb = P.vsT + (size_t)(b * 2 + kvh) * 64 * LDV;
    int j = __builtin_ctzll(rem);
    rem &= rem - 1;
    KV_ISSUE(kb + (size_t)j * 64 * 64, vb + j * 64, LDV);
    __syncthreads();
    KV_STORE();
    bool last = (rem == 0);
    int jn = last ? j : __builtin_ctzll(rem);
    rem &= rem - 1;
    KV_ISSUE(kb + (size_t)jn * 64 * 64, vb + jn * 64, LDV);
    __syncthreads();
    int pb = 0;
    for (;;) {
      const char* KTc = smem + pb * 32768; const char* VTc = KTc + 8192;
      __builtin_amdgcn_sched_barrier(0);
      attn_scores(KTc, kfr0, qf, S);
      int selbits = 0;
#pragma unroll
      for (int nq = 0; nq < NQ; ++nq) selbits |= (int)((mrow[nq] >> j) & 1ull) << nq;
      if (j == c) attn_mask(S, 1, selbits, hb, posbase, 0, l15, q4); else attn_mask(S, 0, selbits, hb, posbase, 0, l15, q4);
      attn_softmax_step(S, m, l, O, true);
      attn_pv(VTc, vfr0, S, O);
      if (last) break;
      { char* KT = smem + (pb ^ 1) * 32768; char* VT = KT + 8192; KV_STORE(); }
      j = jn; last = (rem == 0); jn = last ? j : __builtin_ctzll(rem); rem &= rem - 1;
      KV_ISSUE(kb + (size_t)jn * 64 * 64, vb + jn * 64, LDV);
      __syncthreads();
      pb ^= 1;
    }
  }
#pragma unroll
  for (int nq = 0; nq < NQ; ++nq) {
    float lt = l[nq]; lt += __shfl_xor(lt, 16); lt += __shfl_xor(lt, 32);
    const float sc = sigmoidf_(bf2f(P.z[(tok0 + nq * 16 + l15) * ZLD + ZC_NG + h * 3 + 1])) / fmaxf(lt, 1e-30f);
#pragma unroll
    for (int md = 0; md < 4; ++md) {
      const uint2 ov = oreg[md][nq];
      oreg[md][nq].x = pack2(lo2f(ov.x) + O[md][nq][0] * sc, hi2f(ov.x) + O[md][nq][1] * sc);
      oreg[md][nq].y = pack2(lo2f(ov.y) + O[md][nq][2] * sc, hi2f(ov.y) + O[md][nq][3] * sc);
    }
  }
  attn_reset(m, l, O);
  {
    const bf16_t* kb = P.kwn + (size_t)(b * 2 + kvh) * SEQL * 64;
    const bf16_t* vb = P.vwT + (size_t)(b * 2 + kvh) * 64 * LDV;
    const int j0 = (c - 8 > 0) ? (c - 8) : 0;
    int j = j0;
    KV_ISSUE(kb + (size_t)j * 64 * 64, vb + j * 64, LDV);
    __syncthreads();
    KV_STORE();
    int jn = (j < c) ? j + 1 : j;
    KV_ISSUE(kb + (size_t)jn * 64 * 64, vb + jn * 64, LDV);
    __syncthreads();
    int pb = 0;
    for (;;) {
      const char* KTc = smem + pb * 32768; const char* VTc = KTc + 8192;
      __builtin_amdgcn_sched_barrier(0);
      attn_scores(KTc, kfr0, qf, S);
      if (j == c) attn_mask(S, 1, 3, hb, posbase, 0, l15, q4);
      else if (j == c - 8) attn_mask(S, 2, 3, hb, posbase, 0, l15, q4);
      attn_softmax_step(S, m, l, O, true);
      attn_pv(VTc, vfr0, S, O);
      if (j == c) break;
      { char* KT = smem + (pb ^ 1) * 32768; char* VT = KT + 8192; KV_STORE(); }
      j = jn; jn = (j < c) ? j + 1 : j;
      KV_ISSUE(kb + (size_t)jn * 64 * 64, vb + jn * 64, LDV);
      __syncthreads();
      pb ^= 1;
    }
  }
#pragma unroll
  for (int nq = 0; nq < NQ; ++nq) {
    float lt = l[nq]; lt += __shfl_xor(lt, 16); lt += __shfl_xor(lt, 32);
    const float sc = sigmoidf_(bf2f(P.z[(tok0 + nq * 16 + l15) * ZLD + ZC_NG + h * 3 + 2])) / fmaxf(lt, 1e-30f);
#pragma unroll
    for (int md = 0; md < 4; ++md) {
      const uint2 ov = oreg[md][nq];
      uint2 w; w.x = pack2(lo2f(ov.x) + O[md][nq][0] * sc, hi2f(ov.x) + O[md][nq][1] * sc); w.y = pack2(lo2f(ov.y) + O[md][nq][2] * sc, hi2f(ov.y) + O[md][nq][3] * sc);
      *(uint2*)(P.ob + (tok0 + nq * 16 + l15) * LD5 + h * 64 + md * 16 + q4 * 4) = w;
    }
  }
}
__device__ void phase_attn_s5(const Params& P, int layer, char* smem, int pass) {
  if (BIDX < 128) { s5_unit(P, layer, BIDX, smem); }
  unsigned* ctr = P.bar + 3600 + (layer * 2 + pass) * 56;
  volatile int* slot = (volatile int*)(smem + 65024);
  for (;;) {
    __syncthreads();
    if (threadIdx.x == 0) *slot = (int)atomicAdd(ctr, 1u);
    __syncthreads();
    const int u = __builtin_amdgcn_readfirstlane(*slot);
    if (u >= 1024) break;
    attn_unit(P, u, smem);
  }
}

#define NPHASE 11
__device__ __forceinline__ void run_phase(const Params& P, int layer, int ph, char* smem, float alpha = 1.0f) {
  switch (ph) {
    case 0: phase_convert(P, layer, smem); phase_cmp_bias(P, layer);
            phase_rmsnorm(layer == 0 ? P.in[0] : P.x, layer == 0 ? P.x : nullptr, P.in[1] + (size_t)layer * DM, P.hbuf); break;
    case 1: phase_gemm_in(P, smem); break;
    case 2: phase_prep(P, layer, smem); break;
    case 3: break;
    case 4: phase_cmp2(P, layer, smem); break;
    case 5: phase_attn_s5(P, layer, smem, alpha == 0.0f ? 1 : 0); break;
    case 6: phase_merge(P, smem); break;
    case 7: phase_gemm_resid(P, P.hbuf, LDH, P.Wt_out, DM, smem, alpha); break;
    case 8: phase_rmsnorm(P.x, nullptr, P.in[21] + (size_t)layer * DM, P.hbuf); break;
    case 9: phase_gemm_gateup(P, smem); break;
    case 10: phase_gemm_resid(P, P.z, LDA, P.Wt_down, DFF, smem, alpha); break;
  }
}

#ifndef REPEAT_MASK
#define REPEAT_MASK 0
#endif
#if !MEGA
__global__ void __launch_bounds__(256, 2) k_phase(Params P, int layer, int ph) {
  __shared__ __attribute__((aligned(16))) char smem[65536];
  run_phase(P, layer, ph, smem);
}
#else
#define XB_TMO      128
#define XB_XCNT(j)  (256  + 64 * (j))
#define XB_XSUB(j)  (1280 + 64 * (j))
#define XB_XGEN(j)  (2304 + 64 * (j))
#define XB_TOP      3328
#define XB_TOPGEN   3392
#define XCD_BAR_WORDS 3456
#define XB_SPIN_CAP (1u << 22)
__device__ __forceinline__ unsigned xb_ld(unsigned* p)              { return __hip_atomic_load(p, __ATOMIC_RELAXED, __HIP_MEMORY_SCOPE_AGENT); }
__device__ __forceinline__ unsigned xb_add(unsigned* p, unsigned v) { return __hip_atomic_fetch_add(p, v, __ATOMIC_RELAXED, __HIP_MEMORY_SCOPE_AGENT); }
__device__ __forceinline__ unsigned xb_xcc_id() { return (unsigned)__builtin_amdgcn_s_getreg((3 << 11) | 20) & 0xFu; }
#define XB_SPIN(cond, bar) do { unsigned _sp = 0; while (cond) { __builtin_amdgcn_s_sleep(1); \
    if ((++_sp & 255u) == 0u) { if (xb_ld(&(bar)[XB_TMO])) break; if (_sp > XB_SPIN_CAP) { atomicAdd(&(bar)[XB_TMO], 1u); break; } } } } while (0)
struct XcdBarrier { unsigned* bar; unsigned x, nloc, nx; };
__device__ __forceinline__ void xcd_barrier_complete(unsigned* bar, unsigned x, unsigned& nloc, unsigned& nx) {
  const unsigned G = gridDim.x;
  unsigned sum, cnt, mine, sp = 0u;
  for (;;) {
    sum = 0u; cnt = 0u; mine = 0u;
#pragma unroll
    for (unsigned j = 0; j < 16; ++j) { const unsigned c = xb_ld(&bar[XB_XCNT(j)]); sum += c; cnt += (c > 0u) ? 1u : 0u; mine = (j == x) ? c : mine; }
    if (sum == G) break;
    __builtin_amdgcn_s_sleep(1);
    if ((++sp & 255u) == 0u) { if (xb_ld(&bar[XB_TMO])) break; if (sp > XB_SPIN_CAP) { atomicAdd(&bar[XB_TMO], 1u); break; } }
  }
  nloc = mine > 0u ? mine : 1u; nx = cnt > 0u ? cnt : 1u;
}
__device__ __forceinline__ void xcd_barrier(const XcdBarrier& b) {
  asm volatile("s_waitcnt vmcnt(0)" ::: "memory");
  __syncthreads();
  if (threadIdx.x == 0) {
    unsigned* bar = b.bar;
    __builtin_amdgcn_s_waitcnt(0);
    const unsigned nloc = b.nloc, nx = b.nx;
    const unsigned old = xb_add(&bar[XB_XSUB(b.x)], 1u);
    const unsigned gen = old / nloc;
    if (old + 1u == (gen + 1u) * nloc) {
      __builtin_amdgcn_fence(__ATOMIC_RELEASE, "agent");
      asm volatile("s_waitcnt vmcnt(0)" ::: "memory");
      const unsigned og = xb_add(&bar[XB_TOP], 1u);
      const unsigned tg = og / nx;
      if (og + 1u == (tg + 1u) * nx) xb_add(&bar[XB_TOPGEN], 1u);
      else XB_SPIN(xb_ld(&bar[XB_TOPGEN]) == tg, bar);
      __builtin_amdgcn_fence(__ATOMIC_ACQUIRE, "agent");
      xb_add(&bar[XB_XGEN(b.x)], 1u);
      asm volatile("s_waitcnt vmcnt(0)" ::: "memory");
    } else {
      XB_SPIN(xb_ld(&bar[XB_XGEN(b.x)]) == gen, bar);
      __builtin_amdgcn_fence(__ATOMIC_ACQUIRE, "agent");
      asm volatile("s_waitcnt vmcnt(0)" ::: "memory");
    }
  }
  __syncthreads();
}

__global__ void __launch_bounds__(256, 2) k_mega(Params P) {
  __shared__ __attribute__((aligned(16))) char smem[65536];
  if (P.x == nullptr) { cg::this_grid().sync(); }
  XcdBarrier xb; xb.bar = P.bar; xb.x = xb_xcc_id(); xb.nloc = 1u; xb.nx = 1u;
  if (threadIdx.x == 0) { (void)xb_add(&P.bar[XB_XCNT(xb.x)], 1u); xcd_barrier_complete(P.bar, xb.x, xb.nloc, xb.nx); }
  for (int layer = 0; layer < DEPTH; ++layer) {
    for (int ph = 0; ph < NPHASE; ++ph) {
      if (ph == 3) continue;
      run_phase(P, layer, ph, smem);
      if ((REPEAT_MASK >> ph) & 1) { xcd_barrier(xb); run_phase(P, layer, ph, smem, 0.0f); }
      if (!(layer == DEPTH - 1 && ph == NPHASE - 1)) xcd_barrier(xb);
    }
  }
}
#endif

extern "C" void kernel_launch(void* const* d_in, const int* in_sizes, int n_in, void* d_out, int out_size, void* d_ws, size_t ws_size, hipStream_t stream) {
  Params P;
  memset(&P, 0, sizeof(P));
  for (int i = 0; i < 24; ++i) P.in[i] = (const float*)d_in[i];
  P.x = (float*)d_out;
  char* w = (char*)d_ws;
  size_t off = 0;
  auto take = [&](size_t bytes) { char* p = w + off; off += (bytes + 255) & ~(size_t)255; return (bf16_t*)p; };
  P.Wt_in = take((size_t)ZLD * LDH * 2);
  P.Wt_glu = take((size_t)2048 * LD5 * 2);
  P.Wt_conv = take((size_t)1024 * LD5 * 2);
  P.Wt_o = take((size_t)1024 * LD5 * 2);
  P.Wt_out = take((size_t)1024 * LDH * 2);
  P.Wt_gu = take((size_t)5632 * LDH * 2);
  P.Wt_down = take((size_t)1024 * LDA * 2);
  P.Wt_c1 = take((size_t)512 * LDC * 2);
  P.z = take((size_t)T_TOK * ZLD * 2);
  P.hbuf = take((size_t)T_TOK * LDH * 2);
  P.ys = take((size_t)T_TOK * LD5 * 2);
  P.cv = take((size_t)T_TOK * LD5 * 2);
  P.ob = take((size_t)T_TOK * LD5 * 2);
  P.qn = take((size_t)T_TOK * 512 * 2);
  P.ksn = take((size_t)T_TOK * 128 * 2);
  P.kwn = take((size_t)T_TOK * 128 * 2);
  P.vsT = take((size_t)8 * 64 * LDV * 2);
  P.vwT = take((size_t)8 * 64 * LDV * 2);
  P.acmp = take((size_t)2 * 1024 * LDC * 2);
  P.hid = take((size_t)2 * 1024 * 256 * 2);
  P.kc = take((size_t)8 * 128 * 64 * 2);
  P.vcT = take((size_t)8 * 64 * 128 * 2);
  P.bar = (unsigned*)take((size_t)4096 * 4);
  P.cbias = (float*)take((size_t)512 * 4);
  if (off > ws_size) { fprintf(stderr, "kernel_launch: workspace too small: need %zu have %zu\n", off, ws_size); return; }
#if MEGA
  static int grid_blocks = 0;
  if (!grid_blocks) {
    int dev = 0, cus = 0, per_cu = 0;
    hipGetDevice(&dev);
    hipDeviceGetAttribute(&cus, hipDeviceAttributeMultiprocessorCount, dev);
    hipOccupancyMaxActiveBlocksPerMultiprocessor(&per_cu, k_mega, 256, 0);
    (void)per_cu;
    grid_blocks = cus * 2;
  }
  hipMemsetAsync(P.bar, 0, 4096 * 4, stream);
  void* args[] = {&P};
  hipError_t e = hipLaunchCooperativeKernel((void*)k_mega, dim3(grid_blocks), dim3(256), args, 0, stream);
  if (e != hipSuccess) fprintf(stderr, "cooperative launch failed: %s (grid %d)\n", hipGetErrorString(e), grid_blocks);
#else
  for (int layer = 0; layer < DEPTH; ++layer)
    for (int ph = 0; ph < NPHASE; ++ph) {
      hipLaunchKernelGGL(k_phase, dim3(512), dim3(256), 0, stream, P, layer, ph);
      if ((REPEAT_MASK >> ph) & 1) hipLaunchKernelGGL(k_phase, dim3(512), dim3(256), 0, stream, P, layer, ph);
    }
#endif
}
```

```cpp
#include <hip/hip_runtime.h>
#include <hip/hip_cooperative_groups.h>
#include <stdint.h>
#include <cstdio>
#include <cstring>
namespace cg = cooperative_groups;

#ifndef MEGA
#define MEGA 1
#endif

typedef unsigned short bf16_t;
typedef short bf16x8 __attribute__((ext_vector_type(8)));
typedef float f32x4 __attribute__((ext_vector_type(4)));

#define T_TOK 16384
#define SEQL 4096
#define DM 1024
#define ZLD 6528
#define NIN 6424
#define DFF 2816
#define DEPTH 4
#define LDH 1088
#define LD5 576
#define LDA 2880
#define LDC 2112
#define LDV 4160
#define LDS_F 544
#define ZC_U 0
#define ZC_CB 512
#define ZC_CC 1024
#define ZC_CX 1536
#define ZC_Q 2048
#define ZC_KC 2560
#define ZC_VC 2688
#define ZC_KS 2816
#define ZC_VS 2944
#define ZC_KW 3072
#define ZC_VW 3200
#define ZC_MIX 3328
#define ZC_NG 6400
#define RMS_EPS 1e-6f

struct Params {
  const float* in[24];
  float* x;
  bf16_t *Wt_in, *Wt_glu, *Wt_conv, *Wt_o, *Wt_out, *Wt_gu, *Wt_down, *Wt_c1;
  bf16_t *z, *hbuf, *ys, *cv, *ob, *qn, *ksn, *kwn, *vsT, *vwT, *acmp, *hid, *kc, *vcT;
  unsigned* bar;
  float* cbias;
};

__device__ __forceinline__ int tidx_() { int t = threadIdx.x; asm volatile("" : "+v"(t)); return t; }
__device__ __forceinline__ int bidx_() { int t = blockIdx.x; asm volatile("" : "+s"(t)); return t; }
#define TIDX tidx_()
#define BIDX bidx_()
__device__ __forceinline__ float bf2f(bf16_t b) { return __uint_as_float(((uint32_t)b) << 16); }
__device__ __forceinline__ uint32_t pack2(float lo, float hi) {
  uint32_t r; asm("v_cvt_pk_bf16_f32 %0, %1, %2" : "=v"(r) : "v"(lo), "v"(hi)); return r;
}
__device__ __forceinline__ float lo2f(uint32_t w) { return __uint_as_float(w << 16); }
__device__ __forceinline__ float hi2f(uint32_t w) { return __uint_as_float(w & 0xffff0000u); }
__device__ __forceinline__ float sigmoidf_(float x) { return __builtin_amdgcn_rcpf(1.0f + __expf(-x)); }
__device__ __forceinline__ float gelu_tanh(float x) { return x * sigmoidf_(1.5957691216f * (x + 0.044715f * x * x * x)); }
__device__ __forceinline__ int lds_off(int row, int ch) { return row * 128 + ((ch ^ ((row >> 1) & 7)) << 4); }

__device__ void conv_job(const float* __restrict__ src, int K, int Nsrc, int col0, int ncols, bf16_t* __restrict__ dst, int drow0, float* lt, int b0, int bs, int mode = 0) {
  const int tid = TIDX;
  const int kt = K >> 6, nt = (ncols + 63) >> 6;
  for (int tile = b0; tile < kt * nt; tile += bs) {
    const int tk = tile % kt, tn = tile / kt;
    const int nl = tid & 63, kl = tid >> 6;
    const int n = tn * 64 + nl;
#pragma unroll
    for (int i = 0; i < 16; ++i) {
      const int k = kl + 4 * i;
      int sc = col0 + n;
      if (mode == 1) { const int t = n >> 7, r = n & 127, wc = r >> 6, nn = (r & 63) >> 4, ii = r & 15; sc = ((nn < 2) ? 0 : DFF) + t * 64 + wc * 32 + (nn & 1) * 16 + ii; }
      float v = (n < ncols) ? src[(size_t)(tk * 64 + k) * Nsrc + sc] : 0.f;
      lt[nl * 65 + k] = v;
    }
    __syncthreads();
    const int k8 = (tid & 7) * 8, n2 = tid >> 3;
#pragma unroll
    for (int i = 0; i < 2; ++i) {
      const int nn = n2 + 32 * i;
      if (tn * 64 + nn < ncols) {
        const float* r = lt + nn * 65 + k8;
        uint4 w;
        w.x = pack2(r[0], r[1]); w.y = pack2(r[2], r[3]); w.z = pack2(r[4], r[5]); w.w = pack2(r[6], r[7]);
        *(uint4*)(dst + (size_t)(drow0 + tn * 64 + nn) * (K + 64) + tk * 64 + k8) = w;
      }
    }
    __syncthreads();
  }
}

__device__ void phase_convert(const Params& P, int layer, char* smem) {
  float* lt = (float*)smem;
  const int b0 = BIDX, bs = gridDim.x;
  const float* w_in = P.in[2] + (size_t)layer * DM * NIN;
  conv_job(w_in, DM, NIN, 0, 3328, P.Wt_in, 0, lt, b0, bs);
  conv_job(w_in, DM, NIN, 3352, 3072, P.Wt_in, ZC_MIX, lt, b0, bs);
  conv_job(w_in, DM, NIN, 3328, 24, P.Wt_in, ZC_NG, lt, b0, bs);
  conv_job(P.in[17] + (size_t)(layer * 2 + 0) * 2048 * 256, 2048, 256, 0, 256, P.Wt_c1, 0, lt, b0, bs);
  conv_job(P.in[17] + (size_t)(layer * 2 + 1) * 2048 * 256, 2048, 256, 0, 256, P.Wt_c1, 256, lt, b0, bs);
}
__device__ void phase_convert_late(const Params& P, int layer, char* smem, int b0, int bs) {
  float* lt = (float*)smem;
  conv_job(P.in[11] + (size_t)layer * 512 * 2048, 512, 2048, 0, 2048, P.Wt_glu, 0, lt, b0, bs);
  conv_job(P.in[13] + (size_t)layer * 512 * 1024, 512, 1024, 0, 1024, P.Wt_conv, 0, lt, b0, bs);
  conv_job(P.in[19] + (size_t)layer * 512 * 1024, 512, 1024, 0, 1024, P.Wt_o, 0, lt, b0, bs);
  conv_job(P.in[20] + (size_t)layer * 1024 * 1024, 1024, 1024, 0, 1024, P.Wt_out, 0, lt, b0, bs);
  conv_job(P.in[22] + (size_t)layer * 1024 * 5632, 1024, 5632, 0, 5632, P.Wt_gu, 0, lt, b0, bs, 1);
  conv_job(P.in[23] + (size_t)layer * DFF * 1024, DFF, 1024, 0, 1024, P.Wt_down, 0, lt, b0, bs);
}

__device__ void phase_rmsnorm(const float* __restrict__ xin, float* __restrict__ xcopy, const float* __restrict__ g, bf16_t* __restrict__ out) {
  const int lane = TIDX & 63, wave = TIDX >> 6;
#pragma unroll 2
  for (int tok = BIDX * 4 + wave; tok < T_TOK; tok += gridDim.x * 4) {
    const float4* xr = (const float4*)(xin + (size_t)tok * DM);
    float4 v[4];
    float ss = 0.f;
#pragma unroll
    for (int i = 0; i < 4; ++i) { v[i] = xr[lane + 64 * i]; ss += v[i].x * v[i].x + v[i].y * v[i].y + v[i].z * v[i].z + v[i].w * v[i].w; }
#pragma unroll
    for (int o = 32; o >= 1; o >>= 1) ss += __shfl_xor(ss, o);
    const float r = rsqrtf(ss * (1.0f / DM) + RMS_EPS);
    if (xcopy) {
      float4* xc = (float4*)(xcopy + (size_t)tok * DM);
#pragma unroll
      for (int i = 0; i < 4; ++i) xc[lane + 64 * i] = v[i];
    }
#pragma unroll
    for (int i = 0; i < 4; ++i) {
      const float4 gg = ((const float4*)g)[lane + 64 * i];
      uint2 w; w.x = pack2(v[i].x * r * gg.x, v[i].y * r * gg.y); w.y = pack2(v[i].z * r * gg.z, v[i].w * r * gg.w);
      *(uint2*)(out + (size_t)tok * LDH + (lane + 64 * i) * 4) = w;
    }
  }
}

template <bool A_GATHER = false>
__device__ __forceinline__ void gemm_main(const bf16_t* __restrict__ A, size_t lda, const bf16_t* __restrict__ Bt, int ldb, int K, f32x4 (&acc)[4][4], char* smem, size_t kstepA = 64) {
  const int tid = TIDX, lane = tid & 63, wave = tid >> 6, wr = wave >> 1, wc = wave & 1, l15 = lane & 15, q4 = lane >> 4;
  const int lrow = tid >> 3, lch = tid & 7;
  const bf16_t* ap = A_GATHER ? A : A + (size_t)lrow * lda + lch * 8;
  const bf16_t* bp = Bt + (size_t)lrow * ldb + lch * 8;
  const size_t sa = A_GATHER ? lda : (size_t)32 * lda, sb = (size_t)32 * ldb;
  typedef unsigned u32x4 __attribute__((ext_vector_type(4)));
  u32x4 ra0, ra1, ra2, ra3, rb0, rb1, rb2, rb3;
  u32x4 rc0, rc1, rc2, rc3, rd0, rd1, rd2, rd3;
  int nk = K >> 6;
  asm volatile("" : "+s"(nk));
  const int st_off = lds_off(lrow, lch);
  const int sw = (l15 >> 1) & 7;
  const int fr0 = l15 * 128 + (((q4 ^ (sw & 3)) << 4) | ((sw >> 2) << 6));
  const int a_off = wr * 8192 + fr0, b_off = 16384 + wc * 8192 + fr0;
#ifndef EXP_GL
#define EXP_GL 0
#endif
#ifndef EXP_LDSW
#define EXP_LDSW 0
#endif
#if EXP_GL
#define GLQ const volatile u32x4*
#define GLREP 2
#else
#define GLQ const u32x4*
#define GLREP 1
#endif
#if EXP_LDSW == 1
#define LSQ volatile u32x4*
#define LSREP 2
#else
#define LSQ u32x4*
#define LSREP 1
#endif
#define GLOAD0(AP, BP) do { for (int rep_ = 0; rep_ < GLREP; ++rep_) { ra0 = *(GLQ)(AP); ra1 = *(GLQ)((AP) + sa); ra2 = *(GLQ)((AP) + 2 * sa); ra3 = *(GLQ)((AP) + 3 * sa); \
                            rb0 = *(GLQ)(BP); rb1 = *(GLQ)((BP) + sb); rb2 = *(GLQ)((BP) + 2 * sb); rb3 = *(GLQ)((BP) + 3 * sb); } } while (0)
#define GLOAD1(AP, BP) do { for (int rep_ = 0; rep_ < GLREP; ++rep_) { rc0 = *(GLQ)(AP); rc1 = *(GLQ)((AP) + sa); rc2 = *(GLQ)((AP) + 2 * sa); rc3 = *(GLQ)((AP) + 3 * sa); \
                            rd0 = *(GLQ)(BP); rd1 = *(GLQ)((BP) + sb); rd2 = *(GLQ)((BP) + 2 * sb); rd3 = *(GLQ)((BP) + 3 * sb); } } while (0)
#define XW(P_, V_) asm volatile("ds_write_b128 %0, %1" :: "v"((unsigned)(size_t)(P_)), "v"(V_) : "memory")
#if EXP_LDSW == 2
#define XDUP0(PS) do { XW((PS), ra0); XW((PS) + 4096, ra1); XW((PS) + 8192, ra2); XW((PS) + 12288, ra3); XW((PS) + 16384, rb0); XW((PS) + 20480, rb1); XW((PS) + 24576, rb2); XW((PS) + 28672, rb3); } while (0)
#define XDUP1(PS) do { XW((PS), rc0); XW((PS) + 4096, rc1); XW((PS) + 8192, rc2); XW((PS) + 12288, rc3); XW((PS) + 16384, rd0); XW((PS) + 20480, rd1); XW((PS) + 24576, rd2); XW((PS) + 28672, rd3); } while (0)
#else
#define XDUP0(PS) do { } while (0)
#define XDUP1(PS) do { } while (0)
#endif
#define LSTORE0(PS) do { XDUP0(PS); for (int rep_ = 0; rep_ < LSREP; ++rep_) { *(LSQ)(PS) = ra0; *(LSQ)((PS) + 4096) = ra1; *(LSQ)((PS) + 8192) = ra2; *(LSQ)((PS) + 12288) = ra3; \
                         *(LSQ)((PS) + 16384) = rb0; *(LSQ)((PS) + 20480) = rb1; *(LSQ)((PS) + 24576) = rb2; *(LSQ)((PS) + 28672) = rb3; } } while (0)
#define LSTORE1(PS) do { XDUP1(PS); for (int rep_ = 0; rep_ < LSREP; ++rep_) { *(LSQ)(PS) = rc0; *(LSQ)((PS) + 4096) = rc1; *(LSQ)((PS) + 8192) = rc2; *(LSQ)((PS) + 12288) = rc3; \
                         *(LSQ)((PS) + 16384) = rd0; *(LSQ)((PS) + 20480) = rd1; *(LSQ)((PS) + 24576) = rd2; *(LSQ)((PS) + 28672) = rd3; } } while (0)
#define COMPUTE(BO) do { _Pragma("unroll") for (int ks = 0; ks < 2; ++ks) { \
      bf16x8 af[4], bfr[4]; \
      const char* pa = smem + (BO) + (a_off ^ (ks * 64)); \
      const char* pb = smem + (BO) + (b_off ^ (ks * 64)); \
      _Pragma("unroll") for (int m = 0; m < 4; ++m) af[m] = *(const bf16x8*)(pa + m * 2048); \
      _Pragma("unroll") for (int n = 0; n < 4; ++n) bfr[n] = *(const bf16x8*)(pb + n * 2048); \
      _Pragma("unroll") for (int m = 0; m < 4; ++m) \
        _Pragma("unroll") for (int n = 0; n < 4; ++n) acc[m][n] = __builtin_amdgcn_mfma_f32_16x16x32_bf16(bfr[n], af[m], acc[m][n], 0, 0, 0); } } while (0)
  GLOAD0(ap, bp);
  GLOAD1(ap + kstepA, bp + 64);
  LSTORE0(smem + st_off);
  __syncthreads();
#pragma nounroll
  for (int kt = 0; kt < nk; kt += 2) {
    { const int t2 = (kt + 2 < nk) ? kt + 2 : nk - 1; const bf16_t* ap2 = ap + t2 * kstepA; const bf16_t* bp2 = bp + t2 * 64; GLOAD0(ap2, bp2); }
    __builtin_amdgcn_sched_barrier(0);
    COMPUTE(0);
    LSTORE1(smem + 32768 + st_off);
    __syncthreads();
    { const int t3 = (kt + 3 < nk) ? kt + 3 : nk - 1; const bf16_t* ap2 = ap + t3 * kstepA; const bf16_t* bp2 = bp + t3 * 64; GLOAD1(ap2, bp2); }
    __builtin_amdgcn_sched_barrier(0);
    COMPUTE(32768);
    LSTORE0(smem + st_off);
    __syncthreads();
  }
#undef GLOAD0
#undef GLOAD1
#undef LSTORE0
#undef LSTORE1
#undef COMPUTE
#undef GLQ
#undef LSQ
#undef GLREP
#undef LSREP
}

__device__ __forceinline__ void gemm_main_shallow(const bf16_t* __restrict__ A, int lda, const bf16_t* __restrict__ Bt, int ldb, int K, f32x4 (&acc)[4][4], char* smem) {
  const int tid = TIDX, lane = tid & 63, wave = tid >> 6, wr = wave >> 1, wc = wave & 1, l15 = lane & 15, q4 = lane >> 4;
  const int lrow = tid >> 3, lch = tid & 7;
  const bf16_t* ap = A + (size_t)lrow * lda + lch * 8;
  const bf16_t* bp = Bt + (size_t)lrow * ldb + lch * 8;
  const size_t sa = (size_t)32 * lda, sb = (size_t)32 * ldb;
  uint4 ra0, ra1, ra2, ra3, rb0, rb1, rb2, rb3;
  int nk = K >> 6;
  asm volatile("" : "+s"(nk));
  const int st_off = lds_off(lrow, lch);
  const int sw = (l15 >> 1) & 7;
  const int fr0 = l15 * 128 + (((q4 ^ (sw & 3)) << 4) | ((sw >> 2) << 6));
  const int a_off = wr * 8192 + fr0, b_off = 16384 + wc * 8192 + fr0;
#define GLOAD(AP, BP) do { ra0 = *(const uint4*)(AP); ra1 = *(const uint4*)((AP) + sa); ra2 = *(const uint4*)((AP) + 2 * sa); ra3 = *(const uint4*)((AP) + 3 * sa); \
                           rb0 = *(const uint4*)(BP); rb1 = *(const uint4*)((BP) + sb); rb2 = *(const uint4*)((BP) + 2 * sb); rb3 = *(const uint4*)((BP) + 3 * sb); } while (0)
#define LSTORE(PS) do { *(uint4*)(PS) = ra0; *(uint4*)((PS) + 4096) = ra1; *(uint4*)((PS) + 8192) = ra2; *(uint4*)((PS) + 12288) = ra3; \
                        *(uint4*)((PS) + 16384) = rb0; *(uint4*)((PS) + 20480) = rb1; *(uint4*)((PS) + 24576) = rb2; *(uint4*)((PS) + 28672) = rb3; } while (0)
  GLOAD(ap, bp);
  LSTORE(smem + st_off);
  __syncthreads();
#pragma nounroll
  for (int kt = 0; kt < nk; ++kt) {
    const int bo = (kt & 1) * 32768;
    const bool more = kt + 1 < nk;
    if (more) { const bf16_t* ap2 = ap + (kt + 1) * 64; const bf16_t* bp2 = bp + (kt + 1) * 64; GLOAD(ap2, bp2); }
#pragma unroll
    for (int ks = 0; ks < 2; ++ks) {
      bf16x8 af[4], bfr[4];
      const char* pa = smem + bo + (a_off ^ (ks * 64));
      const char* pb = smem + bo + (b_off ^ (ks * 64));
#pragma unroll
      for (int m = 0; m < 4; ++m) af[m] = *(const bf16x8*)(pa + m * 2048);
#pragma unroll
      for (int n = 0; n < 4; ++n) bfr[n] = *(const bf16x8*)(pb + n * 2048);
#pragma unroll
      for (int m = 0; m < 4; ++m)
#pragma unroll
        for (int n = 0; n < 4; ++n) acc[m][n] = __builtin_amdgcn_mfma_f32_16x16x32_bf16(bfr[n], af[m], acc[m][n], 0, 0, 0);
    }
    if (more) { char* ps = smem + (bo ^ 32768) + st_off; LSTORE(ps); }
    __syncthreads();
  }
#undef GLOAD
#undef LSTORE
}

__device__ __forceinline__ void zero_acc(f32x4 (&acc)[4][4]) {
#pragma unroll
  for (int m = 0; m < 4; ++m)
#pragma unroll
    for (int n = 0; n < 4; ++n) acc[m][n] = (f32x4){0.f, 0.f, 0.f, 0.f};
}
__device__ __forceinline__ bool tile_coords(int u, int nN, int& tm, int& tn) {
  const int nfull = nN >> 3, full = nfull * 1024, xcd = u & 7;
  if (u < full) {
    const int loc = u >> 3, sb = loc >> 6, mi = loc & 7, ni = (loc >> 3) & 7;
    tm = xcd * 16 + (sb & 1) * 8 + mi; tn = (sb >> 1) * 8 + ni;
    return true;
  }
  const int loc = (u - full) >> 3;
  tm = xcd * 16 + (loc & 15); tn = nfull * 8 + (loc >> 4);
  return (loc >> 4) < (nN & 7);
}
__device__ __forceinline__ int tile_slots(int nN) { return 1024 * (nN >> 3) + ((nN & 7) ? 512 : 0); }
#define EPI_SETUP const int lane_ = TIDX & 63, wave_ = TIDX >> 6; const int rbase = tm * 128 + (wave_ >> 1) * 64 + (lane_ & 15); const int cbase = tn * 128 + (wave_ & 1) * 64 + (lane_ >> 4) * 4;

__device__ void phase_gemm_in(const Params& P, char* smem) {
  for (int u = BIDX; u < tile_slots(51); u += gridDim.x) {
    int tm, tn; if (!tile_coords(u, 51, tm, tn)) continue;
    f32x4 acc[4][4]; zero_acc(acc);
    gemm_main(P.hbuf + (size_t)tm * 128 * LDH, LDH, P.Wt_in + (size_t)tn * 128 * LDH, LDH, DM, acc, smem);
    EPI_SETUP
    const bool is_gate = (tn >= ZC_MIX / 128) && (tn < ZC_NG / 128);
#pragma unroll
    for (int m = 0; m < 4; ++m)
#pragma unroll
      for (int n = 0; n < 4; ++n) {
        const int row = rbase + m * 16, col = cbase + n * 16;
        f32x4 v = acc[m][n];
        if (is_gate) { v[0] = sigmoidf_(v[0]); v[1] = sigmoidf_(v[1]); v[2] = sigmoidf_(v[2]); v[3] = sigmoidf_(v[3]); }
        uint2 w; w.x = pack2(v[0], v[1]); w.y = pack2(v[2], v[3]);
        *(uint2*)(smem + (row - tm * 128) * 272 + (col - tn * 128) * 2) = w;
      }
    __syncthreads();
    {
      const int tid = TIDX;
#pragma unroll
      for (int i = 0; i < 8; ++i) {
        const int id = tid + 256 * i, r = id >> 4, c16 = id & 15;
        const uint4 v = *(const uint4*)(smem + r * 272 + c16 * 16);
        *(uint4*)(P.z + (size_t)(tm * 128 + r) * ZLD + tn * 128 + c16 * 8) = v;
      }
    }
    __syncthreads();
  }
}
__device__ void phase_gemm_resid(const Params& P, const bf16_t* A, int lda, const bf16_t* Bt, int K, char* smem, float alpha = 1.0f) {
  for (int u = BIDX; u < tile_slots(8); u += gridDim.x) {
    int tm, tn; if (!tile_coords(u, 8, tm, tn)) continue;
    f32x4 acc[4][4]; zero_acc(acc);
    gemm_main(A + (size_t)tm * 128 * lda, lda, Bt + (size_t)tn * 128 * (K + 64), K + 64, K, acc, smem);
    EPI_SETUP
#pragma unroll
    for (int m = 0; m < 4; ++m)
#pragma unroll
      for (int n = 0; n < 4; ++n) {
        const int row = rbase + m * 16, col = cbase + n * 16;
        float4* p = (float4*)(P.x + (size_t)row * DM + col);
        float4 v = *p;
        v.x += alpha * acc[m][n][0]; v.y += alpha * acc[m][n][1]; v.z += alpha * acc[m][n][2]; v.w += alpha * acc[m][n][3];
        *p = v;
      }
  }
}
__device__ void phase_gemm_gateup(const Params& P, char* smem) {
  bf16_t* act = P.z;
  for (int u = BIDX; u < tile_slots(44); u += gridDim.x) {
    int tm, tn; if (!tile_coords(u, 44, tm, tn)) continue;
    f32x4 acc[4][4]; zero_acc(acc);
    gemm_main(P.hbuf + (size_t)tm * 128 * LDH, LDH, P.Wt_gu + (size_t)tn * 128 * LDH, LDH, DM, acc, smem);
    const int lane_ = TIDX & 63, wave_ = TIDX >> 6;
    const int rbase = tm * 128 + (wave_ >> 1) * 64 + (lane_ & 15);
    const int cbase = tn * 64 + (wave_ & 1) * 32 + (lane_ >> 4) * 4;
#pragma unroll
    for (int m = 0; m < 4; ++m)
#pragma unroll
      for (int n = 0; n < 2; ++n) {
        const int row = rbase + m * 16, col = cbase + n * 16;
        float o[4];
#pragma unroll
        for (int r = 0; r < 4; ++r) { const float gq = acc[m][n][r]; o[r] = gq * sigmoidf_(gq) * acc[m][n + 2][r]; }
        uint2 w; w.x = pack2(o[0], o[1]); w.y = pack2(o[2], o[3]);
        *(uint2*)(smem + (row - tm * 128) * 144 + (col - tn * 64) * 2) = w;
      }
    __syncthreads();
    {
      const int tid = TIDX;
#pragma unroll
      for (int i = 0; i < 4; ++i) {
        const int id = tid + 256 * i, r = id >> 3, c8 = id & 7;
        const uint4 v = *(const uint4*)(smem + r * 144 + c8 * 16);
        *(uint4*)(act + (size_t)(tm * 128 + r) * LDA + tn * 64 + c8 * 8) = v;
      }
    }
    __syncthreads();
  }
}
__device__ void phase_gemm_cmp1(const Params& P, char* smem, int u0, int ustride) {
  float* hidp = (float*)P.acmp;
  for (int u = u0; u < 128; u += ustride) {
    const int kq = u & 3, r5 = u >> 2, which = r5 >> 4, rem = r5 & 15, tm = rem & 7, tn = rem >> 3;
    f32x4 acc[4][4]; zero_acc(acc);
    const int tid = TIDX, lrow = tid >> 3, lch = tid & 7;
    const bf16_t* ap = P.z + ((size_t)(tm * 64 + (lrow >> 1)) * 32 + kq * 8) * ZLD + (which ? ZC_VC : ZC_KC) + (lrow & 1) * 64 + lch * 8;
    gemm_main<true>(ap, (size_t)512 * ZLD, P.Wt_c1 + (size_t)which * 256 * LDC + (size_t)tn * 128 * LDC + kq * 512, LDC, 512, acc, smem, (size_t)ZLD);
    EPI_SETUP
#pragma unroll
    for (int m = 0; m < 4; ++m)
#pragma unroll
      for (int n = 0; n < 4; ++n) {
        const int row = rbase + m * 16, col = cbase + n * 16;
        *(f32x4*)(hidp + ((size_t)(kq * 2 + which) * 1024 + row) * 256 + col) = acc[m][n];
      }
  }
}
__device__ void phase_cmp_bias(const Params& P, int layer) {
  const int lane = TIDX & 63, wave = TIDX >> 6;
  for (int o = BIDX * 4 + wave; o < 512; o += gridDim.x * 4) {
    const int which = o >> 8, col = o & 255;
    const float* pe = P.in[16] + (size_t)(layer * 2 + which) * 2048;
    const float* w1 = P.in[17] + (size_t)(layer * 2 + which) * 2048 * 256 + col;
    float acc = 0.f;
    for (int k = lane; k < 2048; k += 64) acc += pe[k] * w1[(size_t)k * 256];
#pragma unroll
    for (int o2 = 32; o2 >= 1; o2 >>= 1) acc += __shfl_xor(acc, o2);
    if (lane == 0) P.cbias[o] = acc;
  }
}
__device__ __forceinline__ void merge_stage_gates(const bf16_t* __restrict__ zg, int tm, int tn, char* smem) {
  const int tid = TIDX;
#pragma unroll
  for (int i = 0; i < 8; ++i) {
    const int id = tid + 256 * i, r = id >> 4, c16 = id & 15;
    *(uint4*)(smem + r * 272 + c16 * 16) = *(const uint4*)(zg + (size_t)(tm * 128 + r) * ZLD + tn * 128 + c16 * 8);
  }
}
__device__ void phase_merge(const Params& P, char* smem) {
  for (int u = BIDX; u < tile_slots(8); u += gridDim.x) {
    int tm, tn; if (!tile_coords(u, 8, tm, tn)) continue;
    const int lane_ = TIDX & 63, wave_ = TIDX >> 6;
    const int loff = ((wave_ >> 1) * 64 + (lane_ & 15)) * 272 + ((wave_ & 1) * 64 + (lane_ >> 4) * 4) * 2;
    uint2 hreg[4][4];
    {
      f32x4 a0[4][4], a1[4][4]; zero_acc(a0); zero_acc(a1);
      gemm_main_shallow(P.ys + (size_t)tm * 128 * LD5, LD5, P.Wt_glu + (size_t)tn * 128 * LD5, LD5, 512, a0, smem);
      gemm_main_shallow(P.ys + (size_t)tm * 128 * LD5, LD5, P.Wt_glu + (size_t)(1024 + tn * 128) * LD5, LD5, 512, a1, smem);
      merge_stage_gates(P.z + ZC_MIX, tm, tn, smem);
      __syncthreads();
#pragma unroll
      for (int m = 0; m < 4; ++m)
#pragma unroll
        for (int n = 0; n < 4; ++n) {
          const uint2 gw = *(const uint2*)(smem + loff + m * 16 * 272 + n * 32);
          hreg[m][n].x = pack2(lo2f(gw.x) * a0[m][n][0] * sigmoidf_(a1[m][n][0]), hi2f(gw.x) * a0[m][n][1] * sigmoidf_(a1[m][n][1]));
          hreg[m][n].y = pack2(lo2f(gw.y) * a0[m][n][2] * sigmoidf_(a1[m][n][2]), hi2f(gw.y) * a0[m][n][3] * sigmoidf_(a1[m][n][3]));
        }
      __syncthreads();
    }
    int nbr = 3;
    asm volatile("" : "+s"(nbr));
    for (int br = 1; br < nbr; ++br) {
      f32x4 a1[4][4]; zero_acc(a1);
      const bf16_t* A = (br == 1) ? P.cv : P.ob;
      const bf16_t* B = (br == 1) ? P.Wt_conv : P.Wt_o;
      gemm_main_shallow(A + (size_t)tm * 128 * LD5, LD5, B + (size_t)tn * 128 * LD5, LD5, 512, a1, smem);
      merge_stage_gates(P.z + ZC_MIX + br * 1024, tm, tn, smem);
      __syncthreads();
#pragma unroll
      for (int m = 0; m < 4; ++m)
#pragma unroll
        for (int n = 0; n < 4; ++n) {
          const uint2 gw = *(const uint2*)(smem + loff + m * 16 * 272 + n * 32);
          const uint2 hv = hreg[m][n];
          hreg[m][n].x = pack2(lo2f(hv.x) + lo2f(gw.x) * a1[m][n][0], hi2f(hv.x) + hi2f(gw.x) * a1[m][n][1]);
          hreg[m][n].y = pack2(lo2f(hv.y) + lo2f(gw.y) * a1[m][n][2], hi2f(hv.y) + hi2f(gw.y) * a1[m][n][3]);
        }
      __syncthreads();
    }
#pragma unroll
    for (int m = 0; m < 4; ++m)
#pragma unroll
      for (int n = 0; n < 4; ++n) *(uint2*)(smem + loff + m * 16 * 272 + n * 32) = hreg[m][n];
    __syncthreads();
    {
      const int tid = TIDX;
#pragma unroll
      for (int i = 0; i < 8; ++i) {
        const int id = tid + 256 * i, r = id >> 4, c16 = id & 15;
        *(uint4*)(P.hbuf + (size_t)(tm * 128 + r) * LDH + tn * 128 + c16 * 8) = *(const uint4*)(smem + r * 272 + c16 * 16);
      }
    }
    __syncthreads();
  }
}

__device__ void s5_unit(const Params& P, int layer, int unit, char* smem) {
  const int b = unit >> 5, g = unit & 31;
  const int tid = TIDX, lane = tid & 63, w = tid >> 6, l15 = lane & 15, q4 = lane >> 4;
  const int p = lane, q = w;
  float* bu = (float*)smem;
  bf16_t* stb = (bf16_t*)(smem + 33280);
  float2* send = (float2*)(smem + 33280 + 17408);
  bf16_t* usb = (bf16_t*)(smem + 33280 + 17408 + 2048);
  const float* lam_re = P.in[3] + (size_t)layer * 32 * 64 + g * 64, *lam_im = P.in[4] + (size_t)layer * 32 * 64 + g * 64;
  const float* b_re = P.in[5] + ((size_t)layer * 32 + g) * 64 * 16, *b_im = P.in[6] + ((size_t)layer * 32 + g) * 64 * 16;
  const float* c_re = P.in[7] + ((size_t)layer * 32 + g) * 16 * 64, *c_im = P.in[8] + ((size_t)layer * 32 + g) * 16 * 64;
  const float dk = P.in[9][(size_t)layer * 512 + g * 16 + l15];
  const float dt = expf(P.in[10][layer * 32 + g]);
  float lbr, lbi, l16r, l16i;
  {
    const float lr = lam_re[p], li = lam_im[p];
    float sn, cs_; sincosf(li * dt, &sn, &cs_);
    const float e = expf(lr * dt);
    lbr = e * cs_; lbi = e * sn;
    l16r = lbr; l16i = lbi;
#pragma unroll
    for (int i = 0; i < 4; ++i) { const float tr = l16r * l16r - l16i * l16i, ti = 2.f * l16r * l16i; l16r = tr; l16i = ti; }
  }
  bf16x8 bB[2];
#pragma unroll
  for (int nt = 0; nt < 2; ++nt) {
    const int pp = (2 * w + nt) * 16 + l15, ps = pp >> 1, cpl = pp & 1;
    const float lr = lam_re[ps], li = lam_im[ps];
    float sn, cs_; sincosf(li * dt, &sn, &cs_);
    const float e = expf(lr * dt);
    const float nr = e * cs_ - 1.0f, ni = e * sn, den = lr * lr + li * li;
    const float cfr = (nr * lr + ni * li) / den, cfi = (ni * lr - nr * li) / den;
    float v[8];
#pragma unroll
    for (int j = 0; j < 8; ++j) {
      const int h = (q4 & 1) * 8 + j;
      const float br = b_re[ps * 16 + h], bi = b_im[ps * 16 + h];
      const float val = cpl ? (cfr * bi + cfi * br) : (cfr * br - cfi * bi);
      v[j] = (q4 < 2) ? val : 0.f;
    }
    union { uint32_t u[4]; bf16x8 x; } cv; cv.u[0] = pack2(v[0], v[1]); cv.u[1] = pack2(v[2], v[3]); cv.u[2] = pack2(v[4], v[5]); cv.u[3] = pack2(v[6], v[7]);
    bB[nt] = cv.x;
  }
  bf16x8 cB[4];
#pragma unroll
  for (int ks = 0; ks < 4; ++ks) {
    float v[8];
#pragma unroll
    for (int j = 0; j < 8; ++j) {
      const int pp = ks * 32 + q4 * 8 + j, ps = pp >> 1;
      v[j] = (pp & 1) ? -c_im[l15 * 64 + ps] : c_re[l15 * 64 + ps];
    }
    union { uint32_t u[4]; bf16x8 x; } cv; cv.u[0] = pack2(v[0], v[1]); cv.u[1] = pack2(v[2], v[3]); cv.u[2] = pack2(v[4], v[5]); cv.u[3] = pack2(v[6], v[7]);
    cB[ks] = cv.x;
  }
  float car_r = 0.f, car_i = 0.f;
  bf16x8 un0, un1, un2, un3;
  {
    const bf16_t* zp = P.z + ((size_t)b * SEQL + l15) * ZLD + ZC_U + g * 16 + (q4 & 1) * 8;
    un0 = *(const bf16x8*)(zp); un1 = *(const bf16x8*)(zp + (size_t)16 * ZLD); un2 = *(const bf16x8*)(zp + (size_t)32 * ZLD); un3 = *(const bf16x8*)(zp + (size_t)48 * ZLD);
  }
  for (int chunk = 0; chunk < 64; ++chunk) {
    const size_t tok0 = (size_t)b * SEQL + chunk * 64;
    {
      bf16x8 ua[4];
      const bf16x8 zz = (bf16x8){0, 0, 0, 0, 0, 0, 0, 0};
      ua[0] = (q4 < 2) ? un0 : zz; ua[1] = (q4 < 2) ? un1 : zz; ua[2] = (q4 < 2) ? un2 : zz; ua[3] = (q4 < 2) ? un3 : zz;
      if (w == 0 && q4 < 2) {
#pragma unroll
        for (int mt = 0; mt < 4; ++mt) *(bf16x8*)(usb + (chunk & 1) * 1024 + (mt * 16 + l15) * 16 + q4 * 8) = ua[mt];
      }
      if (chunk + 1 < 64) {
        const bf16_t* zp = P.z + (tok0 + 64 + l15) * ZLD + ZC_U + g * 16 + (q4 & 1) * 8;
        un0 = *(const bf16x8*)(zp); un1 = *(const bf16x8*)(zp + (size_t)16 * ZLD); un2 = *(const bf16x8*)(zp + (size_t)32 * ZLD); un3 = *(const bf16x8*)(zp + (size_t)48 * ZLD);
      }
#pragma unroll
      for (int mt = 0; mt < 4; ++mt)
#pragma unroll
        for (int nt = 0; nt < 2; ++nt) {
          const f32x4 acc = __builtin_amdgcn_mfma_f32_16x16x32_bf16(ua[mt], bB[nt], (f32x4){0.f, 0.f, 0.f, 0.f}, 0, 0, 0);
          float* dst = bu + (mt * 16 + q4 * 4) * 130 + (2 * w + nt) * 16 + l15;
          dst[0] = acc[0]; dst[130] = acc[1]; dst[260] = acc[2]; dst[390] = acc[3];
        }
    }
    __syncthreads();
    float locr[16], loci[16];
    float sr = 0.f, si = 0.f;
#pragma unroll
    for (int i = 0; i < 16; ++i) {
      const float2 v = *(const float2*)(bu + (q * 16 + i) * 130 + 2 * p);
      const float nsr = lbr * sr - lbi * si + v.x, nsi = lbr * si + lbi * sr + v.y;
      sr = nsr; si = nsi; locr[i] = sr; loci[i] = si;
    }
    send[q * 64 + p] = make_float2(sr, si);
    __syncthreads();
    float cur_r = car_r, cur_i = car_i, mine_r = 0.f, mine_i = 0.f;
#pragma unroll
    for (int qq = 0; qq < 4; ++qq) {
      if (qq == q) { mine_r = cur_r; mine_i = cur_i; }
      const float2 ev = send[qq * 64 + p];
      const float tr = l16r * cur_r - l16i * cur_i + ev.x, ti = l16r * cur_i + l16i * cur_r + ev.y;
      cur_r = tr; cur_i = ti;
    }
    car_r = cur_r; car_i = cur_i;
    float cpr = lbr * mine_r - lbi * mine_i, cpi = lbr * mine_i + lbi * mine_r;
#pragma unroll
    for (int i = 0; i < 16; ++i) {
      *(uint32_t*)(stb + (q * 16 + i) * 136 + 2 * p) = pack2(locr[i] + cpr, loci[i] + cpi);
      const float tr = lbr * cpr - lbi * cpi, ti = lbr * cpi + lbi * cpr;
      cpr = tr; cpi = ti;
    }
    __syncthreads();
    {
      f32x4 acc = (f32x4){0.f, 0.f, 0.f, 0.f};
#pragma unroll
      for (int ks = 0; ks < 4; ++ks) {
        const bf16x8 as = *(const bf16x8*)(stb + (w * 16 + l15) * 136 + ks * 32 + q4 * 8);
        acc = __builtin_amdgcn_mfma_f32_16x16x32_bf16(as, cB[ks], acc, 0, 0, 0);
      }
#pragma unroll
      for (int r = 0; r < 4; ++r) {
        const size_t t = tok0 + w * 16 + q4 * 4 + r;
        const float uval = bf2f(usb[(chunk & 1) * 1024 + (w * 16 + q4 * 4 + r) * 16 + l15]);
        const float y = gelu_tanh(acc[r] + dk * uval);
        P.ys[t * LD5 + g * 16 + l15] = (bf16_t)(pack2(y, 0.f) & 0xffffu);
      }
    }
  }
}

__device__ __forceinline__ void load8(const bf16_t* p, float (&f)[8]) {
  const uint4 w = *(const uint4*)p;
  f[0] = lo2f(w.x); f[1] = hi2f(w.x); f[2] = lo2f(w.y); f[3] = hi2f(w.y); f[4] = lo2f(w.z); f[5] = hi2f(w.z); f[6] = lo2f(w.w); f[7] = hi2f(w.w);
}
__device__ __forceinline__ void store8(bf16_t* p, const float (&f)[8]) {
  uint4 w; w.x = pack2(f[0], f[1]); w.y = pack2(f[2], f[3]); w.z = pack2(f[4], f[5]); w.w = pack2(f[6], f[7]);
  *(uint4*)p = w;
}
__device__ void prep_unit(const Params& P, int layer, int ck, char* smem) {
  const int tid = TIDX;
  const int tok0 = ck * 64, b = tok0 >> 12, s0 = tok0 & 4095;
  const bf16_t* z = P.z;
  {
    const float* cw = P.in[12] + (size_t)layer * 3 * 512;
    const int c2 = tid * 2;
    const float w00 = cw[c2], w01 = cw[c2 + 1], w10 = cw[512 + c2], w11 = cw[512 + c2 + 1], w20 = cw[1024 + c2], w21 = cw[1024 + c2 + 1];
    float p2a = 0.f, p2b = 0.f, p1a = 0.f, p1b = 0.f;
    if (s0 >= 2) {
      const uint32_t cc2 = *(const uint32_t*)(z + (size_t)(tok0 - 2) * ZLD + ZC_CC + c2), cx2 = *(const uint32_t*)(z + (size_t)(tok0 - 2) * ZLD + ZC_CX + c2);
      const uint32_t cc1 = *(const uint32_t*)(z + (size_t)(tok0 - 1) * ZLD + ZC_CC + c2), cx1 = *(const uint32_t*)(z + (size_t)(tok0 - 1) * ZLD + ZC_CX + c2);
      p2a = lo2f(cc2) * lo2f(cx2); p2b = hi2f(cc2) * hi2f(cx2); p1a = lo2f(cc1) * lo2f(cx1); p1b = hi2f(cc1) * hi2f(cx1);
    }
#pragma unroll 8
    for (int t = 0; t < 64; ++t) {
      const size_t ro = (size_t)(tok0 + t) * ZLD;
      const uint32_t cb = *(const uint32_t*)(z + ro + ZC_CB + c2), cc = *(const uint32_t*)(z + ro + ZC_CC + c2), cx = *(const uint32_t*)(z + ro + ZC_CX + c2);
      const float p0a = lo2f(cc) * lo2f(cx), p0b = hi2f(cc) * hi2f(cx);
      const float oa = lo2f(cb) * (w00 * p2a + w10 * p1a + w20 * p0a), ob_ = hi2f(cb) * (w01 * p2b + w11 * p1b + w21 * p0b);
      *(uint32_t*)(P.cv + (size_t)(tok0 + t) * LD5 + c2) = pack2(oa, ob_);
      p2a = p1a; p2b = p1b; p1a = p0a; p1b = p0b;
    }
  }
  {
    const float* qg = P.in[14] + (size_t)layer * 64;
    const int d8 = (tid & 7) * 8;
    float gq[8];
#pragma unroll
    for (int j = 0; j < 8; ++j) gq[j] = qg[d8 + j] * (0.125f * 1.44269504089f);
#pragma unroll 8
    for (int it = 0; it < 16; ++it) {
      const int row = it * 32 + (tid >> 3), t = row >> 3, h = row & 7;
      float f[8]; load8(z + (size_t)(tok0 + t) * ZLD + ZC_Q + h * 64 + d8, f);
      float ss = 0.f;
#pragma unroll
      for (int j = 0; j < 8; ++j) ss += f[j] * f[j];
      ss += __shfl_xor(ss, 1); ss += __shfl_xor(ss, 2); ss += __shfl_xor(ss, 4);
      const float r = rsqrtf(ss * (1.0f / 64.f) + RMS_EPS);
#pragma unroll
      for (int j = 0; j < 8; ++j) f[j] = f[j] * r * gq[j];
      store8(P.qn + (size_t)(tok0 + t) * 512 + h * 64 + d8, f);
    }
  }
  {
    const float* kg = P.in[15] + (size_t)layer * 3 * 64;
    const int d8 = (tid & 7) * 8;
#pragma unroll 8
    for (int it = 0; it < 8; ++it) {
      const int row = it * 32 + (tid >> 3), which = row >> 7, t = (row >> 1) & 63, kvh = row & 1;
      float f[8]; load8(z + (size_t)(tok0 + t) * ZLD + (which ? ZC_KW : ZC_KS) + kvh * 64 + d8, f);
      float ss = 0.f;
#pragma unroll
      for (int j = 0; j < 8; ++j) ss += f[j] * f[j];
      ss += __shfl_xor(ss, 1); ss += __shfl_xor(ss, 2); ss += __shfl_xor(ss, 4);
      const float r = rsqrtf(ss * (1.0f / 64.f) + RMS_EPS);
#pragma unroll
      for (int j = 0; j < 8; ++j) f[j] = f[j] * r * kg[(1 + which) * 64 + d8 + j];
      bf16_t* dst = (which ? P.kwn : P.ksn) + ((size_t)(b * 2 + kvh) * SEQL + s0 + t) * 64 + d8;
      store8(dst, f);
    }
  }
  {
    bf16_t* lt = (bf16_t*)smem;
    for (int which = 0; which < 2; ++which) {
      __syncthreads();
      {
        const int c8 = (tid & 15) * 8;
#pragma unroll
        for (int it = 0; it < 4; ++it) {
          const int t = it * 16 + (tid >> 4);
          const uint4 w = *(const uint4*)(z + (size_t)(tok0 + t) * ZLD + (which ? ZC_VW : ZC_VS) + c8);
          uint32_t* d = (uint32_t*)(lt + t * 130 + c8);
          d[0] = w.x; d[1] = w.y; d[2] = w.z; d[3] = w.w;
        }
      }
      __syncthreads();
      const int lane = tid & 63, wave = tid >> 6;
      bf16_t* dstb = which ? P.vwT : P.vsT;
#pragma unroll 8
      for (int it = 0; it < 32; ++it) {
        const int row = it * 4 + wave;
        dstb[((size_t)(b * 2) * 64 + row) * LDV + s0 + lane] = lt[lane * 130 + row];
      }
    }
  }
}
__device__ void phase_prep(const Params& P, int layer, char* smem) {
  const int bid = BIDX;
  if (bid < 128) { phase_gemm_cmp1(P, smem, bid, 128); __syncthreads(); phase_convert_late(P, layer, smem, 128 + bid, 256); }
  else if (bid < 384) { prep_unit(P, layer, bid - 128, smem); }
  else phase_convert_late(P, layer, smem, bid - 384, 256);
}

__device__ void phase_cmp2(const Params& P, int layer, char* smem) {
  const int lane = TIDX & 63, wave = TIDX >> 6;
  const float* hidp = (const float*)P.acmp;
  float* hs = (float*)(smem + wave * 1024);
  for (int wu = BIDX * 4 + wave; wu < 2048; wu += gridDim.x * 4) {
    const int which = wu >> 10, row = wu & 1023;
    const float* w2 = P.in[18] + (size_t)(layer * 2 + which) * 256 * 64;
#pragma unroll
    for (int i = 0; i < 4; ++i) {
      const int k = lane + 64 * i;
      float sv = P.cbias[which * 256 + k];
#pragma unroll
      for (int kq = 0; kq < 4; ++kq) sv += hidp[((size_t)(kq * 2 + which) * 1024 + row) * 256 + k];
      hs[k] = gelu_tanh(sv);
    }
    float acc = 0.f;
#pragma unroll 8
    for (int k = 0; k < 256; ++k) acc += hs[k] * w2[k * 64 + lane];
    const int kvh = row & 1, bc = row >> 1, b = bc >> 7, c = bc & 127;
    if (which == 0) {
      float ss = acc * acc;
#pragma unroll
      for (int o = 32; o >= 1; o >>= 1) ss += __shfl_xor(ss, o);
      const float r = rsqrtf(ss * (1.0f / 64.f) + RMS_EPS);
      const float v = acc * r * P.in[15][(size_t)layer * 3 * 64 + lane];
      P.kc[((size_t)(b * 2 + kvh) * 128 + c) * 64 + lane] = (bf16_t)(pack2(v, 0.f) & 0xffff);
    } else {
      P.vcT[((size_t)(b * 2 + kvh) * 64 + lane) * 128 + c] = (bf16_t)(pack2(acc, 0.f) & 0xffff);
    }
  }
}

#define NEGBIG (-1e30f)
#define NQ 2
__device__ __forceinline__ void attn_load_tiles(const bf16_t* __restrict__ Kp, const bf16_t* __restrict__ Vp, int vstride, char* KT, char* VT) {
  const int tid = TIDX;
  const int row = tid >> 3, ch = tid & 7;
  const int so = lds_off(row, ch);
  const uint4 k0 = *(const uint4*)(Kp + (size_t)row * 64 + ch * 8), k1 = *(const uint4*)(Kp + (size_t)(row + 32) * 64 + ch * 8);
  const uint4 v0 = *(const uint4*)(Vp + (size_t)row * vstride + ch * 8), v1 = *(const uint4*)(Vp + (size_t)(row + 32) * vstride + ch * 8);
  *(uint4*)(KT + so) = k0; *(uint4*)(KT + so + 4096) = k1;
  *(uint4*)(VT + so) = v0; *(uint4*)(VT + so + 4096) = v1;
}
#define KV_ISSUE(Kp, Vp, vstride) do { const int tid_ = TIDX; const int row_ = tid_ >> 3, ch_ = tid_ & 7; \
    rk0 = *(const uint4*)((Kp) + (size_t)row_ * 64 + ch_ * 8); rk1 = *(const uint4*)((Kp) + (size_t)(row_ + 32) * 64 + ch_ * 8); \
    rv0 = *(const uint4*)((Vp) + (size_t)row_ * (vstride) + ch_ * 8); rv1 = *(const uint4*)((Vp) + (size_t)(row_ + 32) * (vstride) + ch_ * 8); } while (0)
#define KV_STORE() do { const int tid_ = TIDX; const int so_ = lds_off(tid_ >> 3, tid_ & 7); \
    *(uint4*)(KT + so_) = rk0; *(uint4*)(KT + so_ + 4096) = rk1; *(uint4*)(VT + so_) = rv0; *(uint4*)(VT + so_ + 4096) = rv1; } while (0)
__device__ __forceinline__ void attn_scores(const char* KT, int kfr0, const bf16x8 (&qf)[NQ][2], f32x4 (&S)[4][NQ]) {
#pragma unroll
  for (int mk = 0; mk < 4; ++mk)
#pragma unroll
    for (int nq = 0; nq < NQ; ++nq) S[mk][nq] = (f32x4){0.f, 0.f, 0.f, 0.f};
#pragma unroll
  for (int ks = 0; ks < 2; ++ks) {
    const char* pk = KT + (kfr0 ^ (ks * 64));
#pragma unroll
    for (int mk = 0; mk < 4; ++mk) {
      const bf16x8 kf = *(const bf16x8*)(pk + mk * 2048);
#pragma unroll
      for (int nq = 0; nq < NQ; ++nq) S[mk][nq] = __builtin_amdgcn_mfma_f32_16x16x32_bf16(kf, qf[nq][ks], S[mk][nq], 0, 0, 0);
    }
  }
}
__device__ __forceinline__ void attn_pv(const char* VT, int vfr0, const f32x4 (&S)[4][NQ], f32x4 (&O)[4][NQ]) {
#pragma unroll
  for (int s2 = 0; s2 < 2; ++s2) {
    bf16x8 pf[NQ];
#pragma unroll
    for (int nq = 0; nq < NQ; ++nq) {
      union { uint32_t u[4]; bf16x8 v; } cvt;
      cvt.u[0] = pack2(S[2 * s2][nq][0], S[2 * s2][nq][1]); cvt.u[1] = pack2(S[2 * s2][nq][2], S[2 * s2][nq][3]);
      cvt.u[2] = pack2(S[2 * s2 + 1][nq][0], S[2 * s2 + 1][nq][1]); cvt.u[3] = pack2(S[2 * s2 + 1][nq][2], S[2 * s2 + 1][nq][3]);
      pf[nq] = cvt.v;
    }
    const char* pv0 = VT + (vfr0 ^ (s2 * 64));
    const char* pv1 = VT + (vfr0 ^ (s2 * 64) ^ 32);
#pragma unroll
    for (int md = 0; md < 4; ++md) {
      union { uint2 h[2]; bf16x8 v; } vv;
      vv.h[0] = *(const uint2*)(pv0 + md * 2048);
      vv.h[1] = *(const uint2*)(pv1 + md * 2048);
#pragma unroll
      for (int nq = 0; nq < NQ; ++nq) O[md][nq] = __builtin_amdgcn_mfma_f32_16x16x32_bf16(vv.v, pf[nq], O[md][nq], 0, 0, 0);
    }
  }
}
__device__ __forceinline__ void attn_mask(f32x4 (&S)[4][NQ], int mode, int selbits, int hb, int posbase, int kbase, int l15, int q4) {
#pragma unroll
  for (int nq = 0; nq < NQ; ++nq) {
    const int rr = nq * 16 + l15;
    const bool rs = (selbits >> nq) & 1;
    const int lim = (posbase + rr + 1) >> 5;
#pragma unroll
    for (int mk = 0; mk < 4; ++mk)
#pragma unroll
      for (int r = 0; r < 4; ++r) {
        const int kk = mk * 16 + q4 * 4 + r;
        bool valid = rs;
        if (mode == 1) valid = valid && (kk <= hb + rr);
        else if (mode == 2) valid = valid && (kk > hb + rr);
        else if (mode == 3) valid = valid && (kbase + kk < lim);
        S[mk][nq][r] = valid ? S[mk][nq][r] : NEGBIG;
      }
  }
}
__device__ __forceinline__ void attn_softmax_step(f32x4 (&S)[4][NQ], float (&m)[NQ], float (&l)[NQ], f32x4 (&O)[4][NQ], bool rescale) {
#pragma unroll
  for (int nq = 0; nq < NQ; ++nq) {
    float mx = NEGBIG;
#pragma unroll
    for (int mk = 0; mk < 4; ++mk)
#pragma unroll
      for (int r = 0; r < 4; ++r) mx = fmaxf(mx, S[mk][nq][r]);
    mx = fmaxf(mx, __shfl_xor(mx, 16)); mx = fmaxf(mx, __shfl_xor(mx, 32));
    const float mnew = fmaxf(m[nq], mx);
    const float alpha = __builtin_amdgcn_exp2f(m[nq] - mnew);
    m[nq] = mnew;
    const float muse = fmaxf(mnew, -1e28f);
    float ps = 0.f;
#pragma unroll
    for (int mk = 0; mk < 4; ++mk)
#pragma unroll
      for (int r = 0; r < 4; ++r) {
        const float pv = __builtin_amdgcn_exp2f(S[mk][nq][r] - muse);
        ps += pv; S[mk][nq][r] = pv;
      }
    l[nq] = l[nq] * alpha + ps;
    if (rescale && __ballot(alpha != 1.0f) != 0ull) {
#pragma unroll
      for (int md = 0; md < 4; ++md) O[md][nq] *= alpha;
    }
  }
}
__device__ __forceinline__ void attn_reset(float (&m)[NQ], float (&l)[NQ], f32x4 (&O)[4][NQ]) {
#pragma unroll
  for (int nq = 0; nq < NQ; ++nq) { m[nq] = NEGBIG; l[nq] = 0.f; }
#pragma unroll
  for (int md = 0; md < 4; ++md)
#pragma unroll
    for (int nq = 0; nq < NQ; ++nq) O[md][nq] = (f32x4){0.f, 0.f, 0.f, 0.f};
}

__device__ void attn_unit(const Params& P, int unit, char* smem) {
  const int c32 = 127 - (unit >> 3);
  const int bk = unit & 7, b = bk >> 1, kvh = bk & 1;
  const int c = c32 >> 1, hb = (c32 & 1) * 32, posbase = c32 * 32;
  const int tid = TIDX, lane = tid & 63, g = tid >> 6, l15 = lane & 15, q4 = lane >> 4;
  const int h = kvh * 4 + g;
  const size_t tok0 = (size_t)b * SEQL + posbase;
  char* KT = smem;
  char* VT = smem + 8192;
  float* IMP = (float*)(smem + 16384);
  uint32_t* MASK = (uint32_t*)(smem + 16384 + 32 * 65 * 4);
  const int sw = (l15 >> 1) & 7;
  const int kfr0 = l15 * 128 + (((q4 ^ (sw & 3)) << 4) | ((sw >> 2) << 6));
  const int vfr0 = l15 * 128 + ((((q4 >> 1) ^ (sw & 1)) | (sw & 6)) << 4) + (q4 & 1) * 8;

  bf16x8 qf[NQ][2];
#pragma unroll
  for (int nq = 0; nq < NQ; ++nq)
#pragma unroll
    for (int ks = 0; ks < 2; ++ks) qf[nq][ks] = *(const bf16x8*)(P.qn + (tok0 + nq * 16 + l15) * 512 + h * 64 + ks * 32 + q4 * 8);

  f32x4 S[4][NQ], O[4][NQ];
  float m[NQ], l[NQ];
  const bf16_t* kcb = P.kc + (size_t)(b * 2 + kvh) * 128 * 64;
  const bf16_t* vcb = P.vcT + (size_t)(b * 2 + kvh) * 64 * 128;
  const int njb = (c32 + 1 + 63) >> 6;
  attn_reset(m, l, O);

  uint4 rk0, rk1, rv0, rv1;
  KV_ISSUE(kcb, vcb, 128);
  for (int jb = 0; jb < njb; ++jb) {
    __syncthreads();
    KV_STORE();
    __syncthreads();
    { const int jn = (jb + 1 < njb) ? jb + 1 : 0; KV_ISSUE(kcb + (size_t)jn * 64 * 64, vcb + jn * 64, 128); }
    __builtin_amdgcn_sched_barrier(0);
    attn_scores(KT, kfr0, qf, S);
    attn_mask(S, 3, 3, hb, posbase, jb * 64, l15, q4);
    attn_softmax_step(S, m, l, O, false);
  }
  float invl[NQ];
#pragma unroll
  for (int nq = 0; nq < NQ; ++nq) { float lt = l[nq]; lt += __shfl_xor(lt, 16); lt += __shfl_xor(lt, 32); invl[nq] = 1.0f / fmaxf(lt, 1e-30f); }
  for (int jb = 0; jb < njb; ++jb) {
    __syncthreads();
    KV_STORE();
    __syncthreads();
    { const int jn = (jb + 1 < njb) ? jb + 1 : jb; KV_ISSUE(kcb + (size_t)jn * 64 * 64, vcb + jn * 64, 128); }
    __builtin_amdgcn_sched_barrier(0);
    attn_scores(KT, kfr0, qf, S);
    attn_mask(S, 3, 3, hb, posbase, jb * 64, l15, q4);
#pragma unroll
    for (int nq = 0; nq < NQ; ++nq)
#pragma unroll
      for (int mk = 0; mk < 4; ++mk)
#pragma unroll
        for (int r = 0; r < 4; ++r) S[mk][nq][r] = __builtin_amdgcn_exp2f(S[mk][nq][r] - fmaxf(m[nq], -1e28f)) * invl[nq];
    for (int gg = 0; gg < 4; ++gg) {
      if (g == gg) {
#pragma unroll
        for (int nq = 0; nq < NQ; ++nq)
#pragma unroll
          for (int mk = 0; mk < 4; ++mk) {
            float* ip = IMP + (nq * 16 + l15) * 65 + jb * 32 + mk * 8 + q4 * 2;
            const float v0 = S[mk][nq][0] + S[mk][nq][1], v1 = S[mk][nq][2] + S[mk][nq][3];
            if (gg == 0) { ip[0] = v0; ip[1] = v1; } else { ip[0] += v0; ip[1] += v1; }
          }
      }
      __syncthreads();
    }
    attn_pv(VT, vfr0, S, O);
  }
  uint2 oreg[4][NQ];
#pragma unroll
  for (int nq = 0; nq < NQ; ++nq) {
    const float g0 = sigmoidf_(bf2f(P.z[(tok0 + nq * 16 + l15) * ZLD + ZC_NG + h * 3 + 0]));
#pragma unroll
    for (int md = 0; md < 4; ++md) {
      oreg[md][nq].x = pack2(O[md][nq][0] * g0, O[md][nq][1] * g0); oreg[md][nq].y = pack2(O[md][nq][2] * g0, O[md][nq][3] * g0);
    }
  }
  __syncthreads();
  for (int i = 0; i < 8; ++i) {
    const int rr = g * 8 + i;
    const float v = IMP[rr * 65 + lane];
    const bool visible = lane <= c;
    const bool forced = (lane == 0) || (lane == c) || (lane == c - 1);
    const float val = forced ? 1e4f : (visible ? v : -INFINITY);
    int rank = 0;
#pragma unroll
    for (int j = 0; j < 64; ++j) {
      const float vj = __int_as_float(__builtin_amdgcn_readlane(__float_as_int(val), j));
      rank += ((vj > val) || (vj == val && j < lane)) ? 1 : 0;
    }
    const bool sel = (rank < 16) && visible;
    const unsigned long long mk = __ballot(sel);
    if (lane == 0) { MASK[rr * 2] = (uint32_t)mk; MASK[rr * 2 + 1] = (uint32_t)(mk >> 32); }
  }
  __syncthreads();
  uint32_t ulo = MASK[(lane & 31) * 2], uhi = MASK[(lane & 31) * 2 + 1];
#pragma unroll
  for (int o = 16; o >= 1; o >>= 1) { ulo |= __shfl_xor(ulo, o); uhi |= __shfl_xor(uhi, o); }
  ulo = __builtin_amdgcn_readfirstlane(ulo); uhi = __builtin_amdgcn_readfirstlane(uhi);
  unsigned long long rem = ((unsigned long long)uhi << 32) | ulo;
  unsigned long long mrow[NQ];
#pragma unroll
  for (int nq = 0; nq < NQ; ++nq) mrow[nq] = ((unsigned long long)MASK[(nq * 16 + l15) * 2 + 1] << 32) | MASK[(nq * 16 + l15) * 2];

  attn_reset(m, l, O);
  {
    const bf16_t* kb = P.ksn + (size_t)(b * 2 + kvh) * SEQL * 64;
    const bf16_t* vb = P.vsT + (size_t)(b * 2 + kvh) * 64 * LDV;
    int j = __builtin_ctzll(rem);
    rem &= rem - 1;
    KV_ISSUE(kb + (size_t)j * 64 * 64, vb + j * 64, LDV);
    __syncthreads();
    KV_STORE();
    bool last = (rem == 0);
    int jn = last ? j : __builtin_ctzll(rem);
    rem &= rem - 1;
    KV_ISSUE(kb + (size_t)jn * 64 * 64, vb + jn * 64, LDV);
    __syncthreads();
    int pb = 0;
    for (;;) {
      const char* KTc = smem + pb * 32768; const char* VTc = KTc + 8192;
      __builtin_amdgcn_sched_barrier(0);
      attn_scores(KTc, kfr0, qf, S);
      int selbits = 0;
#pragma unroll
      for (int nq = 0; nq < NQ; ++nq) selbits |= (int)((mrow[nq] >> j) & 1ull) << nq;
      if (j == c) attn_mask(S, 1, selbits, hb, posbase, 0, l15, q4); else attn_mask(S, 0, selbits, hb, posbase, 0, l15, q4);
      attn_softmax_step(S, m, l, O, true);
      attn_pv(VTc, vfr0, S, O);
      if (last) break;
      { char* KT = smem + (pb ^ 1) * 32768; char* VT = KT + 8192; KV_STORE(); }
      j = jn; last = (rem == 0); jn = last ? j : __builtin_ctzll(rem); rem &= rem - 1;
      KV_ISSUE(kb + (size_t)jn * 64 * 64, vb + jn * 64, LDV);
      __syncthreads();
      pb ^= 1;
    }
  }
#pragma unroll
  for (int nq = 0; nq < NQ; ++nq) {
    float lt = l[nq]; lt += __shfl_xor(lt, 16); lt += __shfl_xor(lt, 32);
    const float sc = sigmoidf_(bf2f(P.z[(tok0 + nq * 16 + l15) * ZLD + ZC_NG + h * 3 + 1])) / fmaxf(lt, 1e-30f);
#pragma unroll
    for (int md = 0; md < 4; ++md) {
      const uint2 ov = oreg[md][nq];
      oreg[md][nq].x = pack2(lo2f(ov.x) + O[md][nq][0] * sc, hi2f(ov.x) + O[md][nq][1] * sc);
      oreg[md][nq].y = pack2(lo2f(ov.y) + O[md][nq][2] * sc, hi2f(ov.y) + O[md][nq][3] * sc);
    }
  }
  attn_reset(m, l, O);
  {
    const bf16_t* kb = P.kwn + (size_t)(b * 2 + kvh) * SEQL * 64;
    const bf16_t* vb = P.vwT + (size_t)(b * 2 + kvh) * 64 * LDV;
    const int j0 = (c - 8 > 0) ? (c - 8) : 0;
    int j = j0;
    KV_ISSUE(kb + (size_t)j * 64 * 64, vb + j * 64, LDV);
    __syncthreads();
    KV_STORE();
    int jn = (j < c) ? j + 1 : j;
    KV_ISSUE(kb + (size_t)jn * 64 * 64, vb + jn * 64, LDV);
    __syncthreads();
    int pb = 0;
    for (;;) {
      const char* KTc = smem + pb * 32768; const char* VTc = KTc + 8192;
      __builtin_amdgcn_sched_barrier(0);
      attn_scores(KTc, kfr0, qf, S);
      if (j == c) attn_mask(S, 1, 3, hb, posbase, 0, l15, q4);
      else if (j == c - 8) attn_mask(S, 2, 3, hb, posbase, 0, l15, q4);
      attn_softmax_step(S, m, l, O, true);
      attn_pv(VTc, vfr0, S, O);
      if (j == c) break;
      { char* KT = smem + (pb ^ 1) * 32768; char* VT = KT + 8192; KV_STORE(); }
      j = jn; jn = (j < c) ? j + 1 : j;
      KV_ISSUE(kb + (size_t)jn * 64 * 64, vb + jn * 64, LDV);
      __syncthreads();
      pb ^= 1;
    }
  }
#pragma unroll
  for (int nq = 0; nq < NQ; ++nq) {
    float lt = l[nq]; lt += __shfl_xor(lt, 16); lt += __shfl_xor(lt, 32);
    const float sc = sigmoidf_(bf2f(P.z[(tok0 + nq * 16 + l15) * ZLD + ZC_NG + h * 3 + 2])) / fmaxf(lt, 1e-30f);
#pragma unroll
    for (int md = 0; md < 4; ++md) {
      const uint2 ov = oreg[md][nq];
      uint2 w; w.x = pack2(lo2f(ov.x) + O[md][nq][0] * sc, hi2f(ov.x) + O[md][nq][1] * sc); w.y = pack2(lo2f(ov.y) + O[md][nq][2] * sc, hi2f(ov.y) + O[md][nq][3] * sc);
      *(uint2*)(P.ob + (tok0 + nq * 16 + l15) * LD5 + h * 64 + md * 16 + q4 * 4) = w;
    }
  }
}
__device__ void phase_attn_s5(const Params& P, int layer, char* smem, int pass) {
  if (BIDX < 128) { s5_unit(P, layer, BIDX, smem); }
  unsigned* ctr = P.bar + 3600 + (layer * 2 + pass) * 56;
  volatile int* slot = (volatile int*)(smem + 65024);
  for (;;) {
    __syncthreads();
    if (threadIdx.x == 0) *slot = (int)atomicAdd(ctr, 1u);
    __syncthreads();
    const int u = __builtin_amdgcn_readfirstlane(*slot);
    if (u >= 1024) break;
    attn_unit(P, u, smem);
  }
}

#define NPHASE 11
__device__ __forceinline__ void run_phase(const Params& P, int layer, int ph, char* smem, float alpha = 1.0f) {
  switch (ph) {
    case 0: phase_convert(P, layer, smem); phase_cmp_bias(P, layer);
            phase_rmsnorm(layer == 0 ? P.in[0] : P.x, layer == 0 ? P.x : nullptr, P.in[1] + (size_t)layer * DM, P.hbuf); break;
    case 1: phase_gemm_in(P, smem); break;
    case 2: phase_prep(P, layer, smem); break;
    case 3: break;
    case 4: phase_cmp2(P, layer, smem); break;
    case 5: phase_attn_s5(P, layer, smem, alpha == 0.0f ? 1 : 0); break;
    case 6: phase_merge(P, smem); break;
    case 7: phase_gemm_resid(P, P.hbuf, LDH, P.Wt_out, DM, smem, alpha); break;
    case 8: phase_rmsnorm(P.x, nullptr, P.in[21] + (size_t)layer * DM, P.hbuf); break;
    case 9: phase_gemm_gateup(P, smem); break;
    case 10: phase_gemm_resid(P, P.z, LDA, P.Wt_down, DFF, smem, alpha); break;
  }
}

#ifndef REPEAT_MASK
#define REPEAT_MASK 0
#endif
#if !MEGA
__global__ void __launch_bounds__(256, 2) k_phase(Params P, int layer, int ph) {
  __shared__ __attribute__((aligned(16))) char smem[65536];
  run_phase(P, layer, ph, smem);
}
#else
#define XB_TMO      128
#define XB_XCNT(j)  (256  + 64 * (j))
#define XB_XSUB(j)  (1280 + 64 * (j))
#define XB_XGEN(j)  (2304 + 64 * (j))
#define XB_TOP      3328
#define XB_TOPGEN   3392
#define XCD_BAR_WORDS 3456
#define XB_SPIN_CAP (1u << 22)
__device__ __forceinline__ unsigned xb_ld(unsigned* p)              { return __hip_atomic_load(p, __ATOMIC_RELAXED, __HIP_MEMORY_SCOPE_AGENT); }
__device__ __forceinline__ unsigned xb_add(unsigned* p, unsigned v) { return __hip_atomic_fetch_add(p, v, __ATOMIC_RELAXED, __HIP_MEMORY_SCOPE_AGENT); }
__device__ __forceinline__ unsigned xb_xcc_id() { return (unsigned)__builtin_amdgcn_s_getreg((3 << 11) | 20) & 0xFu; }
#define XB_SPIN(cond, bar) do { unsigned _sp = 0; while (cond) { __builtin_amdgcn_s_sleep(1); \
    if ((++_sp & 255u) == 0u) { if (xb_ld(&(bar)[XB_TMO])) break; if (_sp > XB_SPIN_CAP) { atomicAdd(&(bar)[XB_TMO], 1u); break; } } } } while (0)
struct XcdBarrier { unsigned* bar; unsigned x, nloc, nx; };
__device__ __forceinline__ void xcd_barrier_complete(unsigned* bar, unsigned x, unsigned& nloc, unsigned& nx) {
  const unsigned G = gridDim.x;
  unsigned sum, cnt, mine, sp = 0u;
  for (;;) {
    sum = 0u; cnt = 0u; mine = 0u;
#pragma unroll
    for (unsigned j = 0; j < 16; ++j) { const unsigned c = xb_ld(&bar[XB_XCNT(j)]); sum += c; cnt += (c > 0u) ? 1u : 0u; mine = (j == x) ? c : mine; }
    if (sum == G) break;
    __builtin_amdgcn_s_sleep(1);
    if ((++sp & 255u) == 0u) { if (xb_ld(&bar[XB_TMO])) break; if (sp > XB_SPIN_CAP) { atomicAdd(&bar[XB_TMO], 1u); break; } }
  }
  nloc = mine > 0u ? mine : 1u; nx = cnt > 0u ? cnt : 1u;
}
__device__ __forceinline__ void xcd_barrier(const XcdBarrier& b) {
  asm volatile("s_waitcnt vmcnt(0)" ::: "memory");
  __syncthreads();
  if (threadIdx.x == 0) {
    unsigned* bar = b.bar;
    __builtin_amdgcn_s_waitcnt(0);
    const unsigned nloc = b.nloc, nx = b.nx;
    const unsigned old = xb_add(&bar[XB_XSUB(b.x)], 1u);
    const unsigned gen = old / nloc;
    if (old + 1u == (gen + 1u) * nloc) {
      __builtin_amdgcn_fence(__ATOMIC_RELEASE, "agent");
      asm volatile("s_waitcnt vmcnt(0)" ::: "memory");
      const unsigned og = xb_add(&bar[XB_TOP], 1u);
      const unsigned tg = og / nx;
      if (og + 1u == (tg + 1u) * nx) xb_add(&bar[XB_TOPGEN], 1u);
      else XB_SPIN(xb_ld(&bar[XB_TOPGEN]) == tg, bar);
      __builtin_amdgcn_fence(__ATOMIC_ACQUIRE, "agent");
      xb_add(&bar[XB_XGEN(b.x)], 1u);
      asm volatile("s_waitcnt vmcnt(0)" ::: "memory");
    } else {
      XB_SPIN(xb_ld(&bar[XB_XGEN(b.x)]) == gen, bar);
      __builtin_amdgcn_fence(__ATOMIC_ACQUIRE, "agent");
      asm volatile("s_waitcnt vmcnt(0)" ::: "memory");
    }
  }
  __syncthreads();
}

__global__ void __launch_bounds__(256, 2) k_mega(Params P) {
  __shared__ __attribute__((aligned(16))) char smem[65536];
  if (P.x == nullptr) { cg::this_grid().sync(); }
  XcdBarrier xb; xb.bar = P.bar; xb.x = xb_xcc_id(); xb.nloc = 1u; xb.nx = 1u;
  if (threadIdx.x == 0) { (void)xb_add(&P.bar[XB_XCNT(xb.x)], 1u); xcd_barrier_complete(P.bar, xb.x, xb.nloc, xb.nx); }
  for (int layer = 0; layer < DEPTH; ++layer) {
    for (int ph = 0; ph < NPHASE; ++ph) {
      if (ph == 3) continue;
      run_phase(P, layer, ph, smem);
      if ((REPEAT_MASK >> ph) & 1) { xcd_barrier(xb); run_phase(P, layer, ph, smem, 0.0f); }
      if (!(layer == DEPTH - 1 && ph == NPHASE - 1)) xcd_barrier(xb);
    }
  }
}
#endif

extern "C" void kernel_launch(void* const* d_in, const int* in_sizes, int n_in, void* d_out, int out_size, void* d_ws, size_t ws_size, hipStream_t stream) {
  Params P;
  memset(&P, 0, sizeof(P));
  for (int i = 0; i < 24; ++i) P.in[i] = (const float*)d_in[i];
  P.x = (float*)d_out;
  char* w = (char*)d_ws;
  size_t off = 0;
  auto take = [&](size_t bytes) { char* p = w + off; off += (bytes + 255) & ~(size_t)255; return (bf16_t*)p; };
  P.Wt_in = take((size_t)ZLD * LDH * 2);
  P.Wt_glu = take((size_t)2048 * LD5 * 2);
  P.Wt_conv = take((size_t)1024 * LD5 * 2);
  P.Wt_o = take((size_t)1024 * LD5 * 2);
  P.Wt_out = take((size_t)1024 * LDH * 2);
  P.Wt_gu = take((size_t)5632 * LDH * 2);
  P.Wt_down = take((size_t)1024 * LDA * 2);
  P.Wt_c1 = take((size_t)512 * LDC * 2);
  P.z = take((size_t)T_TOK * ZLD * 2);
  P.hbuf = take((size_t)T_TOK * LDH * 2);
  P.ys = take((size_t)T_TOK * LD5 * 2);
  P.cv = take((size_t)T_TOK * LD5 * 2);
  P.ob = take((size_t)T_TOK * LD5 * 2);
  P.qn = take((size_t)T_TOK * 512 * 2);
  P.ksn = take((size_t)T_TOK * 128 * 2);
  P.kwn = take((size_t)T_TOK * 128 * 2);
  P.vsT = take((size_t)8 * 64 * LDV * 2);
  P.vwT = take((size_t)8 * 64 * LDV * 2);
  P.acmp = take((size_t)2 * 1024 * LDC * 2);
  P.hid = take((size_t)2 * 1024 * 256 * 2);
  P.kc = take((size_t)8 * 128 * 64 * 2);
  P.vcT = take((size_t)8 * 64 * 128 * 2);
  P.bar = (unsigned*)take((size_t)4096 * 4);
  P.cbias = (float*)take((size_t)512 * 4);
  if (off > ws_size) { fprintf(stderr, "kernel_launch: workspace too small: need %zu have %zu\n", off, ws_size); return; }
#if MEGA
  static int grid_blocks = 0;
  if (!grid_blocks) {
    int dev = 0, cus = 0, per_cu = 0;
    hipGetDevice(&dev);
    hipDeviceGetAttribute(&cus, hipDeviceAttributeMultiprocessorCount, dev);
    hipOccupancyMaxActiveBlocksPerMultiprocessor(&per_cu, k_mega, 256, 0);
    (void)per_cu;
    grid_blocks = cus * 2;
  }
  hipMemsetAsync(P.bar, 0, 4096 * 4, stream);
  void* args[] = {&P};
  hipError_t e = hipLaunchCooperativeKernel((void*)k_mega, dim3(grid_blocks), dim3(256), args, 0, stream);
  if (e != hipSuccess) fprintf(stderr, "cooperative launch failed: %s (grid %d)\n", hipGetErrorString(e), grid_blocks);
#else
  for (int layer = 0; layer < DEPTH; ++layer)
    for (int ph = 0; ph < NPHASE; ++ph) {
      hipLaunchKernelGGL(k_phase, dim3(512), dim3(256), 0, stream, P, layer, ph);
      if ((REPEAT_MASK >> ph) & 1) hipLaunchKernelGGL(k_phase, dim3(512), dim3(256), 0, stream, P, layer, ph);
    }
#endif
}
```

```cpp
#include <hip/hip_runtime.h>
#include <hip/hip_cooperative_groups.h>
#include <stdint.h>
#include <cstdio>
#include <cstring>
namespace cg = cooperative_groups;

#ifndef MEGA
#define MEGA 1
#endif

typedef unsigned short bf16_t;
typedef short bf16x8 __attribute__((ext_vector_type(8)));
typedef float f32x4 __attribute__((ext_vector_type(4)));

#define T_TOK 16384
#define SEQL 4096
#define DM 1024
#define ZLD 6528
#define NIN 6424
#define DFF 2816
#define DEPTH 4
#define LDH 1088
#define LD5 576
#define LDA 2880
#define LDC 2112
#define LDV 4160
#define LDS_F 544
#define ZC_U 0
#define ZC_CB 512
#define ZC_CC 1024
#define ZC_CX 1536
#define ZC_Q 2048
#define ZC_KC 2560
#define ZC_VC 2688
#define ZC_KS 2816
#define ZC_VS 2944
#define ZC_KW 3072
#define ZC_VW 3200
#define ZC_MIX 3328
#define ZC_NG 6400
#define RMS_EPS 1e-6f

struct Params {
  const float* in[24];
  float* x;
  bf16_t *Wt_in, *Wt_glu, *Wt_conv, *Wt_o, *Wt_out, *Wt_gu, *Wt_down, *Wt_c1;
  bf16_t *z, *hbuf, *ys, *cv, *ob, *qn, *ksn, *kwn, *vsT, *vwT, *acmp, *hid, *kc, *vcT;
  unsigned* bar;
  float* cbias;
};

__device__ __forceinline__ int tidx_() { int t = threadIdx.x; asm volatile("" : "+v"(t)); return t; }
__device__ __forceinline__ int bidx_() { int t = blockIdx.x; asm volatile("" : "+s"(t)); return t; }
#define TIDX tidx_()
#define BIDX bidx_()
__device__ __forceinline__ float bf2f(bf16_t b) { return __uint_as_float(((uint32_t)b) << 16); }
__device__ __forceinline__ uint32_t pack2(float lo, float hi) {
  uint32_t r; asm("v_cvt_pk_bf16_f32 %0, %1, %2" : "=v"(r) : "v"(lo), "v"(hi)); return r;
}
__device__ __forceinline__ float lo2f(uint32_t w) { return __uint_as_float(w << 16); }
__device__ __forceinline__ float hi2f(uint32_t w) { return __uint_as_float(w & 0xffff0000u); }
__device__ __forceinline__ float sigmoidf_(float x) { return __builtin_amdgcn_rcpf(1.0f + __expf(-x)); }
__device__ __forceinline__ float gelu_tanh(float x) { return x * sigmoidf_(1.5957691216f * (x + 0.044715f * x * x * x)); }
__device__ __forceinline__ int lds_off(int row, int ch) { return row * 128 + ((ch ^ ((row >> 1) & 7)) << 4); }

__device__ void conv_job(const float* __restrict__ src, int K, int Nsrc, int col0, int ncols, bf16_t* __restrict__ dst, int drow0, float* lt, int b0, int bs, int mode = 0) {
  const int tid = TIDX;
  const int kt = K >> 6, nt = (ncols + 63) >> 6;
  for (int tile = b0; tile < kt * nt; tile += bs) {
    const int tk = tile % kt, tn = tile / kt;
    const int nl = tid & 63, kl = tid >> 6;
    const int n = tn * 64 + nl;
#pragma unroll
    for (int i = 0; i < 16; ++i) {
      const int k = kl + 4 * i;
      int sc = col0 + n;
      if (mode == 1) { const int t = n >> 7, r = n & 127, wc = r >> 6, nn = (r & 63) >> 4, ii = r & 15; sc = ((nn < 2) ? 0 : DFF) + t * 64 + wc * 32 + (nn & 1) * 16 + ii; }
      float v = (n < ncols) ? src[(size_t)(tk * 64 + k) * Nsrc + sc] : 0.f;
      lt[nl * 65 + k] = v;
    }
    __syncthreads();
    const int k8 = (tid & 7) * 8, n2 = tid >> 3;
#pragma unroll
    for (int i = 0; i < 2; ++i) {
      const int nn = n2 + 32 * i;
      if (tn * 64 + nn < ncols) {
        const float* r = lt + nn * 65 + k8;
        uint4 w;
        w.x = pack2(r[0], r[1]); w.y = pack2(r[2], r[3]); w.z = pack2(r[4], r[5]); w.w = pack2(r[6], r[7]);
        *(uint4*)(dst + (size_t)(drow0 + tn * 64 + nn) * (K + 64) + tk * 64 + k8) = w;
      }
    }
    __syncthreads();
  }
}

__device__ void phase_convert(const Params& P, int layer, char* smem) {
  float* lt = (float*)smem;
  const int b0 = BIDX, bs = gridDim.x;
  const float* w_in = P.in[2] + (size_t)layer * DM * NIN;
  conv_job(w_in, DM, NIN, 0, 3328, P.Wt_in, 0, lt, b0, bs);
  conv_job(w_in, DM, NIN, 3352, 3072, P.Wt_in, ZC_MIX, lt, b0, bs);
  conv_job(w_in, DM, NIN, 3328, 24, P.Wt_in, ZC_NG, lt, b0, bs);
  conv_job(P.in[17] + (size_t)(layer * 2 + 0) * 2048 * 256, 2048, 256, 0, 256, P.Wt_c1, 0, lt, b0, bs);
  conv_job(P.in[17] + (size_t)(layer * 2 + 1) * 2048 * 256, 2048, 256, 0, 256, P.Wt_c1, 256, lt, b0, bs);
}
__device__ void phase_convert_late(const Params& P, int layer, char* smem, int b0, int bs) {
  float* lt = (float*)smem;
  conv_job(P.in[11] + (size_t)layer * 512 * 2048, 512, 2048, 0, 2048, P.Wt_glu, 0, lt, b0, bs);
  conv_job(P.in[13] + (size_t)layer * 512 * 1024, 512, 1024, 0, 1024, P.Wt_conv, 0, lt, b0, bs);
  conv_job(P.in[19] + (size_t)layer * 512 * 1024, 512, 1024, 0, 1024, P.Wt_o, 0, lt, b0, bs);
  conv_job(P.in[20] + (size_t)layer * 1024 * 1024, 1024, 1024, 0, 1024, P.Wt_out, 0, lt, b0, bs);
  conv_job(P.in[22] + (size_t)layer * 1024 * 5632, 1024, 5632, 0, 5632, P.Wt_gu, 0, lt, b0, bs, 1);
  conv_job(P.in[23] + (size_t)layer * DFF * 1024, DFF, 1024, 0, 1024, P.Wt_down, 0, lt, b0, bs);
}

__device__ void phase_rmsnorm(const float* __restrict__ xin, float* __restrict__ xcopy, const float* __restrict__ g, bf16_t* __restrict__ out) {
  const int lane = TIDX & 63, wave = TIDX >> 6;
#pragma unroll 2
  for (int tok = BIDX * 4 + wave; tok < T_TOK; tok += gridDim.x * 4) {
    const float4* xr = (const float4*)(xin + (size_t)tok * DM);
    float4 v[4];
    float ss = 0.f;
#pragma unroll
    for (int i = 0; i < 4; ++i) { v[i] = xr[lane + 64 * i]; ss += v[i].x * v[i].x + v[i].y * v[i].y + v[i].z * v[i].z + v[i].w * v[i].w; }
#pragma unroll
    for (int o = 32; o >= 1; o >>= 1) ss += __shfl_xor(ss, o);
    const float r = rsqrtf(ss * (1.0f / DM) + RMS_EPS);
    if (xcopy) {
      float4* xc = (float4*)(xcopy + (size_t)tok * DM);
#pragma unroll
      for (int i = 0; i < 4; ++i) xc[lane + 64 * i] = v[i];
    }
#pragma unroll
    for (int i = 0; i < 4; ++i) {
      const float4 gg = ((const float4*)g)[lane + 64 * i];
      uint2 w; w.x = pack2(v[i].x * r * gg.x, v[i].y * r * gg.y); w.y = pack2(v[i].z * r * gg.z, v[i].w * r * gg.w);
      *(uint2*)(out + (size_t)tok * LDH + (lane + 64 * i) * 4) = w;
    }
  }
}

template <bool A_GATHER = false>
__device__ __forceinline__ void gemm_main(const bf16_t* __restrict__ A, size_t lda, const bf16_t* __restrict__ Bt, int ldb, int K, f32x4 (&acc)[4][4], char* smem, size_t kstepA = 64) {
  const int tid = TIDX, lane = tid & 63, wave = tid >> 6, wr = wave >> 1, wc = wave & 1, l15 = lane & 15, q4 = lane >> 4;
  const int lrow = tid >> 3, lch = tid & 7;
  const bf16_t* ap = A_GATHER ? A : A + (size_t)lrow * lda + lch * 8;
  const bf16_t* bp = Bt + (size_t)lrow * ldb + lch * 8;
  const size_t sa = A_GATHER ? lda : (size_t)32 * lda, sb = (size_t)32 * ldb;
  typedef unsigned u32x4 __attribute__((ext_vector_type(4)));
  u32x4 ra0, ra1, ra2, ra3, rb0, rb1, rb2, rb3;
  u32x4 rc0, rc1, rc2, rc3, rd0, rd1, rd2, rd3;
  int nk = K >> 6;
  asm volatile("" : "+s"(nk));
  const int st_off = lds_off(lrow, lch);
  const int sw = (l15 >> 1) & 7;
  const int fr0 = l15 * 128 + (((q4 ^ (sw & 3)) << 4) | ((sw >> 2) << 6));
  const int a_off = wr * 8192 + fr0, b_off = 16384 + wc * 8192 + fr0;
#ifndef EXP_GL
#define EXP_GL 0
#endif
#ifndef EXP_LDSW
#define EXP_LDSW 0
#endif
#if EXP_GL
#define GLQ const volatile u32x4*
#define GLREP 2
#else
#define GLQ const u32x4*
#define GLREP 1
#endif
#if EXP_LDSW == 1
#define LSQ volatile u32x4*
#define LSREP 2
#else
#define LSQ u32x4*
#define LSREP 1
#endif
#define GLOAD0(AP, BP) do { for (int rep_ = 0; rep_ < GLREP; ++rep_) { ra0 = *(GLQ)(AP); ra1 = *(GLQ)((AP) + sa); ra2 = *(GLQ)((AP) + 2 * sa); ra3 = *(GLQ)((AP) + 3 * sa); \
                            rb0 = *(GLQ)(BP); rb1 = *(GLQ)((BP) + sb); rb2 = *(GLQ)((BP) + 2 * sb); rb3 = *(GLQ)((BP) + 3 * sb); } } while (0)
#define GLOAD1(AP, BP) do { for (int rep_ = 0; rep_ < GLREP; ++rep_) { rc0 = *(GLQ)(AP); rc1 = *(GLQ)((AP) + sa); rc2 = *(GLQ)((AP) + 2 * sa); rc3 = *(GLQ)((AP) + 3 * sa); \
                            rd0 = *(GLQ)(BP); rd1 = *(GLQ)((BP) + sb); rd2 = *(GLQ)((BP) + 2 * sb); rd3 = *(GLQ)((BP) + 3 * sb); } } while (0)
#define XW(P_, V_) asm volatile("ds_write_b128 %0, %1" :: "v"((unsigned)(size_t)(P_)), "v"(V_) : "memory")
#if EXP_LDSW == 2
#define XDUP0(PS) do { XW((PS), ra0); XW((PS) + 4096, ra1); XW((PS) + 8192, ra2); XW((PS) + 12288, ra3); XW((PS) + 16384, rb0); XW((PS) + 20480, rb1); XW((PS) + 24576, rb2); XW((PS) + 28672, rb3); } while (0)
#define XDUP1(PS) do { XW((PS), rc0); XW((PS) + 4096, rc1); XW((PS) + 8192, rc2); XW((PS) + 12288, rc3); XW((PS) + 16384, rd0); XW((PS) + 20480, rd1); XW((PS) + 24576, rd2); XW((PS) + 28672, rd3); } while (0)
#else
#define XDUP0(PS) do { } while (0)
#define XDUP1(PS) do { } while (0)
#endif
#define LSTORE0(PS) do { XDUP0(PS); for (int rep_ = 0; rep_ < LSREP; ++rep_) { *(LSQ)(PS) = ra0; *(LSQ)((PS) + 4096) = ra1; *(LSQ)((PS) + 8192) = ra2; *(LSQ)((PS) + 12288) = ra3; \
                         *(LSQ)((PS) + 16384) = rb0; *(LSQ)((PS) + 20480) = rb1; *(LSQ)((PS) + 24576) = rb2; *(LSQ)((PS) + 28672) = rb3; } } while (0)
#define LSTORE1(PS) do { XDUP1(PS); for (int rep_ = 0; rep_ < LSREP; ++rep_) { *(LSQ)(PS) = rc0; *(LSQ)((PS) + 4096) = rc1; *(LSQ)((PS) + 8192) = rc2; *(LSQ)((PS) + 12288) = rc3; \
                         *(LSQ)((PS) + 16384) = rd0; *(LSQ)((PS) + 20480) = rd1; *(LSQ)((PS) + 24576) = rd2; *(LSQ)((PS) + 28672) = rd3; } } while (0)
#define COMPUTE(BO) do { _Pragma("unroll") for (int ks = 0; ks < 2; ++ks) { \
      bf16x8 af[4], bfr[4]; \
      const char* pa = smem + (BO) + (a_off ^ (ks * 64)); \
      const char* pb = smem + (BO) + (b_off ^ (ks * 64)); \
      _Pragma("unroll") for (int m = 0; m < 4; ++m) af[m] = *(const bf16x8*)(pa + m * 2048); \
      _Pragma("unroll") for (int n = 0; n < 4; ++n) bfr[n] = *(const bf16x8*)(pb + n * 2048); \
      _Pragma("unroll") for (int m = 0; m < 4; ++m) \
        _Pragma("unroll") for (int n = 0; n < 4; ++n) acc[m][n] = __builtin_amdgcn_mfma_f32_16x16x32_bf16(bfr[n], af[m], acc[m][n], 0, 0, 0); } } while (0)
  GLOAD0(ap, bp);
  GLOAD1(ap + kstepA, bp + 64);
  LSTORE0(smem + st_off);
  __syncthreads();
#pragma nounroll
  for (int kt = 0; kt < nk; kt += 2) {
    { const int t2 = (kt + 2 < nk) ? kt + 2 : nk - 1; const bf16_t* ap2 = ap + t2 * kstepA; const bf16_t* bp2 = bp + t2 * 64; GLOAD0(ap2, bp2); }
    __builtin_amdgcn_sched_barrier(0);
    COMPUTE(0);
    LSTORE1(smem + 32768 + st_off);
    __syncthreads();
    { const int t3 = (kt + 3 < nk) ? kt + 3 : nk - 1; const bf16_t* ap2 = ap + t3 * kstepA; const bf16_t* bp2 = bp + t3 * 64; GLOAD1(ap2, bp2); }
    __builtin_amdgcn_sched_barrier(0);
    COMPUTE(32768);
    LSTORE0(smem + st_off);
    __syncthreads();
  }
#undef GLOAD0
#undef GLOAD1
#undef LSTORE0
#undef LSTORE1
#undef COMPUTE
#undef GLQ
#undef LSQ
#undef GLREP
#undef LSREP
}

__device__ __forceinline__ void gemm_main_shallow(const bf16_t* __restrict__ A, int lda, const bf16_t* __restrict__ Bt, int ldb, int K, f32x4 (&acc)[4][4], char* smem) {
  const int tid = TIDX, lane = tid & 63, wave = tid >> 6, wr = wave >> 1, wc = wave & 1, l15 = lane & 15, q4 = lane >> 4;
  const int lrow = tid >> 3, lch = tid & 7;
  const bf16_t* ap = A + (size_t)lrow * lda + lch * 8;
  const bf16_t* bp = Bt + (size_t)lrow * ldb + lch * 8;
  const size_t sa = (size_t)32 * lda, sb = (size_t)32 * ldb;
  uint4 ra0, ra1, ra2, ra3, rb0, rb1, rb2, rb3;
  int nk = K >> 6;
  asm volatile("" : "+s"(nk));
  const int st_off = lds_off(lrow, lch);
  const int sw = (l15 >> 1) & 7;
  const int fr0 = l15 * 128 + (((q4 ^ (sw & 3)) << 4) | ((sw >> 2) << 6));
  const int a_off = wr * 8192 + fr0, b_off = 16384 + wc * 8192 + fr0;
#define GLOAD(AP, BP) do { ra0 = *(const uint4*)(AP); ra1 = *(const uint4*)((AP) + sa); ra2 = *(const uint4*)((AP) + 2 * sa); ra3 = *(const uint4*)((AP) + 3 * sa); \
                           rb0 = *(const uint4*)(BP); rb1 = *(const uint4*)((BP) + sb); rb2 = *(const uint4*)((BP) + 2 * sb); rb3 = *(const uint4*)((BP) + 3 * sb); } while (0)
#define LSTORE(PS) do { *(uint4*)(PS) = ra0; *(uint4*)((PS) + 4096) = ra1; *(uint4*)((PS) + 8192) = ra2; *(uint4*)((PS) + 12288) = ra3; \
                        *(uint4*)((PS) + 16384) = rb0; *(uint4*)((PS) + 20480) = rb1; *(uint4*)((PS) + 24576) = rb2; *(uint4*)((PS) + 28672) = rb3; } while (0)
  GLOAD(ap, bp);
  LSTORE(smem + st_off);
  __syncthreads();
#pragma nounroll
  for (int kt = 0; kt < nk; ++kt) {
    const int bo = (kt & 1) * 32768;
    const bool more = kt + 1 < nk;
    if (more) { const bf16_t* ap2 = ap + (kt + 1) * 64; const bf16_t* bp2 = bp + (kt + 1) * 64; GLOAD(ap2, bp2); }
#pragma unroll
    for (int ks = 0; ks < 2; ++ks) {
      bf16x8 af[4], bfr[4];
      const char* pa = smem + bo + (a_off ^ (ks * 64));
      const char* pb = smem + bo + (b_off ^ (ks * 64));
#pragma unroll
      for (int m = 0; m < 4; ++m) af[m] = *(const bf16x8*)(pa + m * 2048);
#pragma unroll
      for (int n = 0; n < 4; ++n) bfr[n] = *(const bf16x8*)(pb + n * 2048);
#pragma unroll
      for (int m = 0; m < 4; ++m)
#pragma unroll
        for (int n = 0; n < 4; ++n) acc[m][n] = __builtin_amdgcn_mfma_f32_16x16x32_bf16(bfr[n], af[m], acc[m][n], 0, 0, 0);
    }
    if (more) { char* ps = smem + (bo ^ 32768) + st_off; LSTORE(ps); }
    __syncthreads();
  }
#undef GLOAD
#undef LSTORE
}

__device__ __forceinline__ void zero_acc(f32x4 (&acc)[4][4]) {
#pragma unroll
  for (int m = 0; m < 4; ++m)
#pragma unroll
    for (int n = 0; n < 4; ++n) acc[m][n] = (f32x4){0.f, 0.f, 0.f, 0.f};
}
__device__ __forceinline__ bool tile_coords(int u, int nN, int& tm, int& tn) {
  const int nfull = nN >> 3, full = nfull * 1024, xcd = u & 7;
  if (u < full) {
    const int loc = u >> 3, sb = loc >> 6, mi = loc & 7, ni = (loc >> 3) & 7;
    tm = xcd * 16 + (sb & 1) * 8 + mi; tn = (sb >> 1) * 8 + ni;
    return true;
  }
  const int loc = (u - full) >> 3;
  tm = xcd * 16 + (loc & 15); tn = nfull * 8 + (loc >> 4);
  return (loc >> 4) < (nN & 7);
}
__device__ __forceinline__ int tile_slots(int nN) { return 1024 * (nN >> 3) + ((nN & 7) ? 512 : 0); }
#define EPI_SETUP const int lane_ = TIDX & 63, wave_ = TIDX >> 6; const int rbase = tm * 128 + (wave_ >> 1) * 64 + (lane_ & 15); const int cbase = tn * 128 + (wave_ & 1) * 64 + (lane_ >> 4) * 4;

__device__ void phase_gemm_in(const Params& P, int layer, char* smem) {
  for (int u = BIDX; u < tile_slots(51); u += gridDim.x) {
    int tm, tn; if (!tile_coords(u, 51, tm, tn)) continue;
    f32x4 acc[4][4]; zero_acc(acc);
    gemm_main(P.hbuf + (size_t)tm * 128 * LDH, LDH, P.Wt_in + (size_t)tn * 128 * LDH, LDH, DM, acc, smem);
    EPI_SETUP
    const bool is_gate = (tn >= ZC_MIX / 128) && (tn < ZC_NG / 128);
#pragma unroll
    for (int m = 0; m < 4; ++m)
#pragma unroll
      for (int n = 0; n < 4; ++n) {
        const int row = rbase + m * 16, col = cbase + n * 16;
        f32x4 v = acc[m][n];
        if (is_gate) { v[0] = sigmoidf_(v[0]); v[1] = sigmoidf_(v[1]); v[2] = sigmoidf_(v[2]); v[3] = sigmoidf_(v[3]); }
        uint2 w; w.x = pack2(v[0], v[1]); w.y = pack2(v[2], v[3]);
        *(uint2*)(smem + (row - tm * 128) * 272 + (col - tn * 128) * 2) = w;
      }
    __syncthreads();
    const int tid = TIDX;
    const bool t_q = (tn >= ZC_Q / 128) && (tn < ZC_KC / 128), t_ks = (tn == ZC_KS / 128), t_kw = (tn == ZC_KW / 128);
    const bool t_vs = (tn == ZC_VS / 128), t_vw = (tn == ZC_VW / 128);
    if (t_q || t_ks || t_kw) {
      const int r = tid >> 1, hh = tid & 1;
      const float* gp = t_q ? (P.in[14] + (size_t)layer * 64) : (P.in[15] + (size_t)layer * 3 * 64 + (t_ks ? 64 : 128));
      const float gs = t_q ? (0.125f * 1.44269504089f) : 1.0f;
      float f[64];
      float ss = 0.f;
#pragma unroll
      for (int j = 0; j < 8; ++j) {
        const uint4 w = *(const uint4*)(smem + r * 272 + hh * 128 + j * 16);
        f[j * 8 + 0] = lo2f(w.x); f[j * 8 + 1] = hi2f(w.x); f[j * 8 + 2] = lo2f(w.y); f[j * 8 + 3] = hi2f(w.y);
        f[j * 8 + 4] = lo2f(w.z); f[j * 8 + 5] = hi2f(w.z); f[j * 8 + 6] = lo2f(w.w); f[j * 8 + 7] = hi2f(w.w);
      }
#pragma unroll
      for (int j = 0; j < 64; ++j) ss += f[j] * f[j];
      const float rn = rsqrtf(ss * (1.0f / 64.f) + RMS_EPS) * gs;
      const int tok = tm * 128 + r;
      bf16_t* dst;
      if (t_q) dst = P.qn + (size_t)tok * 512 + ((tn - ZC_Q / 128) * 2 + hh) * 64;
      else dst = (t_ks ? P.ksn : P.kwn) + ((size_t)((tok >> 12) * 2 + hh) * SEQL + (tok & 4095)) * 64;
#pragma unroll
      for (int j = 0; j < 8; ++j) {
        uint4 w;
        w.x = pack2(f[j * 8 + 0] * rn * gp[j * 8 + 0], f[j * 8 + 1] * rn * gp[j * 8 + 1]); w.y = pack2(f[j * 8 + 2] * rn * gp[j * 8 + 2], f[j * 8 + 3] * rn * gp[j * 8 + 3]);
        w.z = pack2(f[j * 8 + 4] * rn * gp[j * 8 + 4], f[j * 8 + 5] * rn * gp[j * 8 + 5]); w.w = pack2(f[j * 8 + 6] * rn * gp[j * 8 + 6], f[j * 8 + 7] * rn * gp[j * 8 + 7]);
        *(uint4*)(dst + j * 8) = w;
      }
    } else if (t_vs || t_vw) {
      const int col = tid >> 1, hh = tid & 1;
      const int tok0 = tm * 128 + hh * 64;
      bf16_t* dst = (t_vs ? P.vsT : P.vwT) + ((size_t)((tok0 >> 12) * 2) * 64 + col) * LDV + (tok0 & 4095);
#pragma unroll
      for (int j = 0; j < 8; ++j) {
        unsigned short e[8];
#pragma unroll
        for (int i = 0; i < 8; ++i) e[i] = *(const unsigned short*)(smem + (hh * 64 + j * 8 + i) * 272 + col * 2);
        uint4 w;
        w.x = (unsigned)e[0] | ((unsigned)e[1] << 16); w.y = (unsigned)e[2] | ((unsigned)e[3] << 16);
        w.z = (unsigned)e[4] | ((unsigned)e[5] << 16); w.w = (unsigned)e[6] | ((unsigned)e[7] << 16);
        *(uint4*)(dst + j * 8) = w;
      }
    } else {
#pragma unroll
      for (int i = 0; i < 8; ++i) {
        const int id = tid + 256 * i, r = id >> 4, c16 = id & 15;
        const uint4 v = *(const uint4*)(smem + r * 272 + c16 * 16);
        *(uint4*)(P.z + (size_t)(tm * 128 + r) * ZLD + tn * 128 + c16 * 8) = v;
      }
    }
    __syncthreads();
  }
}
__device__ void phase_gemm_resid(const Params& P, const bf16_t* A, int lda, const bf16_t* Bt, int K, char* smem, float alpha = 1.0f) {
  for (int u = BIDX; u < tile_slots(8); u += gridDim.x) {
    int tm, tn; if (!tile_coords(u, 8, tm, tn)) continue;
    f32x4 acc[4][4]; zero_acc(acc);
    gemm_main(A + (size_t)tm * 128 * lda, lda, Bt + (size_t)tn * 128 * (K + 64), K + 64, K, acc, smem);
    EPI_SETUP
#pragma unroll
    for (int m = 0; m < 4; ++m)
#pragma unroll
      for (int n = 0; n < 4; ++n) {
        const int row = rbase + m * 16, col = cbase + n * 16;
        float4* p = (float4*)(P.x + (size_t)row * DM + col);
        float4 v = *p;
        v.x += alpha * acc[m][n][0]; v.y += alpha * acc[m][n][1]; v.z += alpha * acc[m][n][2]; v.w += alpha * acc[m][n][3];
        *p = v;
      }
  }
}
__device__ void phase_gemm_gateup(const Params& P, char* smem) {
  bf16_t* act = P.z;
  for (int u = BIDX; u < tile_slots(44); u += gridDim.x) {
    int tm, tn; if (!tile_coords(u, 44, tm, tn)) continue;
    f32x4 acc[4][4]; zero_acc(acc);
    gemm_main(P.hbuf + (size_t)tm * 128 * LDH, LDH, P.Wt_gu + (size_t)tn * 128 * LDH, LDH, DM, acc, smem);
    const int lane_ = TIDX & 63, wave_ = TIDX >> 6;
    const int rbase = tm * 128 + (wave_ >> 1) * 64 + (lane_ & 15);
    const int cbase = tn * 64 + (wave_ & 1) * 32 + (lane_ >> 4) * 4;
#pragma unroll
    for (int m = 0; m < 4; ++m)
#pragma unroll
      for (int n = 0; n < 2; ++n) {
        const int row = rbase + m * 16, col = cbase + n * 16;
        float o[4];
#pragma unroll
        for (int r = 0; r < 4; ++r) { const float gq = acc[m][n][r]; o[r] = gq * sigmoidf_(gq) * acc[m][n + 2][r]; }
        uint2 w; w.x = pack2(o[0], o[1]); w.y = pack2(o[2], o[3]);
        *(uint2*)(smem + (row - tm * 128) * 144 + (col - tn * 64) * 2) = w;
      }
    __syncthreads();
    {
      const int tid = TIDX;
#pragma unroll
      for (int i = 0; i < 4; ++i) {
        const int id = tid + 256 * i, r = id >> 3, c8 = id & 7;
        const uint4 v = *(const uint4*)(smem + r * 144 + c8 * 16);
        *(uint4*)(act + (size_t)(tm * 128 + r) * LDA + tn * 64 + c8 * 8) = v;
      }
    }
    __syncthreads();
  }
}
__device__ void phase_gemm_cmp1(const Params& P, char* smem, int u0, int ustride) {
  float* hidp = (float*)P.acmp;
  for (int u = u0; u < 128; u += ustride) {
    const int kq = u & 3, r5 = u >> 2, which = r5 >> 4, rem = r5 & 15, tm = rem & 7, tn = rem >> 3;
    f32x4 acc[4][4]; zero_acc(acc);
    const int tid = TIDX, lrow = tid >> 3, lch = tid & 7;
    const bf16_t* ap = P.z + ((size_t)(tm * 64 + (lrow >> 1)) * 32 + kq * 8) * ZLD + (which ? ZC_VC : ZC_KC) + (lrow & 1) * 64 + lch * 8;
    gemm_main<true>(ap, (size_t)512 * ZLD, P.Wt_c1 + (size_t)which * 256 * LDC + (size_t)tn * 128 * LDC + kq * 512, LDC, 512, acc, smem, (size_t)ZLD);
    EPI_SETUP
#pragma unroll
    for (int m = 0; m < 4; ++m)
#pragma unroll
      for (int n = 0; n < 4; ++n) {
        const int row = rbase + m * 16, col = cbase + n * 16;
        *(f32x4*)(hidp + ((size_t)(kq * 2 + which) * 1024 + row) * 256 + col) = acc[m][n];
      }
  }
}
__device__ void phase_cmp_bias(const Params& P, int layer) {
  const int lane = TIDX & 63, wave = TIDX >> 6;
  for (int o = BIDX * 4 + wave; o < 512; o += gridDim.x * 4) {
    const int which = o >> 8, col = o & 255;
    const float* pe = P.in[16] + (size_t)(layer * 2 + which) * 2048;
    const float* w1 = P.in[17] + (size_t)(layer * 2 + which) * 2048 * 256 + col;
    float acc = 0.f;
    for (int k = lane; k < 2048; k += 64) acc += pe[k] * w1[(size_t)k * 256];
#pragma unroll
    for (int o2 = 32; o2 >= 1; o2 >>= 1) acc += __shfl_xor(acc, o2);
    if (lane == 0) P.cbias[o] = acc;
  }
}
__device__ __forceinline__ void merge_stage_gates(const bf16_t* __restrict__ zg, int tm, int tn, char* smem) {
  const int tid = TIDX;
#pragma unroll
  for (int i = 0; i < 8; ++i) {
    const int id = tid + 256 * i, r = id >> 4, c16 = id & 15;
    *(uint4*)(smem + r * 272 + c16 * 16) = *(const uint4*)(zg + (size_t)(tm * 128 + r) * ZLD + tn * 128 + c16 * 8);
  }
}
__device__ void phase_merge(const Params& P, char* smem) {
  for (int u = BIDX; u < tile_slots(8); u += gridDim.x) {
    int tm, tn; if (!tile_coords(u, 8, tm, tn)) continue;
    const int lane_ = TIDX & 63, wave_ = TIDX >> 6;
    const int loff = ((wave_ >> 1) * 64 + (lane_ & 15)) * 272 + ((wave_ & 1) * 64 + (lane_ >> 4) * 4) * 2;
    uint2 hreg[4][4];
    {
      f32x4 a0[4][4], a1[4][4]; zero_acc(a0); zero_acc(a1);
      gemm_main_shallow(P.ys + (size_t)tm * 128 * LD5, LD5, P.Wt_glu + (size_t)tn * 128 * LD5, LD5, 512, a0, smem);
      gemm_main_shallow(P.ys + (size_t)tm * 128 * LD5, LD5, P.Wt_glu + (size_t)(1024 + tn * 128) * LD5, LD5, 512, a1, smem);
      merge_stage_gates(P.z + ZC_MIX, tm, tn, smem);
      __syncthreads();
#pragma unroll
      for (int m = 0; m < 4; ++m)
#pragma unroll
        for (int n = 0; n < 4; ++n) {
          const uint2 gw = *(const uint2*)(smem + loff + m * 16 * 272 + n * 32);
          hreg[m][n].x = pack2(lo2f(gw.x) * a0[m][n][0] * sigmoidf_(a1[m][n][0]), hi2f(gw.x) * a0[m][n][1] * sigmoidf_(a1[m][n][1]));
          hreg[m][n].y = pack2(lo2f(gw.y) * a0[m][n][2] * sigmoidf_(a1[m][n][2]), hi2f(gw.y) * a0[m][n][3] * sigmoidf_(a1[m][n][3]));
        }
      __syncthreads();
    }
    int nbr = 3;
    asm volatile("" : "+s"(nbr));
    for (int br = 1; br < nbr; ++br) {
      f32x4 a1[4][4]; zero_acc(a1);
      const bf16_t* A = (br == 1) ? P.cv : P.ob;
      const bf16_t* B = (br == 1) ? P.Wt_conv : P.Wt_o;
      gemm_main_shallow(A + (size_t)tm * 128 * LD5, LD5, B + (size_t)tn * 128 * LD5, LD5, 512, a1, smem);
      merge_stage_gates(P.z + ZC_MIX + br * 1024, tm, tn, smem);
      __syncthreads();
#pragma unroll
      for (int m = 0; m < 4; ++m)
#pragma unroll
        for (int n = 0; n < 4; ++n) {
          const uint2 gw = *(const uint2*)(smem + loff + m * 16 * 272 + n * 32);
          const uint2 hv = hreg[m][n];
          hreg[m][n].x = pack2(lo2f(hv.x) + lo2f(gw.x) * a1[m][n][0], hi2f(hv.x) + hi2f(gw.x) * a1[m][n][1]);
          hreg[m][n].y = pack2(lo2f(hv.y) + lo2f(gw.y) * a1[m][n][2], hi2f(hv.y) + hi2f(gw.y) * a1[m][n][3]);
        }
      __syncthreads();
    }
#pragma unroll
    for (int m = 0; m < 4; ++m)
#pragma unroll
      for (int n = 0; n < 4; ++n) *(uint2*)(smem + loff + m * 16 * 272 + n * 32) = hreg[m][n];
    __syncthreads();
    {
      const int tid = TIDX;
#pragma unroll
      for (int i = 0; i < 8; ++i) {
        const int id = tid + 256 * i, r = id >> 4, c16 = id & 15;
        *(uint4*)(P.hbuf + (size_t)(tm * 128 + r) * LDH + tn * 128 + c16 * 8) = *(const uint4*)(smem + r * 272 + c16 * 16);
      }
    }
    __syncthreads();
  }
}

__device__ void s5_unit(const Params& P, int layer, int unit, char* smem) {
  const int b = unit >> 5, g = unit & 31;
  const int tid = TIDX, lane = tid & 63, w = tid >> 6, l15 = lane & 15, q4 = lane >> 4;
  const int p = lane, q = w;
  float* bu = (float*)smem;
  bf16_t* stb = (bf16_t*)(smem + 33280);
  float2* send = (float2*)(smem + 33280 + 17408);
  bf16_t* usb = (bf16_t*)(smem + 33280 + 17408 + 2048);
  const float* lam_re = P.in[3] + (size_t)layer * 32 * 64 + g * 64, *lam_im = P.in[4] + (size_t)layer * 32 * 64 + g * 64;
  const float* b_re = P.in[5] + ((size_t)layer * 32 + g) * 64 * 16, *b_im = P.in[6] + ((size_t)layer * 32 + g) * 64 * 16;
  const float* c_re = P.in[7] + ((size_t)layer * 32 + g) * 16 * 64, *c_im = P.in[8] + ((size_t)layer * 32 + g) * 16 * 64;
  const float dk = P.in[9][(size_t)layer * 512 + g * 16 + l15];
  const float dt = expf(P.in[10][layer * 32 + g]);
  float lbr, lbi, l16r, l16i;
  {
    const float lr = lam_re[p], li = lam_im[p];
    float sn, cs_; sincosf(li * dt, &sn, &cs_);
    const float e = expf(lr * dt);
    lbr = e * cs_; lbi = e * sn;
    l16r = lbr; l16i = lbi;
#pragma unroll
    for (int i = 0; i < 4; ++i) { const float tr = l16r * l16r - l16i * l16i, ti = 2.f * l16r * l16i; l16r = tr; l16i = ti; }
  }
  bf16x8 bB[2];
#pragma unroll
  for (int nt = 0; nt < 2; ++nt) {
    const int pp = (2 * w + nt) * 16 + l15, ps = pp >> 1, cpl = pp & 1;
    const float lr = lam_re[ps], li = lam_im[ps];
    float sn, cs_; sincosf(li * dt, &sn, &cs_);
    const float e = expf(lr * dt);
    const float nr = e * cs_ - 1.0f, ni = e * sn, den = lr * lr + li * li;
    const float cfr = (nr * lr + ni * li) / den, cfi = (ni * lr - nr * li) / den;
    float v[8];
#pragma unroll
    for (int j = 0; j < 8; ++j) {
      const int h = (q4 & 1) * 8 + j;
      const float br = b_re[ps * 16 + h], bi = b_im[ps * 16 + h];
      const float val = cpl ? (cfr * bi + cfi * br) : (cfr * br - cfi * bi);
      v[j] = (q4 < 2) ? val : 0.f;
    }
    union { uint32_t u[4]; bf16x8 x; } cv; cv.u[0] = pack2(v[0], v[1]); cv.u[1] = pack2(v[2], v[3]); cv.u[2] = pack2(v[4], v[5]); cv.u[3] = pack2(v[6], v[7]);
    bB[nt] = cv.x;
  }
  bf16x8 cB[4];
#pragma unroll
  for (int ks = 0; ks < 4; ++ks) {
    float v[8];
#pragma unroll
    for (int j = 0; j < 8; ++j) {
      const int pp = ks * 32 + q4 * 8 + j, ps = pp >> 1;
      v[j] = (pp & 1) ? -c_im[l15 * 64 + ps] : c_re[l15 * 64 + ps];
    }
    union { uint32_t u[4]; bf16x8 x; } cv; cv.u[0] = pack2(v[0], v[1]); cv.u[1] = pack2(v[2], v[3]); cv.u[2] = pack2(v[4], v[5]); cv.u[3] = pack2(v[6], v[7]);
    cB[ks] = cv.x;
  }
  float car_r = 0.f, car_i = 0.f;
  bf16x8 un0, un1, un2, un3;
  {
    const bf16_t* zp = P.z + ((size_t)b * SEQL + l15) * ZLD + ZC_U + g * 16 + (q4 & 1) * 8;
    un0 = *(const bf16x8*)(zp); un1 = *(const bf16x8*)(zp + (size_t)16 * ZLD); un2 = *(const bf16x8*)(zp + (size_t)32 * ZLD); un3 = *(const bf16x8*)(zp + (size_t)48 * ZLD);
  }
  for (int chunk = 0; chunk < 64; ++chunk) {
    const size_t tok0 = (size_t)b * SEQL + chunk * 64;
    {
      bf16x8 ua[4];
      const bf16x8 zz = (bf16x8){0, 0, 0, 0, 0, 0, 0, 0};
      ua[0] = (q4 < 2) ? un0 : zz; ua[1] = (q4 < 2) ? un1 : zz; ua[2] = (q4 < 2) ? un2 : zz; ua[3] = (q4 < 2) ? un3 : zz;
      if (w == 0 && q4 < 2) {
#pragma unroll
        for (int mt = 0; mt < 4; ++mt) *(bf16x8*)(usb + (chunk & 1) * 1024 + (mt * 16 + l15) * 16 + q4 * 8) = ua[mt];
      }
      if (chunk + 1 < 64) {
        const bf16_t* zp = P.z + (tok0 + 64 + l15) * ZLD + ZC_U + g * 16 + (q4 & 1) * 8;
        un0 = *(const bf16x8*)(zp); un1 = *(const bf16x8*)(zp + (size_t)16 * ZLD); un2 = *(const bf16x8*)(zp + (size_t)32 * ZLD); un3 = *(const bf16x8*)(zp + (size_t)48 * ZLD);
      }
#pragma unroll
      for (int mt = 0; mt < 4; ++mt)
#pragma unroll
        for (int nt = 0; nt < 2; ++nt) {
          const f32x4 acc = __builtin_amdgcn_mfma_f32_16x16x32_bf16(ua[mt], bB[nt], (f32x4){0.f, 0.f, 0.f, 0.f}, 0, 0, 0);
          float* dst = bu + (mt * 16 + q4 * 4) * 130 + (2 * w + nt) * 16 + l15;
          dst[0] = acc[0]; dst[130] = acc[1]; dst[260] = acc[2]; dst[390] = acc[3];
        }
    }
    __syncthreads();
    float locr[16], loci[16];
    float sr = 0.f, si = 0.f;
#pragma unroll
    for (int i = 0; i < 16; ++i) {
      const float2 v = *(const float2*)(bu + (q * 16 + i) * 130 + 2 * p);
      const float nsr = lbr * sr - lbi * si + v.x, nsi = lbr * si + lbi * sr + v.y;
      sr = nsr; si = nsi; locr[i] = sr; loci[i] = si;
    }
    send[q * 64 + p] = make_float2(sr, si);
    __syncthreads();
    float cur_r = car_r, cur_i = car_i, mine_r = 0.f, mine_i = 0.f;
#pragma unroll
    for (int qq = 0; qq < 4; ++qq) {
      if (qq == q) { mine_r = cur_r; mine_i = cur_i; }
      const float2 ev = send[qq * 64 + p];
      const float tr = l16r * cur_r - l16i * cur_i + ev.x, ti = l16r * cur_i + l16i * cur_r + ev.y;
      cur_r = tr; cur_i = ti;
    }
    car_r = cur_r; car_i = cur_i;
    float cpr = lbr * mine_r - lbi * mine_i, cpi = lbr * mine_i + lbi * mine_r;
#pragma unroll
    for (int i = 0; i < 16; ++i) {
      *(uint32_t*)(stb + (q * 16 + i) * 136 + 2 * p) = pack2(locr[i] + cpr, loci[i] + cpi);
      const float tr = lbr * cpr - lbi * cpi, ti = lbr * cpi + lbi * cpr;
      cpr = tr; cpi = ti;
    }
    __syncthreads();
    {
      f32x4 acc = (f32x4){0.f, 0.f, 0.f, 0.f};
#pragma unroll
      for (int ks = 0; ks < 4; ++ks) {
        const bf16x8 as = *(const bf16x8*)(stb + (w * 16 + l15) * 136 + ks * 32 + q4 * 8);
        acc = __builtin_amdgcn_mfma_f32_16x16x32_bf16(as, cB[ks], acc, 0, 0, 0);
      }
#pragma unroll
      for (int r = 0; r < 4; ++r) {
        const size_t t = tok0 + w * 16 + q4 * 4 + r;
        const float uval = bf2f(usb[(chunk & 1) * 1024 + (w * 16 + q4 * 4 + r) * 16 + l15]);
        const float y = gelu_tanh(acc[r] + dk * uval);
        P.ys[t * LD5 + g * 16 + l15] = (bf16_t)(pack2(y, 0.f) & 0xffffu);
      }
    }
  }
}

__device__ __forceinline__ void load8(const bf16_t* p, float (&f)[8]) {
  const uint4 w = *(const uint4*)p;
  f[0] = lo2f(w.x); f[1] = hi2f(w.x); f[2] = lo2f(w.y); f[3] = hi2f(w.y); f[4] = lo2f(w.z); f[5] = hi2f(w.z); f[6] = lo2f(w.w); f[7] = hi2f(w.w);
}
__device__ __forceinline__ void store8(bf16_t* p, const float (&f)[8]) {
  uint4 w; w.x = pack2(f[0], f[1]); w.y = pack2(f[2], f[3]); w.z = pack2(f[4], f[5]); w.w = pack2(f[6], f[7]);
  *(uint4*)p = w;
}
__device__ void prep_unit(const Params& P, int layer, int ck, char* smem) {
  const int tid = TIDX;
  const int tok0 = ck * 64, b = tok0 >> 12, s0 = tok0 & 4095;
  const bf16_t* z = P.z;
  {
    const float* cw = P.in[12] + (size_t)layer * 3 * 512;
    const int c2 = tid * 2;
    const float w00 = cw[c2], w01 = cw[c2 + 1], w10 = cw[512 + c2], w11 = cw[512 + c2 + 1], w20 = cw[1024 + c2], w21 = cw[1024 + c2 + 1];
    float p2a = 0.f, p2b = 0.f, p1a = 0.f, p1b = 0.f;
    if (s0 >= 2) {
      const uint32_t cc2 = *(const uint32_t*)(z + (size_t)(tok0 - 2) * ZLD + ZC_CC + c2), cx2 = *(const uint32_t*)(z + (size_t)(tok0 - 2) * ZLD + ZC_CX + c2);
      const uint32_t cc1 = *(const uint32_t*)(z + (size_t)(tok0 - 1) * ZLD + ZC_CC + c2), cx1 = *(const uint32_t*)(z + (size_t)(tok0 - 1) * ZLD + ZC_CX + c2);
      p2a = lo2f(cc2) * lo2f(cx2); p2b = hi2f(cc2) * hi2f(cx2); p1a = lo2f(cc1) * lo2f(cx1); p1b = hi2f(cc1) * hi2f(cx1);
    }
#pragma unroll 8
    for (int t = 0; t < 64; ++t) {
      const size_t ro = (size_t)(tok0 + t) * ZLD;
      const uint32_t cb = *(const uint32_t*)(z + ro + ZC_CB + c2), cc = *(const uint32_t*)(z + ro + ZC_CC + c2), cx = *(const uint32_t*)(z + ro + ZC_CX + c2);
      const float p0a = lo2f(cc) * lo2f(cx), p0b = hi2f(cc) * hi2f(cx);
      const float oa = lo2f(cb) * (w00 * p2a + w10 * p1a + w20 * p0a), ob_ = hi2f(cb) * (w01 * p2b + w11 * p1b + w21 * p0b);
      *(uint32_t*)(P.cv + (size_t)(tok0 + t) * LD5 + c2) = pack2(oa, ob_);
      p2a = p1a; p2b = p1b; p1a = p0a; p1b = p0b;
    }
  }
}
__device__ void phase_prep(const Params& P, int layer, char* smem) {
  const int bid = BIDX;
  if (bid < 128) { phase_gemm_cmp1(P, smem, bid, 128); __syncthreads(); phase_convert_late(P, layer, smem, 128 + bid, 512); }
  else if (bid < 384) { prep_unit(P, layer, bid - 128, smem); __syncthreads(); phase_convert_late(P, layer, smem, 128 + bid, 512); }
  else phase_convert_late(P, layer, smem, bid - 384, 512);
}

__device__ void phase_cmp2(const Params& P, int layer, char* smem) {
  const int lane = TIDX & 63, wave = TIDX >> 6;
  const float* hidp = (const float*)P.acmp;
  float* hs = (float*)(smem + wave * 1024);
  for (int wu = BIDX * 4 + wave; wu < 2048; wu += gridDim.x * 4) {
    const int which = wu >> 10, row = wu & 1023;
    const float* w2 = P.in[18] + (size_t)(layer * 2 + which) * 256 * 64;
#pragma unroll
    for (int i = 0; i < 4; ++i) {
      const int k = lane + 64 * i;
      float sv = P.cbias[which * 256 + k];
#pragma unroll
      for (int kq = 0; kq < 4; ++kq) sv += hidp[((size_t)(kq * 2 + which) * 1024 + row) * 256 + k];
      hs[k] = gelu_tanh(sv);
    }
    float acc = 0.f;
#pragma unroll 8
    for (int k = 0; k < 256; ++k) acc += hs[k] * w2[k * 64 + lane];
    const int kvh = row & 1, bc = row >> 1, b = bc >> 7, c = bc & 127;
    if (which == 0) {
      float ss = acc * acc;
#pragma unroll
      for (int o = 32; o >= 1; o >>= 1) ss += __shfl_xor(ss, o);
      const float r = rsqrtf(ss * (1.0f / 64.f) + RMS_EPS);
      const float v = acc * r * P.in[15][(size_t)layer * 3 * 64 + lane];
      P.kc[((size_t)(b * 2 + kvh) * 128 + c) * 64 + lane] = (bf16_t)(pack2(v, 0.f) & 0xffff);
    } else {
      P.vcT[((size_t)(b * 2 + kvh) * 64 + lane) * 128 + c] = (bf16_t)(pack2(acc, 0.f) & 0xffff);
    }
  }
}

#define NEGBIG (-1e30f)
#define NQ 2
__device__ __forceinline__ void attn_load_tiles(const bf16_t* __restrict__ Kp, const bf16_t* __restrict__ Vp, int vstride, char* KT, char* VT) {
  const int tid = TIDX;
  const int row = tid >> 3, ch = tid & 7;
  const int so = lds_off(row, ch);
  const uint4 k0 = *(const uint4*)(Kp + (size_t)row * 64 + ch * 8), k1 = *(const uint4*)(Kp + (size_t)(row + 32) * 64 + ch * 8);
  const uint4 v0 = *(const uint4*)(Vp + (size_t)row * vstride + ch * 8), v1 = *(const uint4*)(Vp + (size_t)(row + 32) * vstride + ch * 8);
  *(uint4*)(KT + so) = k0; *(uint4*)(KT + so + 4096) = k1;
  *(uint4*)(VT + so) = v0; *(uint4*)(VT + so + 4096) = v1;
}
#define KV_ISSUE(Kp, Vp, vstride) do { const int tid_ = TIDX; const int row_ = tid_ >> 3, ch_ = tid_ & 7; \
    rk0 = *(const uint4*)((Kp) + (size_t)row_ * 64 + ch_ * 8); rk1 = *(const uint4*)((Kp) + (size_t)(row_ + 32) * 64 + ch_ * 8); \
    rv0 = *(const uint4*)((Vp) + (size_t)row_ * (vstride) + ch_ * 8); rv1 = *(const uint4*)((Vp) + (size_t)(row_ + 32) * (vstride) + ch_ * 8); } while (0)
#define KV_STORE() do { const int tid_ = TIDX; const int so_ = lds_off(tid_ >> 3, tid_ & 7); \
    *(uint4*)(KT + so_) = rk0; *(uint4*)(KT + so_ + 4096) = rk1; *(uint4*)(VT + so_) = rv0; *(uint4*)(VT + so_ + 4096) = rv1; } while (0)
__device__ __forceinline__ void attn_scores(const char* KT, int kfr0, const bf16x8 (&qf)[NQ][2], f32x4 (&S)[4][NQ]) {
#pragma unroll
  for (int mk = 0; mk < 4; ++mk)
#pragma unroll
    for (int nq = 0; nq < NQ; ++nq) S[mk][nq] = (f32x4){0.f, 0.f, 0.f, 0.f};
#pragma unroll
  for (int ks = 0; ks < 2; ++ks) {
    const char* pk = KT + (kfr0 ^ (ks * 64));
#pragma unroll
    for (int mk = 0; mk < 4; ++mk) {
      const bf16x8 kf = *(const bf16x8*)(pk + mk * 2048);
#pragma unroll
      for (int nq = 0; nq < NQ; ++nq) S[mk][nq] = __builtin_amdgcn_mfma_f32_16x16x32_bf16(kf, qf[nq][ks], S[mk][nq], 0, 0, 0);
    }
  }
}
__device__ __forceinline__ void attn_pv(const char* VT, int vfr0, const f32x4 (&S)[4][NQ], f32x4 (&O)[4][NQ]) {
#pragma unroll
  for (int s2 = 0; s2 < 2; ++s2) {
    bf16x8 pf[NQ];
#pragma unroll
    for (int nq = 0; nq < NQ; ++nq) {
      union { uint32_t u[4]; bf16x8 v; } cvt;
      cvt.u[0] = pack2(S[2 * s2][nq][0], S[2 * s2][nq][1]); cvt.u[1] = pack2(S[2 * s2][nq][2], S[2 * s2][nq][3]);
      cvt.u[2] = pack2(S[2 * s2 + 1][nq][0], S[2 * s2 + 1][nq][1]); cvt.u[3] = pack2(S[2 * s2 + 1][nq][2], S[2 * s2 + 1][nq][3]);
      pf[nq] = cvt.v;
    }
    const char* pv0 = VT + (vfr0 ^ (s2 * 64));
    const char* pv1 = VT + (vfr0 ^ (s2 * 64) ^ 32);
#pragma unroll
    for (int md = 0; md < 4; ++md) {
      union { uint2 h[2]; bf16x8 v; } vv;
      vv.h[0] = *(const uint2*)(pv0 + md * 2048);
      vv.h[1] = *(const uint2*)(pv1 + md * 2048);
#pragma unroll
      for (int nq = 0; nq < NQ; ++nq) O[md][nq] = __builtin_amdgcn_mfma_f32_16x16x32_bf16(vv.v, pf[nq], O[md][nq], 0, 0, 0);
    }
  }
}
__device__ __forceinline__ void attn_mask(f32x4 (&S)[4][NQ], int mode, int selbits, int hb, int posbase, int kbase, int l15, int q4) {
#pragma unroll
  for (int nq = 0; nq < NQ; ++nq) {
    const int rr = nq * 16 + l15;
    const bool rs = (selbits >> nq) & 1;
    const int lim = (posbase + rr + 1) >> 5;
#pragma unroll
    for (int mk = 0; mk < 4; ++mk)
#pragma unroll
      for (int r = 0; r < 4; ++r) {
        const int kk = mk * 16 + q4 * 4 + r;
        bool valid = rs;
        if (mode == 1) valid = valid && (kk <= hb + rr);
        else if (mode == 2) valid = valid && (kk > hb + rr);
        else if (mode == 3) valid = valid && (kbase + kk < lim);
        S[mk][nq][r] = valid ? S[mk][nq][r] : NEGBIG;
      }
  }
}
__device__ __forceinline__ void attn_softmax_step(f32x4 (&S)[4][NQ], float (&m)[NQ], float (&l)[NQ], f32x4 (&O)[4][NQ], bool rescale) {
#pragma unroll
  for (int nq = 0; nq < NQ; ++nq) {
    float mx = NEGBIG;
#pragma unroll
    for (int mk = 0; mk < 4; ++mk)
#pragma unroll
      for (int r = 0; r < 4; ++r) mx = fmaxf(mx, S[mk][nq][r]);
    mx = fmaxf(mx, __shfl_xor(mx, 16)); mx = fmaxf(mx, __shfl_xor(mx, 32));
    const float mnew = fmaxf(m[nq], mx);
    const float alpha = __builtin_amdgcn_exp2f(m[nq] - mnew);
    m[nq] = mnew;
    const float muse = fmaxf(mnew, -1e28f);
    float ps = 0.f;
#pragma unroll
    for (int mk = 0; mk < 4; ++mk)
#pragma unroll
      for (int r = 0; r < 4; ++r) {
        const float pv = __builtin_amdgcn_exp2f(S[mk][nq][r] - muse);
        ps += pv; S[mk][nq][r] = pv;
      }
    l[nq] = l[nq] * alpha + ps;
    if (rescale && __ballot(alpha != 1.0f) != 0ull) {
#pragma unroll
      for (int md = 0; md < 4; ++md) O[md][nq] *= alpha;
    }
  }
}
__device__ __forceinline__ void attn_reset(float (&m)[NQ], float (&l)[NQ], f32x4 (&O)[4][NQ]) {
#pragma unroll
  for (int nq = 0; nq < NQ; ++nq) { m[nq] = NEGBIG; l[nq] = 0.f; }
#pragma unroll
  for (int md = 0; md < 4; ++md)
#pragma unroll
    for (int nq = 0; nq < NQ; ++nq) O[md][nq] = (f32x4){0.f, 0.f, 0.f, 0.f};
}

__device__ void attn_unit(const Params& P, int unit, char* smem) {
  const int c32 = 127 - (unit >> 3);
  const int bk = unit & 7, b = bk >> 1, kvh = bk & 1;
  const int c = c32 >> 1, hb = (c32 & 1) * 32, posbase = c32 * 32;
  const int tid = TIDX, lane = tid & 63, g = tid >> 6, l15 = lane & 15, q4 = lane >> 4;
  const int h = kvh * 4 + g;
  const size_t tok0 = (size_t)b * SEQL + posbase;
  char* KT = smem;
  char* VT = smem + 8192;
  float* IMP = (float*)(smem + 16384);
  uint32_t* MASK = (uint32_t*)(smem + 16384 + 32 * 65 * 4);
  const int sw = (l15 >> 1) & 7;
  const int kfr0 = l15 * 128 + (((q4 ^ (sw & 3)) << 4) | ((sw >> 2) << 6));
  const int vfr0 = l15 * 128 + ((((q4 >> 1) ^ (sw & 1)) | (sw & 6)) << 4) + (q4 & 1) * 8;

  bf16x8 qf[NQ][2];
#pragma unroll
  for (int nq = 0; nq < NQ; ++nq)
#pragma unroll
    for (int ks = 0; ks < 2; ++ks) qf[nq][ks] = *(const bf16x8*)(P.qn + (tok0 + nq * 16 + l15) * 512 + h * 64 + ks * 32 + q4 * 8);

  f32x4 S[4][NQ], O[4][NQ];
  float m[NQ], l[NQ];
  const bf16_t* kcb = P.kc + (size_t)(b * 2 + kvh) * 128 * 64;
  const bf16_t* vcb = P.vcT + (size_t)(b * 2 + kvh) * 64 * 128;
  const int njb = (c32 + 1 + 63) >> 6;
  attn_reset(m, l, O);

  uint4 rk0, rk1, rv0, rv1;
  KV_ISSUE(kcb, vcb, 128);
  for (int jb = 0; jb < njb; ++jb) {
    __syncthreads();
    KV_STORE();
    __syncthreads();
    { const int jn = (jb + 1 < njb) ? jb + 1 : 0; KV_ISSUE(kcb + (size_t)jn * 64 * 64, vcb + jn * 64, 128); }
    __builtin_amdgcn_sched_barrier(0);
    attn_scores(KT, kfr0, qf, S);
    attn_mask(S, 3, 3, hb, posbase, jb * 64, l15, q4);
    attn_softmax_step(S, m, l, O, false);
  }
  float invl[NQ];
#pragma unroll
  for (int nq = 0; nq < NQ; ++nq) { float lt = l[nq]; lt += __shfl_xor(lt, 16); lt += __shfl_xor(lt, 32); invl[nq] = 1.0f / fmaxf(lt, 1e-30f); }
  for (int jb = 0; jb < njb; ++jb) {
    __syncthreads();
    KV_STORE();
    __syncthreads();
    { const int jn = (jb + 1 < njb) ? jb + 1 : jb; KV_ISSUE(kcb + (size_t)jn * 64 * 64, vcb + jn * 64, 128); }
    __builtin_amdgcn_sched_barrier(0);
    attn_scores(KT, kfr0, qf, S);
    attn_mask(S, 3, 3, hb, posbase, jb * 64, l15, q4);
#pragma unroll
    for (int nq = 0; nq < NQ; ++nq)
#pragma unroll
      for (int mk = 0; mk < 4; ++mk)
#pragma unroll
        for (int r = 0; r < 4; ++r) S[mk][nq][r] = __builtin_amdgcn_exp2f(S[mk][nq][r] - fmaxf(m[nq], -1e28f)) * invl[nq];
    for (int gg = 0; gg < 4; ++gg) {
      if (g == gg) {
#pragma unroll
        for (int nq = 0; nq < NQ; ++nq)
#pragma unroll
          for (int mk = 0; mk < 4; ++mk) {
            float* ip = IMP + (nq * 16 + l15) * 65 + jb * 32 + mk * 8 + q4 * 2;
            const float v0 = S[mk][nq][0] + S[mk][nq][1], v1 = S[mk][nq][2] + S[mk][nq][3];
            if (gg == 0) { ip[0] = v0; ip[1] = v1; } else { ip[0] += v0; ip[1] += v1; }
          }
      }
      __syncthreads();
    }
    attn_pv(VT, vfr0, S, O);
  }
  uint2 oreg[4][NQ];
#pragma unroll
  for (int nq = 0; nq < NQ; ++nq) {
    const float g0 = sigmoidf_(bf2f(P.z[(tok0 + nq * 16 + l15) * ZLD + ZC_NG + h * 3 + 0]));
#pragma unroll
    for (int md = 0; md < 4; ++md) {
      oreg[md][nq].x = pack2(O[md][nq][0] * g0, O[md][nq][1] * g0); oreg[md][nq].y = pack2(O[md][nq][2] * g0, O[md][nq][3] * g0);
    }
  }
  __syncthreads();
  for (int i = 0; i < 8; ++i) {
    const int rr = g * 8 + i;
    const float v = IMP[rr * 65 + lane];
    const bool visible = lane <= c;
    const bool forced = (lane == 0) || (lane == c) || (lane == c - 1);
    const float val = forced ? 1e4f : (visible ? v : -INFINITY);
    int rank = 0;
#pragma unroll
    for (int j = 0; j < 64; ++j) {
      const float vj = __int_as_float(__builtin_amdgcn_readlane(__float_as_int(val), j));
      rank += ((vj > val) || (vj == val && j < lane)) ? 1 : 0;
    }
    const bool sel = (rank < 16) && visible;
    const unsigned long long mk = __ballot(sel);
    if (lane == 0) { MASK[rr * 2] = (uint32_t)mk; MASK[rr * 2 + 1] = (uint32_t)(mk >> 32); }
  }
  __syncthreads();
  uint32_t ulo = MASK[(lane & 31) * 2], uhi = MASK[(lane & 31) * 2 + 1];
#pragma unroll
  for (int o = 16; o >= 1; o >>= 1) { ulo |= __shfl_xor(ulo, o); uhi |= __shfl_xor(uhi, o); }
  ulo = __builtin_amdgcn_readfirstlane(ulo); uhi = __builtin_amdgcn_readfirstlane(uhi);
  unsigned long long rem = ((unsigned long long)uhi << 32) | ulo;
  unsigned long long mrow[NQ];
#pragma unroll
  for (int nq = 0; nq < NQ; ++nq) mrow[nq] = ((unsigned long long)MASK[(nq * 16 + l15) * 2 + 1] << 32) | MASK[(nq * 16 + l15) * 2];

  attn_reset(m, l, O);
  {
    const bf16_t* kb = P.ksn + (size_t)(b * 2 + kvh) * SEQL * 64;
    const bf16_t* vb = P.vsT + (size_t)(b * 2 + kvh) * 64 * LDV;
    int j = __builtin_ctzll(rem);
    rem &= rem - 1;
    KV_ISSUE(kb + (size_t)j * 64 * 64, vb + j * 64, LDV);
    __syncthreads();
    KV_STORE();
    bool last = (rem == 0);
    int jn = last ? j : __builtin_ctzll(rem);
    rem &= rem - 1;
    KV_ISSUE(kb + (size_t)jn * 64 * 64, vb + jn * 64, LDV);
    __syncthreads();
    int pb = 0;
    for (;;) {
      const char* KTc = smem + pb * 32768; const char* VTc = KTc + 8192;
      __builtin_amdgcn_sched_barrier(0);
      attn_scores(KTc, kfr0, qf, S);
      int selbits = 0;
#pragma unroll
      for (int nq = 0; nq < NQ; ++nq) selbits |= (int)((mrow[nq] >> j) & 1ull) << nq;
      if (j == c) attn_mask(S, 1, selbits, hb, posbase, 0, l15, q4); else attn_mask(S, 0, selbits, hb, posbase, 0, l15, q4);
      attn_softmax_step(S, m, l, O, true);
      attn_pv(VTc, vfr0, S, O);
      if (last) break;
      { char* KT = smem + (pb ^ 1) * 32768; char* VT = KT + 8192; KV_STORE(); }
      j = jn; last = (rem == 0); jn = last ? j : __builtin_ctzll(rem); rem &= rem - 1;
      KV_ISSUE(kb + (size_t)jn * 64 * 64, vb + jn * 64, LDV);
      __syncthreads();
      pb ^= 1;
    }
  }
#pragma unroll
  for (int nq = 0; nq < NQ; ++nq) {
    float lt = l[nq]; lt += __shfl_xor(lt, 16); lt += __shfl_xor(lt, 32);
    const float sc = sigmoidf_(bf2f(P.z[(tok0 + nq * 16 + l15) * ZLD + ZC_NG + h * 3 + 1])) / fmaxf(lt, 1e-30f);
#pragma unroll
    for (int md = 0; md < 4; ++md) {
      const uint2 ov = oreg[md][nq];
      oreg[md][nq].x = pack2(lo2f(ov.x) + O[md][nq][0] * sc, hi2f(ov.x) + O[md][nq][1] * sc);
      oreg[md][nq].y = pack2(lo2f(ov.y) + O[md][nq][2] * sc, hi2f(ov.y) + O[md][nq][3] * sc);
    }
  }
  attn_reset(m, l, O);
  {
    const bf16_t* kb = P.kwn + (size_t)(b * 2 + kvh) * SEQL * 64;
    const bf16_t* vb = P.vwT + (size_t)(b * 2 + kvh) * 64 * LDV;
    const int j0 = (c - 8 > 0) ? (c - 8) : 0;
    int j = j0;
    KV_ISSUE(kb + (size_t)j * 64 * 64, vb + j * 64, LDV);
    __syncthreads();
    KV_STORE();
    int jn = (j < c) ? j + 1 : j;
    KV_ISSUE(kb + (size_t)jn * 64 * 64, vb + jn * 64, LDV);
    __syncthreads();
    int pb = 0;
    for (;;) {
      const char* KTc = smem + pb * 32768; const char* VTc = KTc + 8192;
      __builtin_amdgcn_sched_barrier(0);
      attn_scores(KTc, kfr0, qf, S);
      if (j == c) attn_mask(S, 1, 3, hb, posbase, 0, l15, q4);
      else if (j == c - 8) attn_mask(S, 2, 3, hb, posbase, 0, l15, q4);
      attn_softmax_step(S, m, l, O, true);
      attn_pv(VTc, vfr0, S, O);
      if (j == c) break;
      { char* KT = smem + (pb ^ 1) * 32768; char* VT = KT + 8192; KV_STORE(); }
      j = jn; jn = (j < c) ? j + 1 : j;
      KV_ISSUE(kb + (size_t)jn * 64 * 64, vb + jn * 64, LDV);
      __syncthreads();
      pb ^= 1;
    }
  }
#pragma unroll
  for (int nq = 0; nq < NQ; ++nq) {
    float lt = l[nq]; lt += __shfl_xor(lt, 16); lt += __shfl_xor(lt, 32);
    const float sc = sigmoidf_(bf2f(P.z[(tok0 + nq * 16 + l15) * ZLD + ZC_NG + h * 3 + 2])) / fmaxf(lt, 1e-30f);
#pragma unroll
    for (int md = 0; md < 4; ++md) {
      const uint2 ov = oreg[md][nq];
      uint2 w; w.x = pack2(lo2f(ov.x) + O[md][nq][0] * sc, hi2f(ov.x) + O[md][nq][1] * sc); w.y = pack2(lo2f(ov.y) + O[md][nq][2] * sc, hi2f(ov.y) + O[md][nq][3] * sc);
      *(uint2*)(P.ob + (tok0 + nq * 16 + l15) * LD5 + h * 64 + md * 16 + q4 * 4) = w;
    }
  }
}
__device__ void phase_attn_s5(const Params& P, int layer, char* smem, int pass) {
  if (BIDX < 128) { s5_unit(P, layer, BIDX, smem); }
  unsigned* ctr = P.bar + 3600 + (layer * 2 + pass) * 56;
  volatile int* slot = (volatile int*)(smem + 65024);
  for (;;) {
    __syncthreads();
    if (threadIdx.x == 0) *slot = (int)atomicAdd(ctr, 1u);
    __syncthreads();
    const int u = __builtin_amdgcn_readfirstlane(*slot);
    if (u >= 1024) break;
    attn_unit(P, u, smem);
  }
}

#define NPHASE 11
__device__ __forceinline__ void run_phase(const Params& P, int layer, int ph, char* smem, float alpha = 1.0f) {
  switch (ph) {
    case 0: phase_convert(P, layer, smem); phase_cmp_bias(P, layer);
            phase_rmsnorm(layer == 0 ? P.in[0] : P.x, layer == 0 ? P.x : nullptr, P.in[1] + (size_t)layer * DM, P.hbuf); break;
    case 1: phase_gemm_in(P, layer, smem); break;
    case 2: phase_prep(P, layer, smem); break;
    case 3: break;
    case 4: phase_cmp2(P, layer, smem); break;
    case 5: phase_attn_s5(P, layer, smem, alpha == 0.0f ? 1 : 0); break;
    case 6: phase_merge(P, smem); break;
    case 7: phase_gemm_resid(P, P.hbuf, LDH, P.Wt_out, DM, smem, alpha); break;
    case 8: phase_rmsnorm(P.x, nullptr, P.in[21] + (size_t)layer * DM, P.hbuf); break;
    case 9: phase_gemm_gateup(P, smem); break;
    case 10: phase_gemm_resid(P, P.z, LDA, P.Wt_down, DFF, smem, alpha); break;
  }
}

#ifndef REPEAT_MASK
#define REPEAT_MASK 0
#endif
#if !MEGA
__global__ void __launch_bounds__(256, 2) k_phase(Params P, int layer, int ph) {
  __shared__ __attribute__((aligned(16))) char smem[65536];
  run_phase(P, layer, ph, smem);
}
#else
#define XB_TMO      128
#define XB_XCNT(j)  (256  + 64 * (j))
#define XB_XSUB(j)  (1280 + 64 * (j))
#define XB_XGEN(j)  (2304 + 64 * (j))
#define XB_TOP      3328
#define XB_TOPGEN   3392
#define XCD_BAR_WORDS 3456
#define XB_SPIN_CAP (1u << 22)
__device__ __forceinline__ unsigned xb_ld(unsigned* p)              { return __hip_atomic_load(p, __ATOMIC_RELAXED, __HIP_MEMORY_SCOPE_AGENT); }
__device__ __forceinline__ unsigned xb_add(unsigned* p, unsigned v) { return __hip_atomic_fetch_add(p, v, __ATOMIC_RELAXED, __HIP_MEMORY_SCOPE_AGENT); }
__device__ __forceinline__ unsigned xb_xcc_id() { return (unsigned)__builtin_amdgcn_s_getreg((3 << 11) | 20) & 0xFu; }
#define XB_SPIN(cond, bar) do { unsigned _sp = 0; while (cond) { __builtin_amdgcn_s_sleep(1); \
    if ((++_sp & 255u) == 0u) { if (xb_ld(&(bar)[XB_TMO])) break; if (_sp > XB_SPIN_CAP) { atomicAdd(&(bar)[XB_TMO], 1u); break; } } } } while (0)
struct XcdBarrier { unsigned* bar; unsigned x, nloc, nx; };
__device__ __forceinline__ void xcd_barrier_complete(unsigned* bar, unsigned x, unsigned& nloc, unsigned& nx) {
  const unsigned G = gridDim.x;
  unsigned sum, cnt, mine, sp = 0u;
  for (;;) {
    sum = 0u; cnt = 0u; mine = 0u;
#pragma unroll
    for (unsigned j = 0; j < 16; ++j) { const unsigned c = xb_ld(&bar[XB_XCNT(j)]); sum += c; cnt += (c > 0u) ? 1u : 0u; mine = (j == x) ? c : mine; }
    if (sum == G) break;
    __builtin_amdgcn_s_sleep(1);
    if ((++sp & 255u) == 0u) { if (xb_ld(&bar[XB_TMO])) break; if (sp > XB_SPIN_CAP) { atomicAdd(&bar[XB_TMO], 1u); break; } }
  }
  nloc = mine > 0u ? mine : 1u; nx = cnt > 0u ? cnt : 1u;
}
__device__ __forceinline__ void xcd_barrier(const XcdBarrier& b) {
  asm volatile("s_waitcnt vmcnt(0)" ::: "memory");
  __syncthreads();
  if (threadIdx.x == 0) {
    unsigned* bar = b.bar;
    __builtin_amdgcn_s_waitcnt(0);
    const unsigned nloc = b.nloc, nx = b.nx;
    const unsigned old = xb_add(&bar[XB_XSUB(b.x)], 1u);
    const unsigned gen = old / nloc;
    if (old + 1u == (gen + 1u) * nloc) {
      __builtin_amdgcn_fence(__ATOMIC_RELEASE, "agent");
      asm volatile("s_waitcnt vmcnt(0)" ::: "memory");
      const unsigned og = xb_add(&bar[XB_TOP], 1u);
      const unsigned tg = og / nx;
      if (og + 1u == (tg + 1u) * nx) xb_add(&bar[XB_TOPGEN], 1u);
      else XB_SPIN(xb_ld(&bar[XB_TOPGEN]) == tg, bar);
      __builtin_amdgcn_fence(__ATOMIC_ACQUIRE, "agent");
      xb_add(&bar[XB_XGEN(b.x)], 1u);
      asm volatile("s_waitcnt vmcnt(0)" ::: "memory");
    } else {
      XB_SPIN(xb_ld(&bar[XB_XGEN(b.x)]) == gen, bar);
      __builtin_amdgcn_fence(__ATOMIC_ACQUIRE, "agent");
      asm volatile("s_waitcnt vmcnt(0)" ::: "memory");
    }
  }
  __syncthreads();
}

__global__ void __launch_bounds__(256, 2) k_mega(Params P) {
  __shared__ __attribute__((aligned(16))) char smem[65536];
  if (P.x == nullptr) { cg::this_grid().sync(); }
  XcdBarrier xb; xb.bar = P.bar; xb.x = xb_xcc_id(); xb.nloc = 1u; xb.nx = 1u;
  if (threadIdx.x == 0) { (void)xb_add(&P.bar[XB_XCNT(xb.x)], 1u); xcd_barrier_complete(P.bar, xb.x, xb.nloc, xb.nx); }
  for (int layer = 0; layer < DEPTH; ++layer) {
    for (int ph = 0; ph < NPHASE; ++ph) {
      if (ph == 3) continue;
      run_phase(P, layer, ph, smem);
      if ((REPEAT_MASK >> ph) & 1) { xcd_barrier(xb); run_phase(P, layer, ph, smem, 0.0f); }
      if (!(layer == DEPTH - 1 && ph == NPHASE - 1)) xcd_barrier(xb);
    }
  }
}
#endif

extern "C" void kernel_launch(void* const* d_in, const int* in_sizes, int n_in, void* d_out, int out_size, void* d_ws, size_t ws_size, hipStream_t stream) {
  Params P;
  memset(&P, 0, sizeof(P));
  for (int i = 0; i < 24; ++i) P.in[i] = (const float*)d_in[i];
  P.x = (float*)d_out;
  char* w = (char*)d_ws;
  size_t off = 0;
  auto take = [&](size_t bytes) { char* p = w + off; off += (bytes + 255) & ~(size_t)255; return (bf16_t*)p; };
  P.Wt_in = take((size_t)ZLD * LDH * 2);
  P.Wt_glu = take((size_t)2048 * LD5 * 2);
  P.Wt_conv = take((size_t)1024 * LD5 * 2);
  P.Wt_o = take((size_t)1024 * LD5 * 2);
  P.Wt_out = take((size_t)1024 * LDH * 2);
  P.Wt_gu = take((size_t)5632 * LDH * 2);
  P.Wt_down = take((size_t)1024 * LDA * 2);
  P.Wt_c1 = take((size_t)512 * LDC * 2);
  P.z = take((size_t)T_TOK * ZLD * 2);
  P.hbuf = take((size_t)T_TOK * LDH * 2);
  P.ys = take((size_t)T_TOK * LD5 * 2);
  P.cv = take((size_t)T_TOK * LD5 * 2);
  P.ob = take((size_t)T_TOK * LD5 * 2);
  P.qn = take((size_t)T_TOK * 512 * 2);
  P.ksn = take((size_t)T_TOK * 128 * 2);
  P.kwn = take((size_t)T_TOK * 128 * 2);
  P.vsT = take((size_t)8 * 64 * LDV * 2);
  P.vwT = take((size_t)8 * 64 * LDV * 2);
  P.acmp = take((size_t)2 * 1024 * LDC * 2);
  P.hid = take((size_t)2 * 1024 * 256 * 2);
  P.kc = take((size_t)8 * 128 * 64 * 2);
  P.vcT = take((size_t)8 * 64 * 128 * 2);
  P.bar = (unsigned*)take((size_t)4096 * 4);
  P.cbias = (float*)take((size_t)512 * 4);
  if (off > ws_size) { fprintf(stderr, "kernel_launch: workspace too small: need %zu have %zu\n", off, ws_size); return; }
#if MEGA
  static int grid_blocks = 0;
  if (!grid_blocks) {
    int dev = 0, cus = 0, per_cu = 0;
    hipGetDevice(&dev);
    hipDeviceGetAttribute(&cus, hipDeviceAttributeMultiprocessorCount, dev);
    hipOccupancyMaxActiveBlocksPerMultiprocessor(&per_cu, k_mega, 256, 0);
    (void)per_cu;
    grid_blocks = cus * 2;
  }
  hipMemsetAsync(P.bar, 0, 4096 * 4, stream);
  void* args[] = {&P};
  hipError_t e = hipLaunchCooperativeKernel((void*)k_mega, dim3(grid_blocks), dim3(256), args, 0, stream);
  if (e != hipSuccess) fprintf(stderr, "cooperative launch failed: %s (grid %d)\n", hipGetErrorString(e), grid_blocks);
#else
  for (int layer = 0; layer < DEPTH; ++layer)
    for (int ph = 0; ph < NPHASE; ++ph) {
      hipLaunchKernelGGL(k_phase, dim3(512), dim3(256), 0, stream, P, layer, ph);
      if ((REPEAT_MASK >> ph) & 1) hipLaunchKernelGGL(k_phase, dim3(512), dim3(256), 0, stream, P, layer, ph);
    }
#endif
}
```
